# Optimizing an MI355X kernel written in HIP

```python
import jax, jax.numpy as jnp
from jax import lax
import numpy as np

D_MODEL = 1024
BATCH = 2
SEQ = 8192
DEPTH = 2

CHUNK = 64
LEFT_CHUNKS = 8
BAND = (LEFT_CHUNKS + 1) * CHUNK
HEAD_DIM = 64
N_HEADS_A = 8
N_HEADS_C = 8
WIDTH_A = N_HEADS_A * HEAD_DIM
WIDTH_C = N_HEADS_C * HEAD_DIM
POOL_WINDOWS = (2, 4, 8, 16)
N_POOL_GROUPS = 4
POOL_GROUP_DIM = 128
WIDTH_B = N_POOL_GROUPS * POOL_GROUP_DIM
REL_CLIP = 128
N_REL = 2 * REL_CLIP + 1
N_BRANCHES = 3
D_FF = 2816
Q_BLOCK = 128
N_MOD = 9
EPS = 1e-6
NEG_INF = -1e30

SPLIT_SIZES = (WIDTH_A, WIDTH_A, WIDTH_A, WIDTH_B, WIDTH_C, WIDTH_C, WIDTH_C, N_HEADS_C, N_BRANCHES * D_MODEL)
D_IN = sum(SPLIT_SIZES)
SPLIT_POINTS = tuple(int(p) for p in np.cumsum(SPLIT_SIZES)[:-1])

kernel_name = "hybrid_chunk_causal_encoder"


def rms_norm(x, gain):
    xf = x.astype(jnp.float32)
    y = xf * lax.rsqrt(jnp.mean(xf * xf, axis=-1, keepdims=True) + EPS)
    return (y * gain.astype(jnp.float32)).astype(x.dtype)


def modulate(h, shift, scale):
    return h * (1 + scale[:, None, :]) + shift[:, None, :]


def swiglu(h, w_gate, w_up, w_down):
    return (jax.nn.silu(h @ w_gate) * (h @ w_up)) @ w_down


def chunked_relpos_attention(q, k, v, gq, gk, rel_bias):
    B, S, H, dh = q.shape
    nc = S // CHUNK
    qf = rms_norm(q, gq).astype(jnp.float32) * (dh ** -0.5)
    kf = rms_norm(k, gk).astype(jnp.float32)
    qc = qf.reshape(B, nc, CHUNK, H, dh)
    pad = ((0, 0), (LEFT_CHUNKS * CHUNK, 0), (0, 0), (0, 0))
    kp = jnp.pad(kf, pad).reshape(B, nc + LEFT_CHUNKS, CHUNK, H, dh)
    vp = jnp.pad(v, pad).reshape(B, nc + LEFT_CHUNKS, CHUNK, H, dh)
    band_idx = np.arange(nc)[:, None] + np.arange(LEFT_CHUNKS + 1)[None, :]
    kb = kp[:, band_idx].reshape(B, nc, BAND, H, dh)
    vb = vp[:, band_idx].reshape(B, nc, BAND, H, dh)
    logits = jnp.einsum('bnqhd,bnkhd->bhnqk', qc, kb)
    rel = np.arange(CHUNK)[:, None] + LEFT_CHUNKS * CHUNK - np.arange(BAND)[None, :]
    rel_idx = np.clip(rel, -REL_CLIP, REL_CLIP) + REL_CLIP
    bias = rel_bias[:, rel_idx].astype(jnp.float32)
    valid = np.repeat(band_idx >= LEFT_CHUNKS, CHUNK, axis=1)
    logits = jnp.where(valid[None, None, :, None, :], logits + bias[None, :, None], NEG_INF)
    p = jax.nn.softmax(logits, axis=-1).astype(v.dtype)
    out = jnp.einsum('bhnqk,bnkhd->bnqhd', p, vb)
    return out.reshape(B, S, H * dh)


def multiscale_pool(u, w_pool, pool_scale):
    B, S, _ = u.shape
    uf = u.astype(jnp.float32)
    cs = jnp.concatenate([jnp.zeros((B, 1, WIDTH_B), jnp.float32), jnp.cumsum(uf, axis=1)], axis=1)
    t = jnp.arange(S, dtype=jnp.float32)
    diffs = []
    for g, w in enumerate(POOL_WINDOWS):
        sl = slice(g * POOL_GROUP_DIM, (g + 1) * POOL_GROUP_DIM)
        csg = cs[:, :, sl]
        upper = csg[:, 1:]
        lower = jnp.pad(csg[:, :S + 1 - w], ((0, 0), (w - 1, 0), (0, 0)))
        count = jnp.minimum(t + 1, float(w))[None, :, None]
        diffs.append((upper - lower) / count - uf[:, :, sl])
    d = jnp.stack(diffs, axis=2).astype(u.dtype)
    y = jnp.einsum('bsgc,gce->bsge', d, w_pool).reshape(B, S, WIDTH_B)
    return y * pool_scale


def forgetting_attention(q, k, v, gq, gk, f_logit):
    B, S, H, dh = q.shape
    qf = rms_norm(q, gq).astype(jnp.float32) * (dh ** -0.5)
    kf = rms_norm(k, gk).astype(jnp.float32)
    cum_logf = jnp.cumsum(jax.nn.log_sigmoid(f_logit.astype(jnp.float32)), axis=1)
    cum_k = cum_logf.transpose(0, 2, 1)
    kpos = jnp.arange(S)

    def block(i):
        start = i * Q_BLOCK
        qb = lax.dynamic_slice_in_dim(qf, start, Q_BLOCK, axis=1)
        cq = lax.dynamic_slice_in_dim(cum_k, start, Q_BLOCK, axis=2)
        logits = jnp.einsum('bqhd,bkhd->bhqk', qb, kf) + (cq[..., None] - cum_k[:, :, None, :])
        qpos = start + jnp.arange(Q_BLOCK)
        mask = kpos[None, :] <= qpos[:, None]
        logits = jnp.where(mask[None, None], logits, NEG_INF)
        p = jax.nn.softmax(logits, axis=-1).astype(v.dtype)
        return jnp.einsum('bhqk,bkhd->bqhd', p, v)

    out = lax.map(block, jnp.arange(S // Q_BLOCK))
    return out.transpose(1, 0, 2, 3, 4).reshape(B, S, H * dh)


def hybrid_mixer(h, w_in, qk_gain, rel_bias, forget_bias, w_pool, pool_scale, w_branch, w_out):
    B, S, _ = h.shape
    proj = h @ w_in
    qa, ka, va, ub, qc, kc, vc, f_lin, g_lin = jnp.split(proj, SPLIT_POINTS, axis=-1)
    ha = lambda t: t.reshape(B, S, N_HEADS_A, HEAD_DIM)
    hc = lambda t: t.reshape(B, S, N_HEADS_C, HEAD_DIM)
    ya = chunked_relpos_attention(ha(qa), ha(ka), ha(va), qk_gain[0], qk_gain[1], rel_bias)
    yb = multiscale_pool(ub, w_pool, pool_scale)
    yc = forgetting_attention(hc(qc), hc(kc), hc(vc), qk_gain[2], qk_gain[3], f_lin + forget_bias)
    ys = jnp.stack([ya, yb, yc], axis=2)
    branch = jnp.einsum('bsnw,nwd->bsnd', ys, w_branch)
    gates = jax.nn.sigmoid(g_lin.reshape(B, S, N_BRANCHES, D_MODEL))
    merged = jnp.sum(gates * branch, axis=2)
    return merged @ w_out


def setup_inputs(seed: int = 0) -> dict:
    key = jax.random.key(seed)
    ks = jax.random.split(key, 18)
    nrm = lambda k, shape, s: jax.random.normal(k, shape, jnp.float32) * s
    return {
        "x": nrm(ks[0], (BATCH, SEQ, D_MODEL), 1.0),
        "c": nrm(ks[1], (BATCH, D_MODEL), 1.0),
        "w_ada": nrm(ks[2], (DEPTH, D_MODEL, N_MOD * D_MODEL), 0.5 * D_MODEL ** -0.5),
        "b_ada": nrm(ks[3], (DEPTH, N_MOD * D_MODEL), 0.02),
        "norm_gain": 1.0 + nrm(ks[4], (DEPTH, 3, D_MODEL), 0.05),
        "ffn_w_gate": nrm(ks[5], (DEPTH, 2, D_MODEL, D_FF), D_MODEL ** -0.5),
        "ffn_w_up": nrm(ks[6], (DEPTH, 2, D_MODEL, D_FF), D_MODEL ** -0.5),
        "ffn_w_down": nrm(ks[7], (DEPTH, 2, D_FF, D_MODEL), D_FF ** -0.5),
        "w_in": nrm(ks[8], (DEPTH, D_MODEL, D_IN), D_MODEL ** -0.5),
        "qk_gain": 1.0 + nrm(ks[9], (DEPTH, 4, HEAD_DIM), 0.05),
        "rel_bias": nrm(ks[10], (DEPTH, N_HEADS_A, N_REL), 0.5),
        "forget_bias": 1.0 + 3.0 * jax.random.uniform(ks[11], (DEPTH, N_HEADS_C), jnp.float32),
        "w_pool": nrm(ks[12], (DEPTH, N_POOL_GROUPS, POOL_GROUP_DIM, POOL_GROUP_DIM), POOL_GROUP_DIM ** -0.5),
        "pool_scale": 1.0 + nrm(ks[13], (DEPTH, WIDTH_B), 0.05),
        "w_branch": nrm(ks[14], (DEPTH, N_BRANCHES, WIDTH_A, D_MODEL), WIDTH_A ** -0.5),
        "w_out": nrm(ks[15], (DEPTH, D_MODEL, D_MODEL), D_MODEL ** -0.5),
    }


def reference(x, c, w_ada, b_ada, norm_gain, ffn_w_gate, ffn_w_up, ffn_w_down, w_in, qk_gain,
              rel_bias, forget_bias, w_pool, pool_scale, w_branch, w_out):
    B = x.shape[0]
    c_act = jax.nn.silu(c)
    for l in range(DEPTH):
        mod = (c_act @ w_ada[l] + b_ada[l]).reshape(B, N_MOD, D_MODEL)
        h = modulate(rms_norm(x, norm_gain[l, 0]), mod[:, 0], mod[:, 1])
        x = x + 0.5 * mod[:, 2][:, None, :] * swiglu(h, ffn_w_gate[l, 0], ffn_w_up[l, 0], ffn_w_down[l, 0])
        h = modulate(rms_norm(x, norm_gain[l, 1]), mod[:, 3], mod[:, 4])
        x = x + mod[:, 5][:, None, :] * hybrid_mixer(h, w_in[l], qk_gain[l], rel_bias[l], forget_bias[l],
                                                      w_pool[l], pool_scale[l], w_branch[l], w_out[l])
        h = modulate(rms_norm(x, norm_gain[l, 2]), mod[:, 6], mod[:, 7])
        x = x + 0.5 * mod[:, 8][:, None, :] * swiglu(h, ffn_w_gate[l, 1], ffn_w_up[l, 1], ffn_w_down[l, 1])
    return x
```

```cpp
#include <hip/hip_runtime.h>
#include <hip/hip_cooperative_groups.h>
#include <hip/hip_bf16.h>
#include <cstdio>
#include <cstdint>
#include <cmath>
namespace cg = cooperative_groups;

namespace pg8 {
#define PG8_LAS __attribute__((address_space(3)))
typedef unsigned short bf16_t;
typedef short bf16x8 __attribute__((ext_vector_type(8)));
typedef float f32x4 __attribute__((ext_vector_type(4)));
typedef unsigned u32x4 __attribute__((ext_vector_type(4)));
constexpr int BM = 256, BK = 64, HALF = 128, HTB = HALF * BK * 2  , STAGE_BYTES = 8 * HTB, NXCD = 8, WGM = 8;

__host__ __device__ __forceinline__ int lds_byte(int r, int c) { const int st = (r >> 4) * 2 + (c >> 5), rr = r & 15, cc = c & 31, ob = rr * 64 + cc * 2; return st * 1024 + (ob ^ (((ob >> 9) & 1) << 5)); }
__host__ __device__ __forceinline__ void stage_rc(int b, int& R, int& C) { const int st = b / 1024, sb = b % 1024, swz = sb ^ (((sb >> 9) & 1) << 5); R = (st >> 1) * 16 + swz / 64; C = (st & 1) * 32 + (swz % 64) / 2; }
__host__ __device__ __forceinline__ int perm32(int rho) { const int n = rho >> 4, i = rho & 15; return 8 * (i >> 2) + 4 * n + (i & 3); }

struct Unit { int pm, pn, roff, nai; };
struct Gemm { const bf16_t* A; const bf16_t* Bt; int M, N, K; int a_tiles; size_t a_stride; };

struct StaticOrder {
    static constexpr bool KEEP = false;
    int nM, nN, nwg, G, c;
    __host__ __device__ void init(int M, int N, int G_, int c_) { nM = M / BM; nN = N / BM; nwg = nM * nN; G = G_; c = c_; tail = 0; }
    int tail;
    __host__ __device__ bool next(int i, Unit& u) const {
        long L = (long)i * G + c; u.roff = 0; u.nai = 2;
        const int full = nwg / G;
        if (tail && (nwg - full * G) * 2 == G && i >= full) { if (i > full) return false; L = (long)full * G + (c >> 1); u.roff = 128 * (c & 1); u.nai = 1; }
        if (L >= nwg) return false;
        int wgid = (int)L; { const int q = nwg / NXCD, r = nwg % NXCD, xcd = wgid % NXCD, off = wgid / NXCD; wgid = (xcd < r ? xcd * (q + 1) : r * (q + 1) + (xcd - r) * q) + off; }
        const int nig = WGM * nN, gid = wgid / nig, fm = gid * WGM, gsz = (nM - fm) < WGM ? (nM - fm) : WGM;
        u.pm = fm + ((wgid % nig) % gsz); u.pn = (wgid % nig) / gsz; return true;
    }
    __device__ __forceinline__ void a_ready(const Unit&) const {}
    __device__ __forceinline__ void done(const Unit&) const {}
};

typedef float f32x2c __attribute__((ext_vector_type(2))); typedef __bf16 bf16x2c __attribute__((ext_vector_type(2)));
__device__ __forceinline__ unsigned cvt_pk_bf16(float lo, float hi) { f32x2c v = {lo, hi}; bf16x2c b = __builtin_convertvector(v, bf16x2c); return __builtin_bit_cast(unsigned, b); }

typedef float f32x2 __attribute__((ext_vector_type(2)));
constexpr float EPI_LOG2E = 1.4426950408889634f;
constexpr float EPI_C2 = 0.125f * 1.4426950408889634f;
__device__ __forceinline__ float sigm(float x) { return __builtin_amdgcn_rcpf(1.0f + __builtin_amdgcn_exp2f(-x * EPI_LOG2E)); }
__device__ __forceinline__ f32x4 sigm4(f32x4 v) { return (f32x4){sigm(v[0]), sigm(v[1]), sigm(v[2]), sigm(v[3])}; }
__device__ __forceinline__ u32x4 pack8(f32x4 v0, f32x4 v1) { u32x4 w; w.x = cvt_pk_bf16(v0[0], v0[1]); w.y = cvt_pk_bf16(v0[2], v0[3]); w.z = cvt_pk_bf16(v1[0], v1[1]); w.w = cvt_pk_bf16(v1[2], v1[3]); return w; }
__device__ __forceinline__ f32x4 bf_lo4(unsigned a, unsigned b) { return (f32x4){__uint_as_float(a << 16), __uint_as_float(a & 0xffff0000u), __uint_as_float(b << 16), __uint_as_float(b & 0xffff0000u)}; }

__device__ __forceinline__ unsigned q4u8(f32x4 g) { f32x4 t = g * 255.0f + 0.5f; t[0] = fmaxf(t[0], 1.0f); t[1] = fmaxf(t[1], 1.0f); t[2] = fmaxf(t[2], 1.0f); t[3] = fmaxf(t[3], 1.0f);     return (unsigned)t[0] | ((unsigned)t[1] << 8) | ((unsigned)t[2] << 16) | ((unsigned)t[3] << 24); }
__device__ __forceinline__ f32x4 dq4u8(unsigned w) { return (f32x4){(float)(w & 0xffu), (float)((w >> 8) & 0xffu), (float)((w >> 16) & 0xffu), (float)(w >> 24)}; }
struct EpiSwiglu {
    static constexpr bool PERM = true, AFTER_DRAIN = false;
    bf16_t* H; int ldh;
    __device__ __forceinline__ void operator()(const f32x4 (&acc)[2][2][4][2], const Unit& u, int wr, int wc, int fr, int fq) const {
        const int row0 = u.pm * BM + u.roff + wr * 64 + fr, col0 = u.pn * 128 + wc * 32 + 8 * fq;
#pragma unroll
        for (int ai = 0; ai < 2; ++ai) if (ai < u.nai)
#pragma unroll
            for (int m = 0; m < 4; ++m) { bf16_t* rowp = H + (size_t)(row0 + ai * HALF + m * 16) * ldh + col0;
                const f32x4 g0 = acc[ai][0][m][0], g1 = acc[ai][0][m][1], u0 = acc[ai][1][m][0], u1 = acc[ai][1][m][1];
                const f32x4 h0 = g0 * sigm4(g0) * u0, h1 = g1 * sigm4(g1) * u1;
                *(u32x4*)rowp = pack8(h0, h1); }
    }
};
struct EpiResid {
    static constexpr bool PERM = false, AFTER_DRAIN = true;
    const float* base; float* out; const float* gate;
    bf16_t* xn; const float* ngain; const float* nshift; const float* nscale; float* xbuf; unsigned* cnt; float coef; int donorm;
    __device__ __forceinline__ void fused(f32x4 (&acc)[2][2][4][2], const Unit& u, int wr, int wc, int fr, int fq, PG8_LAS unsigned char* lds, int wid, int lane) const {
        const int row0 = u.pm * BM + wr * 64 + fr, col0 = u.pn * BM + wc * 32 + 4 * fq; const int bo = (u.pm >= 32 ? 9216 : 0); const float* gp = gate + bo + col0;
        f32x4 gv[2][2];
#pragma unroll
        for (int bj = 0; bj < 2; ++bj)
#pragma unroll
            for (int n = 0; n < 2; ++n) gv[bj][n] = *(const f32x4*)(gp + bj * HALF + n * 16) * coef;
#pragma unroll
        for (int ai = 0; ai < 2; ++ai)
#pragma unroll
            for (int m = 0; m < 4; ++m) { const size_t off = (size_t)(row0 + ai * HALF + m * 16) * 1024 + col0;
#pragma unroll
                for (int bj = 0; bj < 2; ++bj)
#pragma unroll
                    for (int n = 0; n < 2; ++n) { const f32x4 bs = *(const f32x4*)(base + off + bj * HALF + n * 16); acc[ai][bj][m][n] = bs + gv[bj][n] * acc[ai][bj][m][n]; *(f32x4*)(out + off + bj * HALF + n * 16) = acc[ai][bj][m][n]; }
                if (m & 1) asm volatile("" ::: "memory"); }
        if (donorm == 0) return;
        PG8_LAS float* P = (PG8_LAS float*)lds;
        PG8_LAS float* S = (PG8_LAS float*)(lds + 4096);
#pragma unroll
        for (int ai = 0; ai < 2; ++ai)
#pragma unroll
            for (int m = 0; m < 4; ++m) { float q = 0.f;
#pragma unroll
                for (int bj = 0; bj < 2; ++bj)
#pragma unroll
                    for (int n = 0; n < 2; ++n) { const f32x4 x = acc[ai][bj][m][n]; q += (x[0] * x[0] + x[1] * x[1]) + (x[2] * x[2] + x[3] * x[3]); }
                q += __shfl_xor(q, 16); q += __shfl_xor(q, 32);
                if (fq == 0) P[(ai * HALF + wr * 64 + m * 16 + fr) * 4 + wc] = q; }
        asm volatile("s_waitcnt lgkmcnt(0)" ::: "memory"); __builtin_amdgcn_s_barrier(); asm volatile("" ::: "memory");
        const int row = wid * 32 + (lane & 31); float* slot = xbuf + ((size_t)(u.pm * BM + row)) * 4;
        if (lane < 32) { const float t = (P[row * 4 + 0] + P[row * 4 + 1]) + (P[row * 4 + 2] + P[row * 4 + 3]); __hip_atomic_store((unsigned*)slot + u.pn, __float_as_uint(t), __ATOMIC_RELAXED, __HIP_MEMORY_SCOPE_AGENT); }
        asm volatile("s_waitcnt vmcnt(0)" ::: "memory");
        if (lane == 0) __hip_atomic_fetch_add(cnt + 64 * u.pm, 1u, __ATOMIC_RELAXED, __HIP_MEMORY_SCOPE_AGENT);
        if (wid == 0) { for (unsigned sp = 0; sp < (1u << 22); ++sp) { if ((unsigned)__builtin_amdgcn_readfirstlane(__hip_atomic_load(cnt + 64 * u.pm, __ATOMIC_RELAXED, __HIP_MEMORY_SCOPE_AGENT)) >= 32u) break; __builtin_amdgcn_s_sleep(2); }
            __builtin_amdgcn_fence(__ATOMIC_ACQUIRE, "agent"); }
        asm volatile("s_waitcnt vmcnt(0) lgkmcnt(0)" ::: "memory"); __builtin_amdgcn_s_barrier(); asm volatile("" ::: "memory");
        if (lane < 32) { float t = 0.f;
#pragma unroll
            for (int k = 0; k < 4; ++k) t += __uint_as_float(__hip_atomic_load((unsigned*)slot + k, __ATOMIC_RELAXED, __HIP_MEMORY_SCOPE_AGENT));
            S[row] = 1.0f / sqrtf(t * (1.0f / 1024.0f) + 1e-6f); }
        asm volatile("s_waitcnt lgkmcnt(0)" ::: "memory"); __builtin_amdgcn_s_barrier(); asm volatile("" ::: "memory");
        typedef unsigned u32x2v __attribute__((ext_vector_type(2)));
        const float* g2 = ngain + col0; const float* sh2 = nshift + bo + col0; const float* sc2 = nscale + bo + col0;
#pragma unroll
        for (int bj = 0; bj < 2; ++bj)
#pragma unroll
            for (int n = 0; n < 2; ++n) { const f32x4 g = *(const f32x4*)(g2 + bj * HALF + n * 16), sc = *(const f32x4*)(sc2 + bj * HALF + n * 16), sh = *(const f32x4*)(sh2 + bj * HALF + n * 16); const f32x4 gm = g * (1.0f + sc);
#pragma unroll
                for (int ai = 0; ai < 2; ++ai)
#pragma unroll
                    for (int m = 0; m < 4; ++m) { const int r = ai * HALF + wr * 64 + m * 16 + fr; const float rs = S[r]; const f32x4 v = (acc[ai][bj][m][n] * rs) * gm + sh;
                        u32x2v w; w.x = cvt_pk_bf16(v[0], v[1]); w.y = cvt_pk_bf16(v[2], v[3]);
                        *(u32x2v*)(xn + (size_t)(u.pm * BM + r) * 1024 + col0 + bj * HALF + n * 16) = w; } }
    }
};
struct EpiInproj {
    static constexpr bool PERM = true, AFTER_DRAIN = false;
    bf16_t* base; bf16_t* G; const PG8_LAS float* gain;
    __device__ __forceinline__ void operator()(const f32x4 (&acc)[2][2][4][2], const Unit& u, int wr, int wc, int fr, int fq) const {
        const int row0 = u.pm * BM + u.roff + wr * 64 + fr;
        if (u.pn >= 14) {
            const int col0 = (u.pn - 14) * 256 + 64 * wc + 8 * fq;
#pragma unroll
            for (int ai = 0; ai < 2; ++ai) if (ai < u.nai)
#pragma unroll
                for (int m = 0; m < 4; ++m) { unsigned char* rowp = (unsigned char*)G + (size_t)(row0 + ai * HALF + m * 16) * 3072 + col0;
#pragma unroll
                    for (int bj = 0; bj < 2; ++bj) { typedef unsigned u32x2q __attribute__((ext_vector_type(2))); u32x2q w; w.x = q4u8(sigm4(acc[ai][bj][m][0])); w.y = q4u8(sigm4(acc[ai][bj][m][1])); *(u32x2q*)(rowp + 32 * bj) = w; } }
        } else {
            const int t = u.pn >> 1; const int slot = (t == 0) ? 0 : (t == 4) ? 2 : (t < 4) ? t + 2 : t + 1; bf16_t* O = base + (size_t)slot * ((size_t)16384 * 512);     const int col0 = (u.pn & 1) * 256 + 64 * wc + 8 * fq;
            if (t == 0 || t == 1 || t == 4 || t == 5) {
                const int gi = (t == 0) ? 0 : (t == 1) ? 1 : (t == 4) ? 2 : 3; const float qs = (t == 0 || t == 4) ? EPI_C2 : 1.f;
                f32x4 gv[2][2];
#pragma unroll
                for (int bj = 0; bj < 2; ++bj)
#pragma unroll
                    for (int n = 0; n < 2; ++n) gv[bj][n] = *(const PG8_LAS f32x4*)(gain + gi * 64 + 32 * bj + 8 * fq + 4 * n) * qs;
#pragma unroll
                for (int ai = 0; ai < 2; ++ai) if (ai < u.nai)
#pragma unroll
                    for (int m = 0; m < 4; ++m) { bf16_t* rowp = O + (size_t)(row0 + ai * HALF + m * 16) * 512 + col0;
                        float ss = 0.f;
#pragma unroll
                        for (int bj = 0; bj < 2; ++bj)
#pragma unroll
                            for (int n = 0; n < 2; ++n) { const f32x4 x = acc[ai][bj][m][n]; ss += (x[0] * x[0] + x[1] * x[1]) + (x[2] * x[2] + x[3] * x[3]); }
                        ss += __shfl_xor(ss, 16); ss += __shfl_xor(ss, 32);
                        const float rstd = __builtin_amdgcn_rsqf(ss * (1.0f / 64.0f) + 1e-6f);
#pragma unroll
                        for (int bj = 0; bj < 2; ++bj) *(u32x4*)(rowp + 32 * bj) = pack8(acc[ai][bj][m][0] * rstd * gv[bj][0], acc[ai][bj][m][1] * rstd * gv[bj][1]); }
            } else {
#pragma unroll
                for (int ai = 0; ai < 2; ++ai) if (ai < u.nai)
#pragma unroll
                    for (int m = 0; m < 4; ++m) { bf16_t* rowp = O + (size_t)(row0 + ai * HALF + m * 16) * 512 + col0;
#pragma unroll
                        for (int bj = 0; bj < 2; ++bj) *(u32x4*)(rowp + 32 * bj) = pack8(acc[ai][bj][m][0], acc[ai][bj][m][1]); }
            }
        }
    }
};
struct EpiBranch {
    static constexpr bool PERM = true, AFTER_DRAIN = false;
    bf16_t* MG; const bf16_t* G;
    __device__ __forceinline__ void operator()(f32x4 (&acc)[2][2][4][2], const Unit& u, int wr, int wc, int fr, int fq) const {
        typedef unsigned u32x2q __attribute__((ext_vector_type(2)));
        const int n = u.pn >> 2, pc = u.pn & 3; const int row0 = u.pm * BM + wr * 64 + fr, col0 = pc * 256 + wc * 32 + 8 * fq;
        const int nn = (n < 2) ? n + 1 : n;
#pragma unroll
        for (int ai = 0; ai < 2; ++ai)
#pragma unroll
          for (int mp2 = 0; mp2 < 2; ++mp2) {
            u32x2q ga[2][2], gb[2][2];
#pragma unroll
            for (int q = 0; q < 2; ++q) { const int m = 2 * mp2 + q; const size_t row = (size_t)(row0 + ai * HALF + m * 16); const unsigned char* gp = (const unsigned char*)G + row * 3072 + col0;
#pragma unroll
                for (int bj = 0; bj < 2; ++bj) { ga[q][bj] = *(const u32x2q*)(gp + n * 1024 + bj * HALF); gb[q][bj] = *(const u32x2q*)(gp + nn * 1024 + bj * HALF); } }
            asm volatile("" : "+v"(ga[0][0]), "+v"(ga[0][1]), "+v"(ga[1][0]), "+v"(ga[1][1]), "+v"(gb[0][0]), "+v"(gb[0][1]), "+v"(gb[1][0]), "+v"(gb[1][1]));
#pragma unroll
            for (int q = 0; q < 2; ++q) { const int m = 2 * mp2 + q; const size_t row = (size_t)(row0 + ai * HALF + m * 16);
                if (n < 2) {
#pragma unroll
                    for (int bj = 0; bj < 2; ++bj) { const f32x4 d0 = dq4u8(gb[q][bj].x), d1 = dq4u8(gb[q][bj].y);
                        const f32x4 r0 = dq4u8(ga[q][bj].x) * (f32x4){__builtin_amdgcn_rcpf(d0[0]), __builtin_amdgcn_rcpf(d0[1]), __builtin_amdgcn_rcpf(d0[2]), __builtin_amdgcn_rcpf(d0[3])};
                        const f32x4 r1 = dq4u8(ga[q][bj].y) * (f32x4){__builtin_amdgcn_rcpf(d1[0]), __builtin_amdgcn_rcpf(d1[1]), __builtin_amdgcn_rcpf(d1[2]), __builtin_amdgcn_rcpf(d1[3])};
                        acc[ai][bj][m][0] *= r0; acc[ai][bj][m][1] *= r1; }
                } else { bf16_t* mp = MG + row * 1024 + col0;
#pragma unroll
                    for (int bj = 0; bj < 2; ++bj) *(u32x4*)(mp + bj * HALF) = pack8(dq4u8(ga[q][bj].x) * (acc[ai][bj][m][0] * (1.0f / 255.0f)), dq4u8(ga[q][bj].y) * (acc[ai][bj][m][1] * (1.0f / 255.0f))); } }
          }
    }
};
struct BranchOrder {
    static constexpr bool KEEP = true;
    StaticOrder S0;
    __device__ __forceinline__ bool next(int i, Unit& u) const { Unit t; if (!S0.next(i / 3, t)) return false; u.pm = t.pm; u.pn = 4 * (i % 3) + t.pn; u.roff = 0; u.nai = 2; return true; }
    __device__ __forceinline__ void a_ready(const Unit&) const {}
    __device__ __forceinline__ void done(const Unit&) const {}
};

template <class Epi, class Sched, bool ALIGN_EPI = false, bool SP2 = false>
__device__ __forceinline__ void gemm_phase(PG8_LAS unsigned char* lds, const Gemm g, const Sched& S, const Epi& E) {
    int tid_l = threadIdx.x; asm volatile("" : "+v"(tid_l));
    const int tid = tid_l, wid = __builtin_amdgcn_readfirstlane(tid >> 6), lane = tid & 63, wr = wid >> 2, wc = wid & 3, fr = lane & 15, fq = lane >> 4;
    const int K = g.K, nt = K / BK;
    unsigned voffA[2], voffB[2];
#pragma unroll
    for (int i = 0; i < 2; ++i) { int R, C; stage_rc(tid * 16 + i * 8192, R, C); const int Rb = Epi::PERM ? ((R & ~31) + perm32(R & 31)) : R;
        voffA[i] = (unsigned)(R * K + C) * 2u; voffB[i] = (unsigned)(Rb * K + C) * 2u; }
    const size_t kstep = (size_t)(BK * 2);
    const size_t hstep = (size_t)HALF * K * 2;
    const size_t tstep = 2 * hstep;
    const unsigned ldsw = (unsigned)wid * 1024u;
    const int aoff = lds_byte(wr * 64 + fr, fq * 8), boff = lds_byte(wc * 32 + fr, fq * 8);
#define PG8_SA(b, h) (((b) * 2 + (h)) * HTB)
#define PG8_SB(b, h) ((4 + (b) * 2 + (h)) * HTB)
#define PG8_STAGE(bufoff, gbase, voff) do { _Pragma("unroll") for (int _i = 0; _i < 2; ++_i) \
        __builtin_amdgcn_global_load_lds((const unsigned*)((const char*)(gbase) + (voff)[_i]), (PG8_LAS unsigned*)(lds + (bufoff) + ldsw + _i * 8192), 16, 0, 0); } while (0)
#define PG8_LDA(dst, b, h) do { _Pragma("unroll") for (int m = 0; m < 4; ++m) _Pragma("unroll") for (int k = 0; k < 2; ++k) dst[m][k] = *(const PG8_LAS bf16x8*)(lds + PG8_SA(b, h) + aoff + m * 2048 + k * 1024); } while (0)
#define PG8_LDB(dst, b, h) do { _Pragma("unroll") for (int n = 0; n < 2; ++n) _Pragma("unroll") for (int k = 0; k < 2; ++k) dst[n][k] = *(const PG8_LAS bf16x8*)(lds + PG8_SB(b, h) + boff + n * 2048 + k * 1024); } while (0)
#define PG8_MMA(ai, bj, At, Bt) do { __builtin_amdgcn_s_setprio(1); _Pragma("unroll") for (int m = 0; m < 4; ++m) _Pragma("unroll") for (int n = 0; n < 2; ++n) _Pragma("unroll") for (int k = 0; k < 2; ++k) \
        acc[ai][bj][m][n] = __builtin_amdgcn_mfma_f32_16x16x32_bf16(Bt[n][k], At[m][k], acc[ai][bj][m][n], 0, 0, 0); __builtin_amdgcn_s_setprio(0); } while (0)
#define PG8_WAIT_V(n) asm volatile("s_waitcnt vmcnt(" #n ")" ::: "memory")
#define PG8_WAIT_L(n) asm volatile("s_waitcnt lgkmcnt(" #n ")" ::: "memory")
#define PG8_BAR __builtin_amdgcn_s_barrier()
#define PG8_SCHED __builtin_amdgcn_sched_barrier(0)
    Unit cur, nxt; int ui = 0;
    if (!S.next(0, cur)) return;
    f32x4 acc[2][2][4][2];
#pragma unroll
    for (int a = 0; a < 2; ++a)
#pragma unroll
        for (int b = 0; b < 2; ++b)
#pragma unroll
            for (int m = 0; m < 4; ++m)
#pragma unroll
                for (int n = 0; n < 2; ++n) acc[a][b][m][n] = (f32x4){0.f, 0.f, 0.f, 0.f};
    bf16x8 At[4][2], B0[2][2], B1[2][2];
    const char* cA = (const char*)g.A + (size_t)(cur.pn / g.a_tiles) * g.a_stride + (size_t)cur.pm * tstep + (size_t)cur.roff * K * 2; const char* cB = (const char*)g.Bt + (size_t)cur.pn * tstep;
    S.a_ready(cur);
    if constexpr (SP2) {
        PG8_STAGE(PG8_SB(0, 0), cB, voffB); PG8_STAGE(PG8_SB(0, 1), cB + hstep, voffB); PG8_STAGE(PG8_SA(0, 0), cA, voffA); PG8_STAGE(PG8_SA(0, 1), cA + hstep, voffA);
        if (wr == 1) PG8_BAR;
        PG8_WAIT_V(2); PG8_BAR;
        PG8_STAGE(PG8_SB(1, 0), cB + kstep, voffB); PG8_STAGE(PG8_SA(1, 0), cA + kstep, voffA); PG8_STAGE(PG8_SB(1, 1), cB + hstep + kstep, voffB);
        PG8_WAIT_V(6); PG8_BAR;
    } else {
        PG8_STAGE(PG8_SB(0, 0), cB, voffB); PG8_STAGE(PG8_SA(0, 0), cA, voffA); PG8_STAGE(PG8_SB(0, 1), cB + hstep, voffB); PG8_STAGE(PG8_SA(0, 1), cA + hstep, voffA);
        if (wr == 1) PG8_BAR;
        PG8_WAIT_V(4); PG8_BAR;
        PG8_STAGE(PG8_SB(1, 0), cB + kstep, voffB); PG8_STAGE(PG8_SA(1, 0), cA + kstep, voffA); PG8_STAGE(PG8_SB(1, 1), cB + hstep + kstep, voffB);
        PG8_WAIT_V(6); PG8_BAR;
    }
    for (;;) {
        const bool has_next = S.next(ui + 1, nxt);
        const char* nA = has_next ? (const char*)g.A + (size_t)(nxt.pn / g.a_tiles) * g.a_stride + (size_t)nxt.pm * tstep + (size_t)nxt.roff * K * 2 : cA; const char* nB = has_next ? (const char*)g.Bt + (size_t)nxt.pn * tstep : cB;
        const bool full = (cur.nai == 2);
        for (int t = 0; t < nt; t += 2) {
            const bool last = (t == nt - 2);
            const char* a1 = cA + (size_t)(t + 1) * kstep;
            const char* a2 = last ? nA : cA + (size_t)(t + 2) * kstep; const char* b2 = last ? nB : cB + (size_t)(t + 2) * kstep;
            const char* a3 = a2 + kstep; const char* b3 = b2 + kstep;
            if (last && has_next) S.a_ready(nxt);
            if constexpr (SP2) {
            PG8_LDB(B0, 0, 0); PG8_LDB(B1, 0, 1); PG8_SCHED; PG8_LDA(At, 0, 0); PG8_STAGE(PG8_SA(1, 1), a1 + hstep, voffA);
            PG8_WAIT_V(8); PG8_WAIT_L(0); PG8_BAR; PG8_MMA(0, 0, At, B0); PG8_MMA(0, 1, At, B1); PG8_BAR; PG8_SCHED;
            if (full) PG8_LDA(At, 0, 1); PG8_STAGE(PG8_SB(0, 0), b2, voffB); PG8_STAGE(PG8_SB(0, 1), b2 + hstep, voffB); PG8_STAGE(PG8_SA(0, 0), a2, voffA);
            PG8_WAIT_V(8); PG8_WAIT_L(0); PG8_BAR; if (full) { PG8_MMA(1, 0, At, B0); PG8_MMA(1, 1, At, B1); } PG8_BAR; PG8_SCHED;
            PG8_LDB(B0, 1, 0); PG8_LDB(B1, 1, 1); PG8_SCHED; PG8_LDA(At, 1, 0); PG8_STAGE(PG8_SA(0, 1), a2 + hstep, voffA);
            PG8_WAIT_V(8); PG8_WAIT_L(0); PG8_BAR; PG8_MMA(0, 0, At, B0); PG8_MMA(0, 1, At, B1); PG8_BAR; PG8_SCHED;
            if (full) PG8_LDA(At, 1, 1); PG8_STAGE(PG8_SB(1, 0), b3, voffB); PG8_STAGE(PG8_SB(1, 1), b3 + hstep, voffB); PG8_STAGE(PG8_SA(1, 0), a3, voffA);
            PG8_WAIT_V(8); PG8_WAIT_L(0); PG8_BAR; if (full) { PG8_MMA(1, 0, At, B0); PG8_MMA(1, 1, At, B1); } PG8_BAR; PG8_SCHED;
            } else {
            PG8_LDB(B0, 0, 0); PG8_SCHED; PG8_LDA(At, 0, 0); PG8_STAGE(PG8_SA(1, 1), a1 + hstep, voffA);
            PG8_WAIT_L(8); PG8_BAR; PG8_WAIT_L(0); PG8_MMA(0, 0, At, B0); PG8_BAR; PG8_SCHED;
            PG8_LDB(B1, 0, 1); PG8_STAGE(PG8_SB(0, 0), b2, voffB);
            PG8_BAR; PG8_WAIT_L(0); PG8_MMA(0, 1, At, B1); PG8_BAR;
            PG8_LDA(At, 0, 1); PG8_STAGE(PG8_SA(0, 0), a2, voffA);
            PG8_BAR; PG8_WAIT_L(0); PG8_MMA(1, 0, At, B0); PG8_BAR; PG8_SCHED;
            PG8_STAGE(PG8_SB(0, 1), b2 + hstep, voffB);
            PG8_WAIT_V(6); PG8_BAR; PG8_MMA(1, 1, At, B1); PG8_BAR;
            PG8_LDB(B0, 1, 0); PG8_SCHED; PG8_LDA(At, 1, 0); PG8_STAGE(PG8_SA(0, 1), a2 + hstep, voffA);
            PG8_WAIT_L(8); PG8_BAR; PG8_WAIT_L(0); PG8_MMA(0, 0, At, B0); PG8_BAR; PG8_SCHED;
            PG8_LDB(B1, 1, 1); PG8_STAGE(PG8_SB(1, 0), b3, voffB);
            PG8_BAR; PG8_WAIT_L(0); PG8_MMA(0, 1, At, B1); PG8_BAR;
            PG8_LDA(At, 1, 1); PG8_STAGE(PG8_SA(1, 0), a3, voffA);
            PG8_BAR; PG8_WAIT_L(0); PG8_MMA(1, 0, At, B0); PG8_BAR; PG8_SCHED;
            PG8_STAGE(PG8_SB(1, 1), b3 + hstep, voffB);
            PG8_WAIT_V(6); PG8_BAR; PG8_MMA(1, 1, At, B1); PG8_BAR;
            }
        }
        if constexpr (ALIGN_EPI) { if (wr == 0) PG8_BAR; }
        if constexpr (!Epi::AFTER_DRAIN) { E(acc, cur, wr, wc, fr, fq); S.done(cur); }
        if (!has_next) break;
        if (!Sched::KEEP || (nxt.pn >> 2) == 0) {
#pragma unroll
        for (int a = 0; a < 2; ++a)
#pragma unroll
            for (int b = 0; b < 2; ++b)
#pragma unroll
                for (int m = 0; m < 4; ++m)
#pragma unroll
                    for (int n = 0; n < 2; ++n) acc[a][b][m][n] = (f32x4){0.f, 0.f, 0.f, 0.f};
        }
        cur = nxt; cA = nA; cB = nB; ++ui;
        if constexpr (ALIGN_EPI) { if (wr == 1) PG8_BAR; }
    }
    PG8_WAIT_V(0);
    if constexpr (!ALIGN_EPI) { if (wr == 0) PG8_BAR; }
    PG8_BAR;
    if constexpr (Epi::AFTER_DRAIN) { E.fused(acc, cur, wr, wc, fr, fq, lds, wid, lane); S.done(cur); }
#undef PG8_SA
#undef PG8_SB
#undef PG8_STAGE
#undef PG8_LDA
#undef PG8_LDB
#undef PG8_MMA
#undef PG8_WAIT_V
#undef PG8_WAIT_L
#undef PG8_BAR
#undef PG8_SCHED
}
}

#include <hip/hip_bf16.h>
#include <cmath>
namespace attn_body {
using bf16=__hip_bfloat16;
using bf16x8=__attribute__((ext_vector_type(8)))short;
using s16x4=__attribute__((ext_vector_type(4)))short;
using f32x16=__attribute__((ext_vector_type(16)))float;
using u32x4=__attribute__((ext_vector_type(4)))unsigned;
constexpr int BATCH=2,NHEAD=8,SEQ=8192,D=64,DM=NHEAD*D;
constexpr int NW=8,QBLK=32,QB=QBLK*NW,KVBLK=64,NQB=SEQ/QB;
constexpr int ATTN_PITCH=DM, ATTN_UNIT_ROWS=QB;
__device__ __forceinline__ int crow(int r,int hi){return (r&3)+8*(r>>2)+4*hi;}
#define SBAR() __builtin_amdgcn_sched_barrier(0)
__device__ __forceinline__ void cmask(f32x16&p0,f32x16&p1,int jb,int qrel,int hi){
  const float NEG=-INFINITY; int kb=64*jb+4*hi;
  #pragma unroll
  for(int r=0;r<16;++r){int kv=kb+(r&3)+8*(r>>2); if(kv>qrel)p0[r]=NEG; if(kv+32>qrel)p1[r]=NEG;}
}

constexpr int NSLOT=3, SLOTB=8192;
constexpr int LDS_K=0, LDS_V=NSLOT*SLOTB, LDS_WS=2*NSLOT*SLOTB, LDS_OST=LDS_WS+NW*64*4, LDS_BYTES=LDS_OST+NW*4096;
constexpr float C2=0.125f*1.4426950408889634f; constexpr float LOG2E=1.4426950408889634f; constexpr int TAB_OFF=86016, LDS_BYTES_ALL=TAB_OFF+32768+512; constexpr float NEGBIG=-30000.f;

typedef __attribute__((address_space(3))) float* lds_fptr;
typedef float f32x4a __attribute__((ext_vector_type(4)));
template<int MODE> __device__ __forceinline__ void hook(f32x16&p0,f32x16&p1,int t,int NT,int qrel,int hi,lds_fptr tab,int dbase,int ibase){
  if(MODE==0){
    const lds_fptr tb=tab+64*t+4*hi;
    #pragma unroll
    for(int g=0;g<4;++g){ const f32x4a a=*(const __attribute__((address_space(3))) f32x4a*)(tb+8*g); const f32x4a c=*(const __attribute__((address_space(3))) f32x4a*)(tb+32+8*g);
      p0[4*g+0]+=a.x;p0[4*g+1]+=a.y;p0[4*g+2]+=a.z;p0[4*g+3]+=a.w; p1[4*g+0]+=c.x;p1[4*g+1]+=c.y;p1[4*g+2]+=c.z;p1[4*g+3]+=c.w; }
    const int jb=t-(NT-4); if(jb>=0)cmask(p0,p1,jb,qrel,hi);
  } else {
    const int delta=dbase-t;
    if(delta<0||delta>8){
      #pragma unroll
      for(int r=0;r<16;++r){p0[r]=NEGBIG;p1[r]=NEGBIG;}
    } else if(delta>=3){ const float cf=tab[256];
      #pragma unroll
      for(int r=0;r<16;++r){p0[r]+=cf;p1[r]+=cf;}
    } else { const int ib=64*delta+ibase-4*hi;
      #pragma unroll
      for(int r=0;r<16;++r){ const int kc=(r&3)+8*(r>>2); int i0=ib-kc, i1=ib-32-kc; i0=i0>256?256:i0; i1=i1>256?256:i1; p0[r]+=tab[i0]; p1[r]+=tab[i1]; }
    }
  }
}
__device__ __forceinline__ void glds16(const void*gsrc,unsigned lds_dst){unsigned keep;
  asm volatile("s_mov_b32 %0, m0\n\ts_mov_b32 m0, %2\n\ts_nop 0\n\tglobal_load_lds_dwordx4 %1, off\n\ts_mov_b32 m0, %0":"=&s"(keep):"v"(gsrc),"s"(lds_dst):"memory");}
__device__ __forceinline__ float max3f(float a,float b,float c){float r;asm("v_max3_f32 %0, %1, %2, %3":"=v"(r):"v"(a),"v"(b),"v"(c));return r;}
__device__ __forceinline__ float max2f(float a,float b){float r;asm("v_max_f32_e32 %0, %1, %2":"=v"(r):"v"(a),"v"(b));return r;}
__device__ __forceinline__ float fadd_s(float a,float b){float r;asm("v_add_f32_e32 %0, %1, %2":"=v"(r):"v"(a),"v"(b));return r;}
__device__ __forceinline__ float fsub_s(float a,float b){float r;asm("v_sub_f32_e32 %0, %1, %2":"=v"(r):"v"(a),"v"(b));return r;}
typedef float f32x2_t __attribute__((ext_vector_type(2))); typedef __bf16 bf16x2_t __attribute__((ext_vector_type(2)));
__device__ __forceinline__ unsigned cvtpk_s(float lo,float hi){f32x2_t v={lo,hi};bf16x2_t b=__builtin_convertvector(v,bf16x2_t);return __builtin_bit_cast(unsigned,b);}
#define WAIT_BAR(N) asm volatile("s_waitcnt vmcnt(" #N ") lgkmcnt(0)\n\ts_barrier":::"memory")

__device__ __forceinline__ void qkt(f32x16&p0,f32x16&p1,const char*Kslot,const bf16x8*qr,const f32x16&negm,int r32,int hi){
  const char*kb=Kslot+hi*1024+r32*16;
  #pragma unroll
  for(int d0=0;d0<4;++d0){
    const bf16x8 b0=*reinterpret_cast<const bf16x8*>(kb+d0*2048);
    const bf16x8 b1=*reinterpret_cast<const bf16x8*>(kb+d0*2048+512);
    if(d0==0){p0=__builtin_amdgcn_mfma_f32_32x32x16_bf16(b0,qr[0],negm,0,0,0);p1=__builtin_amdgcn_mfma_f32_32x32x16_bf16(b1,qr[0],negm,0,0,0);}
    else{p0=__builtin_amdgcn_mfma_f32_32x32x16_bf16(b0,qr[d0],p0,0,0,0);p1=__builtin_amdgcn_mfma_f32_32x32x16_bf16(b1,qr[d0],p1,0,0,0);}}
}
typedef __attribute__((address_space(3))) const char* lds_cptr;
typedef short v4i16_t __attribute__((ext_vector_type(4)));
__device__ __forceinline__ void kload8(bf16x8*kf,lds_cptr kp){
  kf[0]=*(const __attribute__((address_space(3))) bf16x8*)(kp);      kf[1]=*(const __attribute__((address_space(3))) bf16x8*)(kp+512);
  kf[2]=*(const __attribute__((address_space(3))) bf16x8*)(kp+2048); kf[3]=*(const __attribute__((address_space(3))) bf16x8*)(kp+2560);
  kf[4]=*(const __attribute__((address_space(3))) bf16x8*)(kp+4096); kf[5]=*(const __attribute__((address_space(3))) bf16x8*)(kp+4608);
  kf[6]=*(const __attribute__((address_space(3))) bf16x8*)(kp+6144); kf[7]=*(const __attribute__((address_space(3))) bf16x8*)(kp+6656);
}
__device__ __forceinline__ void kload2(bf16x8*kf,lds_cptr kp,int j){ kf[2*j]=*(const __attribute__((address_space(3))) bf16x8*)(kp+j*2048); kf[2*j+1]=*(const __attribute__((address_space(3))) bf16x8*)(kp+j*2048+512); }
__device__ __forceinline__ s16x4 vtr(lds_cptr p){ return __builtin_bit_cast(s16x4,__builtin_amdgcn_ds_read_tr16_b64_v4i16((__attribute__((address_space(3))) v4i16_t*)p)); }
__device__ __forceinline__ float rowmax(const f32x16&p0,const f32x16&p1){
  float a=max3f(p0[0],p0[1],p1[0]),b=max3f(p0[2],p0[3],p1[1]);a=max3f(a,p1[2],p1[3]);
  #pragma unroll
  for(int r=4;r<16;r+=4){a=max3f(a,p0[r],p0[r+1]);b=max3f(b,p0[r+2],p0[r+3]);a=max3f(a,p1[r],p1[r+1]);b=max3f(b,p1[r+2],p1[r+3]);}
  const float m=max2f(a,b);
  auto rr=__builtin_amdgcn_permlane32_swap(__float_as_uint(m),__float_as_uint(m),false,false);
  return max2f(__uint_as_float(rr[0]),__uint_as_float(rr[1]));
}
__device__ __forceinline__ void pv(f32x16*o,int vb,bf16x8 pa0,bf16x8 pa1,bf16x8 pa2,bf16x8 pa3){
  #pragma unroll
  for(int d0=0;d0<2;++d0){s16x4 lo[4],hi[4];
    #pragma unroll
    for(int ks=0;ks<4;++ks){
      asm volatile("ds_read_b64_tr_b16 %0,%1 offset:%c2":"=&v"(lo[ks]):"v"(vb),"i"(d0*4096+ks*1024):"memory");
      asm volatile("ds_read_b64_tr_b16 %0,%1 offset:%c2":"=&v"(hi[ks]):"v"(vb),"i"(d0*4096+ks*1024+512):"memory");}
    asm volatile("s_waitcnt lgkmcnt(0)":::"memory");SBAR();
    #define PK(k) (bf16x8){lo[k][0],lo[k][1],lo[k][2],lo[k][3],hi[k][0],hi[k][1],hi[k][2],hi[k][3]}
    o[d0]=__builtin_amdgcn_mfma_f32_32x32x16_bf16(pa0,PK(0),o[d0],0,0,0);
    o[d0]=__builtin_amdgcn_mfma_f32_32x32x16_bf16(pa1,PK(1),o[d0],0,0,0);
    o[d0]=__builtin_amdgcn_mfma_f32_32x32x16_bf16(pa2,PK(2),o[d0],0,0,0);
    o[d0]=__builtin_amdgcn_mfma_f32_32x32x16_bf16(pa3,PK(3),o[d0],0,0,0);
    #undef PK
  }
}

#ifndef ATTN_STORE16
#define ATTN_STORE16(p,v) (*(u32x4*)(p)=(v))
#endif
template<int MODE,int THRL> __device__ __forceinline__ void attn_unit(int b,int h,int qb,const bf16*Q,const bf16*__restrict__ K,const bf16*__restrict__ V,bf16*O,char*shm,const float*aux0,const float*aux1,const float*aux2){
  int tid_l=threadIdx.x; asm volatile("":"+v"(tid_l)); const int tid=tid_l,lane=tid&63,r32=lane&31,hi=lane>>5; const int wid=__builtin_amdgcn_readfirstlane(tid>>6);
  const long rowbase=(long)b*SEQ; const int q0=qb*QB;
  const bf16*Qw=Q+(rowbase+q0+wid*QBLK)*DM+h*D;
  bf16x8 qr[4];
  #pragma unroll
  for(int d0=0;d0<4;++d0)qr[d0]=*reinterpret_cast<const bf16x8*>(&Qw[(long)r32*DM+d0*16+hi*8]);
  float cvk[16];
  int T0;
  if(MODE==1){ T0=(4*qb-8)>0?(4*qb-8):0; }
  else {
    const lds_fptr bp0=(lds_fptr)((lds_cptr)shm+TAB_OFF)+8192;
    const float*cum0=aux0+(long)(b*NHEAD+h)*SEQ; const int ntp=q0/KVBLK, nkeys0=q0+QB;
    #pragma unroll
    for(int u=0;u<16;++u){ const int jj=tid+512*u; cvk[u]=(jj<nkeys0)?cum0[jj]:0.f; }
    float gq=fabsf(aux2[128+lane]), gk=fabsf(aux2[192+lane]); const float cq0=cum0[q0];
    const float ce0=(lane<ntp)?cum0[64*lane+63]:0.f, ce1=(lane+64<ntp)?cum0[64*(lane+64)+63]:0.f;
    if(wid==0){ const float a=aux1[(b*128+lane)*32+h], c=aux1[(b*128+64+lane)*32+h]; float sa=a, sc=c;
      #pragma unroll
      for(int o=1;o<64;o<<=1){ const float ta=__shfl_up(sa,o), tc=__shfl_up(sc,o); if(lane>=o){sa+=ta;sc+=tc;} }
      const float tot=__shfl(sa,63); bp0[lane]=sa-a; bp0[64+lane]=tot+sc-c; }
    asm volatile("s_waitcnt vmcnt(0) lgkmcnt(0)\n\ts_barrier":::"memory");
    #pragma unroll
    for(int o=1;o<64;o<<=1){ gq=fmaxf(gq,__shfl_xor(gq,o)); gk=fmaxf(gk,__shfl_xor(gk,o)); }
    const float thr=-(cq0+bp0[q0>>6])*LOG2E-(2.05f*8.f*LOG2E*gq*gk+44.f);
    bool c0=false,c1=false;
    if(lane<ntp) c0=(-(ce0+bp0[lane])*LOG2E<thr);
    if(lane+64<ntp) c1=(-(ce1+bp0[lane+64])*LOG2E<thr);
    const int cnt=__popcll(__ballot(c0))+__popcll(__ballot(c1));
    T0=__builtin_amdgcn_readfirstlane(cnt&~1);
  }
  const bf16*Kh=K+(rowbase+(long)T0*KVBLK)*DM+h*D,*Vh=V+(rowbase+(long)T0*KVBLK)*DM+h*D;
  const unsigned lds0=(unsigned)(uintptr_t)shm;
  float*wsf=(float*)(shm+LDS_WS)+wid*64;
  const bf16*ksrc=Kh+(long)lane*DM+wid*8;
  const bf16*vsrc=Vh+(long)(16*(wid&3)+(lane>>2))*DM+(wid>>2)*32+(lane&3)*8;
  const unsigned kdst=lds0+LDS_K+wid*1024, vdst=lds0+LDS_V+wid*1024;
  #define DMA_K(t,slot) glds16(ksrc+(long)(t)*KVBLK*DM,(unsigned)__builtin_amdgcn_readfirstlane(kdst+(slot)))
  #define DMA_V(t,slot) glds16(vsrc+(long)(t)*KVBLK*DM,(unsigned)__builtin_amdgcn_readfirstlane(vdst+(slot)))
  const int vb0=(int)(lds0+LDS_V)+((lane>>4)&1)*32+(lane&3)*8+(4*hi+((lane&15)>>2))*64;
  const char*Kbase=shm+LDS_K; bf16x8 kf[8];
  const lds_cptr shm3=(lds_cptr)shm; const lds_cptr kp0=shm3+LDS_K+hi*1024+r32*16; const lds_cptr vp0=shm3+LDS_V+((lane>>4)&1)*32+(lane&3)*8+(4*hi+((lane&15)>>2))*64;
  const int NT=(q0+QB)/KVBLK-T0;
  const lds_fptr tab=(lds_fptr)(shm3+TAB_OFF);
  const int dbase=4*qb+(wid>>1)-T0, ibase=32*(wid&1)+r32+128; const lds_fptr tabh=(MODE==0)?tab+64*T0:tab;
  if(MODE==0){
    const lds_fptr bp=tab+8192;
    const int nkeys=q0+QB;
    #pragma unroll
    for(int u=0;u<16;++u){ const int jj=tid+512*u; if(jj>=64*T0&&jj<nkeys) tab[jj]=-(cvk[u]+bp[jj>>6])*LOG2E; }
  } else {
    if(tid<257) tab[tid]=aux0[tid]*LOG2E;
  }
  DMA_K(0,0);DMA_V(0,0);DMA_K(1,SLOTB);
  float mhat=0.f,l_reg=0.f;f32x16 o[2];o[0]=f32x16{};o[1]=f32x16{};f32x16 negm=f32x16{};asm volatile("":"+v"(negm));
  const int qrel=wid*QBLK+r32;
  #define CMASK(P0,P1,t) hook<MODE>(P0,P1,(t),NT,qrel,hi,tabh,dbase,ibase)
  bool resc=false;
  #define START(P0,P1) do{ const float rm=rowmax(P0,P1); resc=false; \
    { const float dl=rm; mhat=fadd_s(mhat,dl); \
      _Pragma("unroll") for(int r=0;r<16;++r){P0[r]=fsub_s(P0[r],dl);P1[r]=fsub_s(P1[r],dl);} \
      _Pragma("unroll") for(int r=0;r<16;++r)negm[r]=-mhat; asm volatile("":"+v"(negm)); } \
    _Pragma("unroll") for(int r=0;r<16;++r)P0[r]=__builtin_amdgcn_exp2f(P0[r]); }while(0)
  #define RESC() do{ if(resc){ asm volatile("s_waitcnt lgkmcnt(0)":::"memory"); \
      _Pragma("unroll") for(int d_=0;d_<2;++d_) _Pragma("unroll") for(int r=0;r<16;++r)o[d_][r]*=wsf[crow(r,hi)]; } }while(0)
  f32x16 pA0,pA1,pB0,pB1;
  int sl_prev=0,sl_cur=0,sl_next=SLOTB;
  #define ROT() do{sl_prev=sl_cur;sl_cur=sl_next;sl_next=(sl_next==(NSLOT-1)*SLOTB)?0:sl_next+SLOTB;}while(0)
  DMA_K(2,2*SLOTB);
  WAIT_BAR(3);
  qkt(pA0,pA1,Kbase,qr,negm,r32,hi);asm volatile("s_nop 15\n\ts_nop 7":"+v"(pA0),"+v"(pA1));CMASK(pA0,pA1,0);
  START(pA0,pA1);
  _Pragma("unroll") for(int r=0;r<16;++r)pA1[r]=__builtin_amdgcn_exp2f(pA1[r]);
  WAIT_BAR(0);
  DMA_K(3,0);DMA_V(1,SLOTB);
  ROT();
  kload8(kf,kp0+sl_cur);
  WAIT_BAR(2);
  s16x4 vlo[8],vhi[8]; u32x4 pw0,pw1,pw2,pw3;
  #define PKW(P,B) cvtpk_s(P[B],P[B+1])
  #define PAF(k) __builtin_bit_cast(bf16x8,pw##k)
  #define VFR(i) (bf16x8){vlo[i][0],vlo[i][1],vlo[i][2],vlo[i][3],vhi[i][0],vhi[i][1],vhi[i][2],vhi[i][3]}
  #define PIN(x) asm volatile("":"+v"(x))
  #define MX3(a,b,c) __builtin_fmaxf(__builtin_fmaxf((a),(b)),(c))
  #define GAPA(MF,A0,A1,A2,A3,W0,W1,PW) do{ MF; sacc+=A0; sacc+=A1; sacc+=A2; sacc+=A3; PIN(sacc); W0; W1; PIN(PW); SBAR(); }while(0)
  #define EX(v) __builtin_amdgcn_exp2f(v)
  #define GAPB(MF,X,B) do{ MF; X[B]=EX(X[B]); X[B+1]=EX(X[B+1]); X[B+2]=EX(X[B+2]); X[B+3]=EX(X[B+3]); PIN(X); SBAR(); }while(0)
  #define VRD(i) do{ vlo[i]=vtr(vp_+(((i)>>2)*4096+((i)&3)*1024)); vhi[i]=vtr(vp_+(((i)>>2)*4096+((i)&3)*1024+512)); }while(0)
  #define KRD(G,j) do{ if(G){ kload2(kf,kp0+sl_next,j); SBAR(); } }while(0)
  #define STEP(C0,C1,P0,P1,t,GK,GV,GL) do{ SBAR(); \
    const lds_cptr vp_=vp0+sl_prev; \
    VRD(0); SBAR(); float sacc=(P0[0]+P0[1]); \
    GAPA(C0=__builtin_amdgcn_mfma_f32_32x32x16_bf16(kf[0],qr[0],negm,0,0,0), P0[2],P0[3],P0[4],P0[5],     pw0[0]=PKW(P0,0), pw0[1]=PKW(P0,2), pw0); \
    VRD(4); SBAR(); GAPA(C1=__builtin_amdgcn_mfma_f32_32x32x16_bf16(kf[1],qr[0],negm,0,0,0), P0[6],P0[7],P0[8],P0[9],     pw0[2]=PKW(P0,4), pw0[3]=PKW(P0,6), pw0); \
    VRD(1); SBAR(); GAPA(C0=__builtin_amdgcn_mfma_f32_32x32x16_bf16(kf[2],qr[1],C0,0,0,0),   P0[10],P0[11],P0[12],P0[13], pw1[0]=PKW(P0,8), pw1[1]=PKW(P0,10), pw1); \
    VRD(5); SBAR(); GAPA(C1=__builtin_amdgcn_mfma_f32_32x32x16_bf16(kf[3],qr[1],C1,0,0,0),   P0[14],P0[15],P1[0],P1[1],   pw1[2]=PKW(P0,12),pw1[3]=PKW(P0,14), pw1); \
    VRD(2); SBAR(); GAPA(C0=__builtin_amdgcn_mfma_f32_32x32x16_bf16(kf[4],qr[2],C0,0,0,0),   P1[2],P1[3],P1[4],P1[5],     pw2[0]=PKW(P1,0), pw2[1]=PKW(P1,2), pw2); \
    VRD(6); SBAR(); GAPA(C1=__builtin_amdgcn_mfma_f32_32x32x16_bf16(kf[5],qr[2],C1,0,0,0),   P1[6],P1[7],P1[8],P1[9],     pw2[2]=PKW(P1,4), pw2[3]=PKW(P1,6), pw2); \
    VRD(3); SBAR(); GAPA(C0=__builtin_amdgcn_mfma_f32_32x32x16_bf16(kf[6],qr[3],C0,0,0,0),   P1[10],P1[11],P1[12],P1[13], pw3[0]=PKW(P1,8), pw3[1]=PKW(P1,10), pw3); \
    VRD(7); SBAR(); GAPA(C1=__builtin_amdgcn_mfma_f32_32x32x16_bf16(kf[7],qr[3],C1,0,0,0),   P1[14],P1[15],0.f,0.f,       pw3[2]=PKW(P1,12),pw3[3]=PKW(P1,14), pw3); \
    l_reg+=sacc; \
    if(GK){DMA_K((t)+3,sl_cur);} if(GV){DMA_V((t)+1,sl_next);} \
    CMASK(C0,C1,t); \
    { float a=MX3(C0[0],C0[1],C1[0]),b=MX3(C0[2],C0[3],C1[1]); a=MX3(a,C1[2],C1[3]); \
      _Pragma("unroll") for(int r=4;r<16;r+=4){a=MX3(a,C0[r],C0[r+1]);b=MX3(b,C0[r+2],C0[r+3]);a=MX3(a,C1[r],C1[r+1]);b=MX3(b,C1[r+2],C1[r+3]);} \
      float rm=__builtin_fmaxf(a,b); { auto rr=__builtin_amdgcn_permlane32_swap(__float_as_uint(rm),__float_as_uint(rm),false,false); rm=__builtin_fmaxf(__uint_as_float(rr[0]),__uint_as_float(rr[1])); } \
      resc=false; \
      if(__builtin_expect(__any(rm>(float)THRL),0)){ const float dl=__builtin_fmaxf(rm,0.f); mhat+=dl; \
        _Pragma("unroll") for(int r=0;r<16;++r){C0[r]-=dl;C1[r]-=dl;} \
        _Pragma("unroll") for(int r=0;r<16;++r)negm[r]=-mhat; asm volatile("":"+v"(negm)); \
        const float f=__builtin_amdgcn_exp2f(-dl); l_reg*=f; if(hi==0)wsf[r32]=f; resc=true; } } \
    SBAR(); \
    GAPB(o[0]=__builtin_amdgcn_mfma_f32_32x32x16_bf16(PAF(0),VFR(0),o[0],0,0,0), C0,0); \
    GAPB(o[1]=__builtin_amdgcn_mfma_f32_32x32x16_bf16(PAF(0),VFR(4),o[1],0,0,0), C0,4); \
    KRD(GL,0); GAPB(o[0]=__builtin_amdgcn_mfma_f32_32x32x16_bf16(PAF(1),VFR(1),o[0],0,0,0), C0,8); \
    KRD(GL,1); GAPB(o[1]=__builtin_amdgcn_mfma_f32_32x32x16_bf16(PAF(1),VFR(5),o[1],0,0,0), C0,12); \
    KRD(GL,2); GAPB(o[0]=__builtin_amdgcn_mfma_f32_32x32x16_bf16(PAF(2),VFR(2),o[0],0,0,0), C1,0); \
    KRD(GL,3); GAPB(o[1]=__builtin_amdgcn_mfma_f32_32x32x16_bf16(PAF(2),VFR(6),o[1],0,0,0), C1,4); \
    GAPB(o[0]=__builtin_amdgcn_mfma_f32_32x32x16_bf16(PAF(3),VFR(3),o[0],0,0,0), C1,8); \
    GAPB(o[1]=__builtin_amdgcn_mfma_f32_32x32x16_bf16(PAF(3),VFR(7),o[1],0,0,0), C1,12); \
    }while(0)
  int t=1;
  for(;t+5<NT;t+=2){
    STEP(pB0,pB1,pA0,pA1,t,true,true,true);     WAIT_BAR(2); RESC(); ROT();
    STEP(pA0,pA1,pB0,pB1,t+1,true,true,true);   WAIT_BAR(2); RESC(); ROT();
  }
  #define ENDW(tt) do{ if((tt)+3<NT){WAIT_BAR(2);} else if((tt)+2<NT){WAIT_BAR(1);} else {WAIT_BAR(0);} }while(0)
  for(;t+1<NT;t+=2){
    STEP(pB0,pB1,pA0,pA1,t,(t+3<NT),(t+1<NT),(t+1<NT));       ENDW(t);   RESC(); ROT();
    STEP(pA0,pA1,pB0,pB1,t+1,(t+4<NT),(t+2<NT),(t+2<NT));     ENDW(t+1); RESC(); ROT();
  }
  STEP(pB0,pB1,pA0,pA1,NT-1,false,false,false); RESC();
  { float sacc=pB0[0]+pB0[1]; _Pragma("unroll") for(int r=2;r<16;++r)sacc+=pB0[r]; _Pragma("unroll") for(int r=0;r<16;++r)sacc+=pB1[r]; l_reg+=sacc;
    pw0=(u32x4){PKW(pB0,0),PKW(pB0,2),PKW(pB0,4),PKW(pB0,6)};pw1=(u32x4){PKW(pB0,8),PKW(pB0,10),PKW(pB0,12),PKW(pB0,14)};pw2=(u32x4){PKW(pB1,0),PKW(pB1,2),PKW(pB1,4),PKW(pB1,6)};pw3=(u32x4){PKW(pB1,8),PKW(pB1,10),PKW(pB1,12),PKW(pB1,14)};
    SBAR(); pv(o,vb0+sl_cur,PAF(0),PAF(1),PAF(2),PAF(3)); }
  #undef PKW
  #undef PAF
  #undef VFR
  #undef PIN
  #undef MX3
  #undef GAPA
  #undef GAPB
  #undef EX
  #undef VRD
  #undef KRD
  #undef STEP
  #undef ENDW
  {auto rr=__builtin_amdgcn_permlane32_swap(__float_as_uint(l_reg),__float_as_uint(l_reg),false,false);l_reg=__uint_as_float(rr[0])+__uint_as_float(rr[1]);}
  if(hi==0)wsf[32+r32]=l_reg;asm volatile("s_waitcnt lgkmcnt(0)":::"memory");
  float rli[16];
  #pragma unroll
  for(int r=0;r<16;++r)rli[r]=__builtin_amdgcn_rcpf(wsf[32+crow(r,hi)]);
  bf16*Ow=O+(rowbase+q0+wid*QBLK)*DM+h*D;
  { bf16*stg=(bf16*)(shm+LDS_OST)+wid*2048;
    #pragma unroll
    for(int r=0;r<16;++r){const int orow=crow(r,hi);
      #pragma unroll
      for(int d0=0;d0<2;++d0)stg[orow*64+d0*32+r32]=__float2bfloat16(o[d0][r]*rli[r]);}
    asm volatile("s_waitcnt lgkmcnt(0)":::"memory");
    #pragma unroll
    for(int i=0;i<4;++i){const int row=i*8+(lane>>3),ch=lane&7; const u32x4 v=*(const u32x4*)(stg+row*64+ch*8); ATTN_STORE16(Ow+(long)row*DM+ch*8,v);} }
  asm volatile("s_waitcnt lgkmcnt(0)\n\ts_barrier":::"memory");
  #undef DMA_K
  #undef DMA_V
  #undef CMASK
  #undef START
  #undef RESC
  #undef ROT
}
constexpr int ATTN_LDS_BYTES=LDS_BYTES_ALL;
#undef SBAR
#undef WAIT_BAR
}

constexpr int NWAVES = 8;
constexpr int M = 16384, D = 1024, FF = 2816, NGU = 5632, NIN = 6656, DIN = 6664, SEQ = 8192;
constexpr size_t MiB = 1u << 20;
constexpr size_t WS_MOD = 0;
constexpr size_t WS_WF = 256 * 1024;
constexpr size_t WS_BT = 320 * 1024;
constexpr size_t WS_CTL = 1536 * 1024, CTL_ZERO_BYTES = 131072;
constexpr size_t WS_XBUF = WS_CTL + 131072;
constexpr size_t WS_CUM = 1 * MiB;
constexpr size_t WS_WGU = 2 * MiB;
constexpr size_t WS_WD = WS_WGU + 22 * MiB;
constexpr size_t WS_WIN = WS_WD + 11 * MiB;
constexpr size_t WS_WBR = WS_WIN + 13 * MiB;
constexpr size_t WS_WO = WS_WBR + 3 * MiB;
constexpr size_t WS_XN = 54 * MiB;
constexpr size_t WS_BIG = 86 * MiB;
constexpr size_t SLOT = 16 * MiB;
constexpr size_t WS_G = WS_BIG + 8 * SLOT;
constexpr size_t WS_MG = WS_BIG + 3 * SLOT;
constexpr size_t WS_END = WS_G + 96 * MiB;
static_assert(WS_WO + 2 * MiB <= WS_XN, "weights fit");
constexpr int LDS_BYTES = 147456;

#define LAS __attribute__((address_space(3)))
typedef unsigned short bf16;
typedef unsigned v4u __attribute__((ext_vector_type(4)));
typedef float f32x4 __attribute__((ext_vector_type(4)));
#define LDS_WAIT() asm volatile("s_waitcnt lgkmcnt(0)" ::: "memory")
__device__ __forceinline__ unsigned f2bf(float f) { unsigned u = __builtin_bit_cast(unsigned, f); return (u + 0x7fffu + ((u >> 16) & 1u)) >> 16; }
__device__ __forceinline__ unsigned pk2(float lo, float hi) { return f2bf(lo) | (f2bf(hi) << 16); }
__device__ __forceinline__ float wave_sum(float v) {
#pragma unroll
    for (int o = 1; o < 64; o <<= 1) v += __shfl_xor(v, o);
    return v;
}
__device__ __forceinline__ float silu_f(float x) { return x / (1.0f + __expf(-x)); }

__device__ __forceinline__ void transpose_item(const float* __restrict__ W, int ldw, int k0, int c0, bf16* WT, int K, int drow0, LAS float* scr, int lane) {
    { const int kr = lane >> 3, n4 = lane & 7;
      f32x4 v[8];
#pragma unroll
      for (int i = 0; i < 8; ++i) v[i] = *(const f32x4*)(W + (size_t)(k0 + 8 * i + kr) * ldw + c0 + 4 * n4);
#pragma unroll
      for (int i = 0; i < 8; ++i) { LAS float* p = scr + (8 * i + kr) * 33 + 4 * n4; p[0] = v[i].x; p[1] = v[i].y; p[2] = v[i].z; p[3] = v[i].w; } }
    LDS_WAIT(); asm volatile("" ::: "memory");
    const int c = lane & 7;
#pragma unroll
    for (int j = 0; j < 4; ++j) { const int n = (lane >> 3) + 8 * j; const LAS float* s = scr + (8 * c) * 33 + n;
        v4u o; o.x = pk2(s[0 * 33], s[1 * 33]); o.y = pk2(s[2 * 33], s[3 * 33]); o.z = pk2(s[4 * 33], s[5 * 33]); o.w = pk2(s[6 * 33], s[7 * 33]);
        *(v4u*)(WT + (size_t)(drow0 + n) * K + k0 + 8 * c) = o; }
    LDS_WAIT(); asm volatile("" ::: "memory");
}

#define XB_TMO      128
#define XB_XCNT(j)  (256  + 64 * (j))
#define XB_XSUB(j)  (1280 + 64 * (j))
#define XB_XGEN(j)  (2304 + 64 * (j))
#define XB_TOP      3328
#define XB_TOPGEN   3392
#define XCD_BAR_WORDS 3456
#define XB_SPIN_CAP (1u << 18)

__device__ __forceinline__ unsigned xb_ld(unsigned* p)              { return __hip_atomic_load(p, __ATOMIC_RELAXED, __HIP_MEMORY_SCOPE_AGENT); }
__device__ __forceinline__ unsigned xb_add(unsigned* p, unsigned v) { return __hip_atomic_fetch_add(p, v, __ATOMIC_RELAXED, __HIP_MEMORY_SCOPE_AGENT); }
__device__ __forceinline__ unsigned xb_xcc_id() { return (unsigned)__builtin_amdgcn_s_getreg((3 << 11) | 20) & 0xFu; }
#define XB_SPIN(cond, bar) do { unsigned _sp = 0; while (cond) { __builtin_amdgcn_s_sleep(1); \
    if ((++_sp & 255u) == 0u) { if (xb_ld(&(bar)[XB_TMO])) break; if (_sp > XB_SPIN_CAP) { atomicAdd(&(bar)[XB_TMO], 1u); break; } } } } while (0)

struct XcdBarrier {
    unsigned* bar; unsigned x;
    volatile LAS unsigned* st;
};

__device__ __forceinline__ XcdBarrier xcd_barrier_post(unsigned* bar, volatile LAS unsigned* st) {
    XcdBarrier b; b.bar = bar; b.x = xb_xcc_id(); b.st = st;
    if (threadIdx.x == 0) (void)xb_add(&bar[XB_XCNT(b.x)], 1u);
    return b;
}
__device__ __forceinline__ void xcd_barrier_complete(unsigned* bar, unsigned x, unsigned& nloc, unsigned& nx) {
    const unsigned G = gridDim.x * gridDim.y * gridDim.z;
    unsigned sum, cnt, mine, sp = 0u;
    for (;;) {
        sum = 0u; cnt = 0u; mine = 0u;
#pragma unroll
        for (unsigned j = 0; j < 16; ++j) { const unsigned c = xb_ld(&bar[XB_XCNT(j)]); sum += c; cnt += (c > 0u) ? 1u : 0u; mine = (j == x) ? c : mine; }
        if (sum == G) break;
        __builtin_amdgcn_s_sleep(1);
        if ((++sp & 255u) == 0u) { if (xb_ld(&bar[XB_TMO])) break; if (sp > XB_SPIN_CAP) { atomicAdd(&bar[XB_TMO], 1u); break; } }
    }
    nloc = mine > 0u ? mine : 1u; nx = cnt > 0u ? cnt : 1u;
}

__device__ __forceinline__ void xcd_barrier(const XcdBarrier& b) {
    asm volatile("s_waitcnt vmcnt(0)" ::: "memory");
    __syncthreads();
    if (threadIdx.x == 0) {
        unsigned* bar = b.bar;
        __builtin_amdgcn_s_waitcnt(0);
        unsigned nloc = b.st[0], nx = b.st[1];
        if (nloc == 0u) { xcd_barrier_complete(bar, b.x, nloc, nx); b.st[0] = nloc; b.st[1] = nx; }
        const unsigned old = xb_add(&bar[XB_XSUB(b.x)], 1u);
        const unsigned gen = old / nloc;
        if (old + 1u == (gen + 1u) * nloc) {
            __builtin_amdgcn_fence(__ATOMIC_RELEASE, "agent");
            asm volatile("s_waitcnt vmcnt(0)" ::: "memory");
            const unsigned og = xb_add(&bar[XB_TOP], 1u);
            const unsigned tg = og / nx;
            if (og + 1u == (tg + 1u) * nx) xb_add(&bar[XB_TOPGEN], 1u);
            else XB_SPIN(xb_ld(&bar[XB_TOPGEN]) == tg, bar);
            __builtin_amdgcn_fence(__ATOMIC_ACQUIRE, "agent");
            xb_add(&bar[XB_XGEN(b.x)], 1u);
            asm volatile("s_waitcnt vmcnt(0)" ::: "memory");
        } else {
            XB_SPIN(xb_ld(&bar[XB_XGEN(b.x)]) == gen, bar);
            __builtin_amdgcn_fence(__ATOMIC_ACQUIRE, "agent");
            asm volatile("s_waitcnt vmcnt(0)" ::: "memory");
        }
    }
    __syncthreads();
}

struct Args { const float* in[16]; float* out; unsigned char* ws; int cg_seam, pad; };
__device__ __forceinline__ const float* argp(int i) { auto ka = __builtin_amdgcn_kernarg_segment_ptr(); const __attribute__((address_space(1))) float* r; asm volatile("s_load_dwordx2 %0, %1, %2\n\ts_waitcnt lgkmcnt(0)" : "=s"(r) : "s"(ka), "i"(i * 8) : "memory"); return (const float*)r; }
#define ARG_IN(i) argp(i)
#define ARG_OUT ((float*)argp(16))
#define ARG_WS ((unsigned char*)argp(17))
__device__ __forceinline__ int arg_cg_seam() { auto ka = __builtin_amdgcn_kernarg_segment_ptr(); int r; asm volatile("s_load_dword %0, %1, 144\n\ts_waitcnt lgkmcnt(0)" : "=s"(r) : "s"(ka) : "memory"); return r; }

__device__ __forceinline__ void mod_phase(int j0, int j1, LAS unsigned char* lds, int vcu, int G, int tid, int wave, int lane) {
    unsigned char* ws_ = ARG_WS; float* MOD = (float*)(ws_ + WS_MOD); const float* c = ARG_IN(1); const float* w_ada = ARG_IN(2); const float* b_ada = ARG_IN(3);
    LAS float* part = (LAS float*)lds;
    for (int job = j0 + vcu; job < j1; job += G) {
        const int lm = job / 144, colbase = (job % 144) * 64, kk = lane >> 4, c4 = lane & 15;
        f32x4 acc0 = {0.f, 0.f, 0.f, 0.f}, acc1 = {0.f, 0.f, 0.f, 0.f};
        const float* wp = w_ada + ((size_t)lm * 1024 + wave * 128 + kk) * 9216 + colbase + 4 * c4;
#pragma unroll 8
        for (int i = 0; i < 32; ++i) { const int k = wave * 128 + 4 * i + kk; const f32x4 wv = *(const f32x4*)(wp + (size_t)i * 4 * 9216); const float a0 = silu_f(c[k]), a1 = silu_f(c[1024 + k]); acc0 += a0 * wv; acc1 += a1 * wv; }
#pragma unroll
        for (int e = 0; e < 4; ++e) { acc0[e] += __shfl_xor(acc0[e], 16); acc0[e] += __shfl_xor(acc0[e], 32); acc1[e] += __shfl_xor(acc1[e], 16); acc1[e] += __shfl_xor(acc1[e], 32); }
        if (kk == 0) { *(LAS f32x4*)(part + (wave * 2 + 0) * 64 + 4 * c4) = acc0; *(LAS f32x4*)(part + (wave * 2 + 1) * 64 + 4 * c4) = acc1; }
        __syncthreads();
        if (tid < 128) { const int b = tid >> 6, col = tid & 63; float s = b_ada[lm * 9216 + colbase + col];
#pragma unroll
          for (int w = 0; w < 8; ++w) s += part[(w * 2 + b) * 64 + col];
          MOD[(size_t)(lm * 2 + b) * 9216 + colbase + col] = s; }
        __syncthreads();
    }
}

__device__ __forceinline__ void weights_phase(int l, LAS unsigned char* lds, int vcu, int G, int wave, int lane) {
    LAS float* scr = (LAS float*)(lds + wave * 16384); unsigned char* ws_ = ARG_WS;
    bf16* WGU = (bf16*)(ws_ + WS_WGU); bf16* WD = (bf16*)(ws_ + WS_WD); bf16* WIN = (bf16*)(ws_ + WS_WIN); bf16* WBR = (bf16*)(ws_ + WS_WBR); bf16* WO = (bf16*)(ws_ + WS_WO);
    constexpr int IT_EFF = 1024, IT_GU = 2 * 2 * 16 * 88, IT_DN = 2 * 44 * 32, IT_IN = 16 * 208, IT_BR = 2 * 8 * 32, IT_WO = 16 * 32, IT_WF = 128, NITEMS = IT_EFF + IT_GU + IT_DN + IT_IN + IT_BR + IT_WO + IT_WF;
    const int gw = vcu * NWAVES + wave, NGW = G * NWAVES;
    for (int it = gw; it < NITEMS; it += NGW) {
        int r = it;
        if (r < IT_EFF) {
            const int cblk = r & 127, kh = (r >> 7) & 1, g = r >> 8, ci = kh * 64 + lane;
            const float* wp = ARG_IN(12) + ((size_t)(l * 4 + g) * 128 + ci) * 128; const float* ps = ARG_IN(13) + l * 512 + g * 128;
            const float* wb = ARG_IN(14) + ((size_t)(l * 3 + 1) * 512 + g * 128) * 1024 + cblk * 8;
            f32x4 a0 = {0.f, 0.f, 0.f, 0.f}, a1 = {0.f, 0.f, 0.f, 0.f};
#pragma unroll 16
            for (int e = 0; e < 128; ++e) { const float cf = wp[e] * ps[e]; a0 += cf * *(const f32x4*)(wb + (size_t)e * 1024); a1 += cf * *(const f32x4*)(wb + (size_t)e * 1024 + 4); }
            bf16* dst = WBR + (size_t)(1024 + cblk * 8) * 512 + g * 128 + ci;
            dst[0 * 512] = (bf16)f2bf(a0.x); dst[1 * 512] = (bf16)f2bf(a0.y); dst[2 * 512] = (bf16)f2bf(a0.z); dst[3 * 512] = (bf16)f2bf(a0.w);
            dst[4 * 512] = (bf16)f2bf(a1.x); dst[5 * 512] = (bf16)f2bf(a1.y); dst[6 * 512] = (bf16)f2bf(a1.z); dst[7 * 512] = (bf16)f2bf(a1.w);
        } else if ((r -= IT_EFF) < IT_GU) { const int j = r / 2816; r %= 2816; const int isup = r / 1408; r %= 1408; const int kb = r / 88, nb = r % 88, f0 = 32 * nb;
            const float* src = (isup ? ARG_IN(6) : ARG_IN(5)) + (size_t)(l * 2 + j) * 1024 * 2816;
            transpose_item(src, 2816, 64 * kb, f0, WGU + (size_t)j * NGU * 1024, 1024, 256 * (f0 >> 7) + 128 * isup + (f0 & 127), scr, lane);
        } else if ((r -= IT_GU) < IT_DN) { const int j = r / 1408; r %= 1408; const int kb = r / 32, nb = r % 32;
            transpose_item(ARG_IN(7) + (size_t)(l * 2 + j) * 2816 * 1024, 1024, 64 * kb, 32 * nb, WD + (size_t)j * 1024 * 2816, 2816, 32 * nb, scr, lane);
        } else if ((r -= IT_DN) < IT_IN) { const int kb = r / 208, nb = r % 208, L0 = 32 * nb, c0 = L0 < 3584 ? L0 : L0 + 8, pn = L0 >> 8, w = L0 & 255, hh = w >> 6, dh = (w >> 5) & 1;
            transpose_item(ARG_IN(8) + (size_t)l * 1024 * DIN, DIN, 64 * kb, c0, WIN, 1024, 256 * pn + 128 * dh + 32 * hh, scr, lane);
        } else if ((r -= IT_IN) < IT_BR) { const int n = (r / 256) * 2; r %= 256; const int kb = r / 32, nb = r % 32;
            transpose_item(ARG_IN(14) + (size_t)(l * 3 + n) * 512 * 1024, 1024, 64 * kb, 32 * nb, WBR, 512, n * 1024 + 32 * nb, scr, lane);
        } else if ((r -= IT_BR) < IT_WO) { const int kb = r / 32, nb = r % 32; transpose_item(ARG_IN(15) + (size_t)l * 1024 * 1024, 1024, 64 * kb, 32 * nb, WO, 1024, 32 * nb, scr, lane);
        } else { r -= IT_WO; float* WF = (float*)(ws_ + WS_WF); const int i = r * 64 + lane, hh = i >> 10, k = i & 1023; WF[i] = (ARG_IN(8) + (size_t)l * 1024 * DIN)[(size_t)k * DIN + 3584 + hh]; }
    }
}

__device__ __forceinline__ float log_sigmoid_f(float x) { return fminf(x, 0.f) - log1pf(__expf(-fabsf(x))); }

template <bool MIX>
__device__ __forceinline__ void norm_phase(const float* xin, int l, int sub, LAS unsigned char* lds, int vcu, int G, int tid, int wave, int lane) {
    unsigned char* ws_ = ARG_WS; const float* gain = ARG_IN(4) + (size_t)(l * 3 + sub) * 1024; const float* MOD = (const float*)(ws_ + WS_MOD);
    const float* shift = MOD + (size_t)(l * 2) * 9216 + (3 * sub) * 1024; const float* scale = shift + 1024;
    bf16* XN = (bf16*)(ws_ + WS_XN);
    LAS float* wfs = (LAS float*)lds; LAS float* lfs = (LAS float*)(lds + 32768);
    if (MIX) { const float* WF = (const float*)(ws_ + WS_WF); for (int i = tid; i < 8192; i += 512) wfs[i] = WF[i]; __syncthreads(); }
    for (int blk = vcu; blk < 256; blk += G) {
        const int b = blk >> 7;
#pragma unroll (MIX ? 2 : 4)
        for (int i = 0; i < 8; ++i) { const int rl = wave * 8 + i, row = blk * 64 + rl;
            const f32x4* xr = (const f32x4*)(xin + (size_t)row * 1024) + lane;
            f32x4 v[4]; float ss = 0.f;
#pragma unroll
            for (int j = 0; j < 4; ++j) { v[j] = xr[64 * j]; ss += (v[j].x * v[j].x + v[j].y * v[j].y) + (v[j].z * v[j].z + v[j].w * v[j].w); }
            const float rstd = 1.0f / sqrtf(wave_sum(ss) * (1.0f / 1024.0f) + 1e-6f);
            unsigned long long* o8 = (unsigned long long*)(XN + (size_t)row * 1024) + lane;
#pragma unroll
            for (int j = 0; j < 4; ++j) { const f32x4 g = ((const f32x4*)gain)[64 * j + lane], sc = ((const f32x4*)(scale + b * 9216))[64 * j + lane], sh = ((const f32x4*)(shift + b * 9216))[64 * j + lane];
                v[j] = (v[j] * rstd * g) * (1.0f + sc) + sh;
                o8[64 * j] = (unsigned long long)pk2(v[j].x, v[j].y) | ((unsigned long long)pk2(v[j].z, v[j].w) << 32); }
            if (MIX) { float keep = 0.f;
#pragma unroll
                for (int hh = 0; hh < 8; ++hh) { float p = 0.f;
#pragma unroll
                    for (int j = 0; j < 4; ++j) { const f32x4 w = *(const LAS f32x4*)(wfs + hh * 1024 + 4 * (64 * j + lane)); p += (v[j].x * w.x + v[j].y * w.y) + (v[j].z * w.z + v[j].w * w.w); }
                    p = wave_sum(p); keep = (lane == hh) ? p : keep; }
                if (lane < 8) lfs[rl * 8 + lane] = log_sigmoid_f(keep + ARG_IN(11)[l * 8 + lane]); }
        }
        if (MIX) { __syncthreads();
            float* CUM = (float*)(ws_ + WS_CUM); float* BT = (float*)(ws_ + WS_BT);
            float s = lfs[lane * 8 + wave];
#pragma unroll
            for (int o = 1; o < 64; o <<= 1) { const float t = __shfl_up(s, o); if (lane >= o) s += t; }
            CUM[(size_t)(b * 8 + wave) * SEQ + (blk & 127) * 64 + lane] = s; if (lane == 63) BT[blk * 32 + wave] = s;
            __syncthreads(); }
    }
}

__device__ __forceinline__ void f_phase(int l, LAS unsigned char* lds, int vcu, int G, int tid, int wave, int lane) {
    unsigned char* ws_ = ARG_WS; const bf16* XN = (const bf16*)(ws_ + WS_XN); const float* fb = ARG_IN(11) + l * 8;
    LAS float* wfs = (LAS float*)lds; LAS float* lfs = (LAS float*)(lds + 32768);
    { const float* WF = (const float*)(ws_ + WS_WF); for (int i = tid; i < 8192; i += 512) wfs[i] = WF[i]; __syncthreads(); }
    for (int blk = vcu; blk < 256; blk += G) {
        const int b = blk >> 7;
#pragma unroll 2
        for (int i = 0; i < 8; ++i) { const int rl = wave * 8 + i, row = blk * 64 + rl;
            const v4u* xr = (const v4u*)(XN + (size_t)row * 1024) + lane;
            const v4u a = xr[0], c = xr[64];
            const f32x4 h0 = {__uint_as_float(a.x << 16), __uint_as_float(a.x & 0xffff0000u), __uint_as_float(a.y << 16), __uint_as_float(a.y & 0xffff0000u)};
            const f32x4 h1 = {__uint_as_float(a.z << 16), __uint_as_float(a.z & 0xffff0000u), __uint_as_float(a.w << 16), __uint_as_float(a.w & 0xffff0000u)};
            const f32x4 h2 = {__uint_as_float(c.x << 16), __uint_as_float(c.x & 0xffff0000u), __uint_as_float(c.y << 16), __uint_as_float(c.y & 0xffff0000u)};
            const f32x4 h3 = {__uint_as_float(c.z << 16), __uint_as_float(c.z & 0xffff0000u), __uint_as_float(c.w << 16), __uint_as_float(c.w & 0xffff0000u)};
            float keep = 0.f;
#pragma unroll
            for (int hh = 0; hh < 8; ++hh) { const LAS f32x4* w = (const LAS f32x4*)(wfs + hh * 1024 + 8 * lane);
                const f32x4 w0 = w[0], w1 = w[1], w2 = w[128], w3 = w[129];
                float p = ((h0.x * w0.x + h0.y * w0.y) + (h0.z * w0.z + h0.w * w0.w)) + ((h1.x * w1.x + h1.y * w1.y) + (h1.z * w1.z + h1.w * w1.w))
                        + ((h2.x * w2.x + h2.y * w2.y) + (h2.z * w2.z + h2.w * w2.w)) + ((h3.x * w3.x + h3.y * w3.y) + (h3.z * w3.z + h3.w * w3.w));
                p = wave_sum(p); keep = (lane == hh) ? p : keep; }
            if (lane < 8) lfs[rl * 8 + lane] = log_sigmoid_f(keep + fb[lane]); }
        __syncthreads();
        { float* CUM = (float*)(ws_ + WS_CUM); float* BT = (float*)(ws_ + WS_BT);
          float s = lfs[lane * 8 + wave];
#pragma unroll
          for (int o = 1; o < 64; o <<= 1) { const float t = __shfl_up(s, o); if (lane >= o) s += t; }
          CUM[(size_t)(b * 8 + wave) * SEQ + (blk & 127) * 64 + lane] = s; if (lane == 63) BT[blk * 32 + wave] = s; }
        __syncthreads();
    }
}

__device__ __forceinline__ void pool_phase(const bf16* UB, bf16* DD, int vcu, int G, int tid) {
    for (int blk = vcu; blk < 256; blk += G) {
        const int t0 = (blk & 127) * 64, ch = (tid & 63) * 8, w = 2 << (ch >> 7);
        for (int i = 0; i < 8; ++i) { const int rl = (tid >> 6) + 8 * i, t = t0 + rl; const size_t row = (size_t)blk * 64 + rl; const int cnt = (t + 1 < w) ? t + 1 : w;
            float s[8], cur[8];
#pragma unroll
            for (int e = 0; e < 8; ++e) { s[e] = 0.f; cur[e] = 0.f; }
#pragma unroll
            for (int q = 0; q < 16; ++q) if (q < cnt) { const v4u u = *(const v4u*)(UB + (row - q) * 512 + ch);
                const float f[8] = {__uint_as_float(u.x << 16), __uint_as_float(u.x & 0xffff0000u), __uint_as_float(u.y << 16), __uint_as_float(u.y & 0xffff0000u), __uint_as_float(u.z << 16), __uint_as_float(u.z & 0xffff0000u), __uint_as_float(u.w << 16), __uint_as_float(u.w & 0xffff0000u)};
#pragma unroll
                for (int e = 0; e < 8; ++e) { s[e] += f[e]; if (q == 0) cur[e] = f[e]; } }
            const float inv = 1.0f / (float)cnt; v4u o;
            o.x = pk2(s[0] * inv - cur[0], s[1] * inv - cur[1]); o.y = pk2(s[2] * inv - cur[2], s[3] * inv - cur[3]); o.z = pk2(s[4] * inv - cur[4], s[5] * inv - cur[5]); o.w = pk2(s[6] * inv - cur[6], s[7] * inv - cur[7]);
            *(v4u*)(DD + row * 512 + ch) = o; }
    }
}

__global__ void __launch_bounds__(NWAVES * 64, 2) mk_fwd(Args) {
    extern __shared__ __attribute__((aligned(16))) unsigned char lds_raw[];
    cg::grid_group grid = cg::this_grid();
    LAS unsigned char* lds = (LAS unsigned char*)lds_raw;
    const int tid = threadIdx.x, lane = tid & 63, wave = __builtin_amdgcn_readfirstlane(tid >> 6);
    const int G = gridDim.x, bx = blockIdx.x, vcu = (G % 8 == 0) ? (bx % 8) * (G / 8) + bx / 8 : bx;
    constexpr size_t SLOT_E = (size_t)M * 512;
    constexpr int NOSPLIT = 1 << 30;
    typedef pg8::bf16_t pbf;
#define CG_SYNC() do { asm volatile("s_waitcnt vmcnt(0) lgkmcnt(0)" ::: "memory"); __syncthreads(); grid.sync(); __builtin_amdgcn_fence(__ATOMIC_ACQUIRE, "agent"); asm volatile("s_waitcnt vmcnt(0)" ::: "memory"); __syncthreads(); } while (0)
#define GRID_SYNC() do { asm volatile("s_waitcnt lgkmcnt(0)" ::: "memory"); XcdBarrier b_; b_.bar = (unsigned*)(ARG_WS + WS_CTL); b_.x = xb_xcc_id(); b_.st = (volatile LAS unsigned*)(lds + 131072 + 256); xcd_barrier(b_); } while (0)
#define FRESH() int G_ = G, bx_ = bx, vcu_ = vcu, tid_ = tid; asm volatile("" : "+s"(G_), "+s"(bx_), "+s"(vcu_), "+v"(tid_)); const int lane_ = tid_ & 63; (void)lane_; (void)bx_
    volatile LAS unsigned* bst = (volatile LAS unsigned*)(lds + 131072 + 256);
    if (tid < 2) bst[tid] = 0u;
    __syncthreads();
    (void)xcd_barrier_post((unsigned*)(ARG_WS + WS_CTL), bst);
    if (arg_cg_seam()) CG_SYNC();
    { FRESH(); mod_phase(0, 32, lds, vcu_, G_, tid_, wave, lane_); }
    GRID_SYNC();
    { FRESH(); norm_phase<false>(ARG_IN(0), 0, 0, lds, vcu_, G_, tid_, wave, lane_); }
    { FRESH(); mod_phase(32, 288, lds, vcu_, G_, tid_, wave, lane_); }
    { FRESH(); weights_phase(0, lds, vcu_, G_, wave, lane_); }
    GRID_SYNC();
    for (int l = 0; l < 2; ++l) {
        if (l == 1) { FRESH(); weights_phase(1, lds, vcu_, G_, wave, lane_); GRID_SYNC(); }
        for (int f = 0; f < 2; ++f) {
#ifndef NO_N
#endif
            {
                FRESH(); unsigned char* ws = ARG_WS;
                pg8::Gemm g{(const pbf*)(ws + WS_XN), (const pbf*)(ws + WS_WGU) + (size_t)f * NGU * 1024, M, NGU, D, NOSPLIT, 0}; pg8::StaticOrder S; S.init(M, NGU, G_, bx_); S.tail = 1;
                pg8::EpiSwiglu E{(pbf*)(ws + WS_BIG), FF};
#ifndef NO_GU
                pg8::gemm_phase<pg8::EpiSwiglu, pg8::StaticOrder, true, true>(lds, g, S, E);
#endif
            }
            GRID_SYNC();
            {
                FRESH(); unsigned char* ws = ARG_WS; float* outp = ARG_OUT;
                pg8::Gemm g{(const pbf*)(ws + WS_BIG), (const pbf*)(ws + WS_WD) + (size_t)f * 1024 * FF, M, D, FF, NOSPLIT, 0}; pg8::StaticOrder S; S.init(M, D, G_, bx_);
                const int nl = (f == 0) ? l : 1, nsub = (f == 0) ? 1 : 0, bank = (f == 0) ? 3 + l : 2, donorm = (f == 0 || l == 0) ? 1 : 0;
                const float* ng_ = ARG_IN(4) + (size_t)(nl * 3 + nsub) * 1024; const float* xin_ = ARG_IN(0);
                const float* nm_ = (const float*)(ws + WS_MOD) + (size_t)(nl * 2) * 9216 + (size_t)(3 * nsub) * 1024;
                pg8::EpiResid E{(f == 0 && l == 0) ? xin_ : (const float*)outp, outp, (const float*)(ws + WS_MOD) + (size_t)(l * 2) * 9216 + (f == 0 ? 2 : 8) * 1024,
                                (pbf*)(ws + WS_XN), ng_, nm_, nm_ + 1024, (float*)(ws + WS_XBUF), (unsigned*)(ws + WS_CTL) + 4096 + bank * 4096, 0.5f, donorm};
#ifndef NO_RES
                pg8::gemm_phase<pg8::EpiResid, pg8::StaticOrder, false, true>(lds, g, S, E);
#endif
            }
            GRID_SYNC();
            if (f == 0) {
                {
                    FRESH(); f_phase(l, lds, vcu_, G_, tid_, wave, lane_); unsigned char* ws = ARG_WS;
                    pg8::Gemm g{(const pbf*)(ws + WS_XN), (const pbf*)(ws + WS_WIN), M, NIN, D, NOSPLIT, 0}; pg8::StaticOrder S; S.init(M, NIN, G_, bx_); S.tail = 1;
                    LAS float* gl = (LAS float*)(lds + 131072 + 1024); if (tid_ < 256) gl[tid_] = (ARG_IN(9) + l * 256)[tid_]; __syncthreads();
                    pg8::EpiInproj E{(pbf*)(ws + WS_BIG), (pbf*)(ws + WS_G), (const LAS float*)gl};
#ifndef NO_IN
                    pg8::gemm_phase<pg8::EpiInproj, pg8::StaticOrder, true, true>(lds, g, S, E);
#endif
                }
                GRID_SYNC();
                {
                    FRESH(); unsigned char* ws = ARG_WS; pbf* SL = (pbf*)(ws + WS_BIG);
#ifndef NO_POOL
                    pool_phase((const bf16*)(SL + 5 * SLOT_E), (bf16*)(SL + 1 * SLOT_E), vcu_, G_, tid_);
#endif
                    using abf = attn_body::bf16;
                    volatile LAS int* hmap = (volatile LAS int*)(lds + 131072 + 288);
                    if (tid_ < 8) { const float* fbp = ARG_IN(11) + l * 8; const float fh = fbp[tid_]; int rank = 0;
#pragma unroll
                        for (int jj = 0; jj < 8; ++jj) { const float fj = fbp[jj]; rank += (fj > fh || (fj == fh && jj < tid_)) ? 1 : 0; }
                        hmap[rank] = tid_; }
                    __syncthreads();
                    for (int uu = vcu_; uu < 256; uu += G_) { const int bh = uu >> 4, s = uu & 15, b = bh >> 3, r = bh & 7;
#ifndef NO_ATTN0
                        for (int i = 0; i < 2; ++i) { const int h = __builtin_amdgcn_readfirstlane(hmap[i ? 7 - r : r]);
                            attn_body::attn_unit<0, 24>(b, h, i ? s : 31 - s, (const abf*)(SL + 2 * SLOT_E), (const abf*)(SL + 6 * SLOT_E), (const abf*)(SL + 7 * SLOT_E), (abf*)(SL + 2 * SLOT_E), (char*)lds_raw, (const float*)(ws + WS_CUM), (const float*)(ws + WS_BT), ARG_IN(9) + l * 256); }
#endif
#ifndef NO_ATTN1
                        for (int i = 0; i < 2; ++i)
                            attn_body::attn_unit<1, 8>(b, r, i ? s : 31 - s, (const abf*)(SL + 0 * SLOT_E), (const abf*)(SL + 3 * SLOT_E), (const abf*)(SL + 4 * SLOT_E), (abf*)(SL + 0 * SLOT_E), (char*)lds_raw, ARG_IN(10) + (size_t)(l * 8 + r) * 257, nullptr, nullptr);
#endif
                    }
                }
                GRID_SYNC();
                {
                    FRESH(); unsigned char* ws = ARG_WS;
                    pg8::Gemm g{(const pbf*)(ws + WS_BIG), (const pbf*)(ws + WS_WBR), M, 3072, 512, 4, SLOT}; pg8::BranchOrder S; S.S0.init(M, D, G_, bx_);
                    pg8::EpiBranch E{(pbf*)(ws + WS_MG), (const pbf*)(ws + WS_G)};
#ifndef NO_BR
                    pg8::gemm_phase<pg8::EpiBranch, pg8::BranchOrder, true, true>(lds, g, S, E);
#endif
                }
                GRID_SYNC();
                {
                    FRESH(); unsigned char* ws = ARG_WS; float* outp = ARG_OUT;
                    pg8::Gemm g{(const pbf*)(ws + WS_MG), (const pbf*)(ws + WS_WO), M, D, D, NOSPLIT, 0}; pg8::StaticOrder S; S.init(M, D, G_, bx_);
                    const float* ng_ = ARG_IN(4) + (size_t)(l * 3 + 2) * 1024;
                    pg8::EpiResid E{outp, outp, (const float*)(ws + WS_MOD) + (size_t)(l * 2) * 9216 + 5 * 1024,
                                    (pbf*)(ws + WS_XN), ng_, (const float*)(ws + WS_MOD) + (size_t)(l * 2) * 9216 + 6 * 1024, (const float*)(ws + WS_MOD) + (size_t)(l * 2) * 9216 + 7 * 1024, (float*)(ws + WS_XBUF), (unsigned*)(ws + WS_CTL) + 4096 + l * 4096, 1.0f, 1};
#ifndef NO_RES
                    pg8::gemm_phase<pg8::EpiResid, pg8::StaticOrder, false, true>(lds, g, S, E);
#endif
                }
                GRID_SYNC();
            }
        }
    }
}

extern "C" void kernel_launch(void* const* d_in, const int* in_sizes, int n_in, void* d_out, int out_size, void* d_ws, size_t ws_size, hipStream_t stream) {
    static int grid = 0;
    if (grid == 0) {
        if (n_in != 16 || out_size != M * D || ws_size < WS_END) { fprintf(stderr, "kernel_launch: unexpected shapes (n_in %d out %d ws %zu need %zu)\n", n_in, out_size, ws_size, (size_t)WS_END); grid = -1; return; }
        int dev = 0, cus = 0, per_cu = 0;
        if (hipGetDevice(&dev) != hipSuccess || hipDeviceGetAttribute(&cus, hipDeviceAttributeMultiprocessorCount, dev) != hipSuccess) { grid = -1; return; }
        if (hipFuncSetAttribute((const void*)mk_fwd, hipFuncAttributeMaxDynamicSharedMemorySize, LDS_BYTES) != hipSuccess) { fprintf(stderr, "kernel_launch: hipFuncSetAttribute failed\n"); grid = -1; return; }
        if (hipOccupancyMaxActiveBlocksPerMultiprocessor(&per_cu, (const void*)mk_fwd, NWAVES * 64, LDS_BYTES) != hipSuccess || per_cu < 1) { fprintf(stderr, "kernel_launch: occupancy query says %d\n", per_cu); per_cu = 1; }
        (void)hipGetLastError();
        grid = cus;
    }
    if (grid < 0) return;
    Args a{};
    for (int i = 0; i < 16; ++i) a.in[i] = (const float*)d_in[i];
    a.out = (float*)d_out; a.ws = (unsigned char*)d_ws; a.cg_seam = 0; a.pad = 0;
    if (hipMemsetAsync((char*)d_ws + WS_CTL, 0, CTL_ZERO_BYTES, stream) != hipSuccess) { fprintf(stderr, "kernel_launch: hipMemsetAsync failed\n"); return; }
    void* params[] = {&a};
    const hipError_t e = hipLaunchCooperativeKernel((const void*)mk_fwd, dim3(grid), dim3(NWAVES * 64), params, LDS_BYTES, stream);
    if (e != hipSuccess) fprintf(stderr, "kernel_launch: cooperative launch failed: %s (grid %d)\n", hipGetErrorString(e), grid);
}
```

```cpp
#include <hip/hip_runtime.h>
#include <hip/hip_cooperative_groups.h>
#include <hip/hip_bf16.h>
#include <cstdio>
#include <cstdint>
#include <cmath>
namespace cg = cooperative_groups;

namespace pg8 {
#define PG8_LAS __attribute__((address_space(3)))
typedef unsigned short bf16_t;
typedef short bf16x8 __attribute__((ext_vector_type(8)));
typedef float f32x4 __attribute__((ext_vector_type(4)));
typedef unsigned u32x4 __attribute__((ext_vector_type(4)));
constexpr int BM = 256, BK = 64, HALF = 128, HTB = HALF * BK * 2  , STAGE_BYTES = 8 * HTB, NXCD = 8, WGM = 8;

__host__ __device__ __forceinline__ int lds_byte(int r, int c) { const int st = (r >> 4) * 2 + (c >> 5), rr = r & 15, cc = c & 31, ob = rr * 64 + cc * 2; return st * 1024 + (ob ^ (((ob >> 9) & 1) << 5)); }
__host__ __device__ __forceinline__ void stage_rc(int b, int& R, int& C) { const int st = b / 1024, sb = b % 1024, swz = sb ^ (((sb >> 9) & 1) << 5); R = (st >> 1) * 16 + swz / 64; C = (st & 1) * 32 + (swz % 64) / 2; }
__host__ __device__ __forceinline__ int perm32(int rho) { const int n = rho >> 4, i = rho & 15; return 8 * (i >> 2) + 4 * n + (i & 3); }

struct Unit { int pm, pn, roff, nai; };
struct Gemm { const bf16_t* A; const bf16_t* Bt; int M, N, K; int a_tiles; size_t a_stride; };

struct StaticOrder {
    static constexpr bool KEEP = false;
    int nM, nN, nwg, G, c;
    __host__ __device__ void init(int M, int N, int G_, int c_) { nM = M / BM; nN = N / BM; nwg = nM * nN; G = G_; c = c_; tail = 0; }
    int tail;
    __host__ __device__ bool next(int i, Unit& u) const {
        long L = (long)i * G + c; u.roff = 0; u.nai = 2;
        const int full = nwg / G;
        if (tail && (nwg - full * G) * 2 == G && i >= full) { if (i > full) return false; L = (long)full * G + (c >> 1); u.roff = 128 * (c & 1); u.nai = 1; }
        if (L >= nwg) return false;
        int wgid = (int)L; { const int q = nwg / NXCD, r = nwg % NXCD, xcd = wgid % NXCD, off = wgid / NXCD; wgid = (xcd < r ? xcd * (q + 1) : r * (q + 1) + (xcd - r) * q) + off; }
        const int nig = WGM * nN, gid = wgid / nig, fm = gid * WGM, gsz = (nM - fm) < WGM ? (nM - fm) : WGM;
        u.pm = fm + ((wgid % nig) % gsz); u.pn = (wgid % nig) / gsz; return true;
    }
    __device__ __forceinline__ void a_ready(const Unit&) const {}
    __device__ __forceinline__ void done(const Unit&) const {}
};

typedef float f32x2c __attribute__((ext_vector_type(2))); typedef __bf16 bf16x2c __attribute__((ext_vector_type(2)));
__device__ __forceinline__ unsigned cvt_pk_bf16(float lo, float hi) { f32x2c v = {lo, hi}; bf16x2c b = __builtin_convertvector(v, bf16x2c); return __builtin_bit_cast(unsigned, b); }

typedef float f32x2 __attribute__((ext_vector_type(2)));
constexpr float EPI_LOG2E = 1.4426950408889634f;
constexpr float EPI_C2 = 0.125f * 1.4426950408889634f;
__device__ __forceinline__ float sigm(float x) { return __builtin_amdgcn_rcpf(1.0f + __builtin_amdgcn_exp2f(-x * EPI_LOG2E)); }
__device__ __forceinline__ f32x4 sigm4(f32x4 v) { return (f32x4){sigm(v[0]), sigm(v[1]), sigm(v[2]), sigm(v[3])}; }
__device__ __forceinline__ u32x4 pack8(f32x4 v0, f32x4 v1) { u32x4 w; w.x = cvt_pk_bf16(v0[0], v0[1]); w.y = cvt_pk_bf16(v0[2], v0[3]); w.z = cvt_pk_bf16(v1[0], v1[1]); w.w = cvt_pk_bf16(v1[2], v1[3]); return w; }
__device__ __forceinline__ f32x4 bf_lo4(unsigned a, unsigned b) { return (f32x4){__uint_as_float(a << 16), __uint_as_float(a & 0xffff0000u), __uint_as_float(b << 16), __uint_as_float(b & 0xffff0000u)}; }

__device__ __forceinline__ unsigned q4u8(f32x4 g) { f32x4 t = g * 255.0f + 0.5f; t[0] = fmaxf(t[0], 1.0f); t[1] = fmaxf(t[1], 1.0f); t[2] = fmaxf(t[2], 1.0f); t[3] = fmaxf(t[3], 1.0f);     return (unsigned)t[0] | ((unsigned)t[1] << 8) | ((unsigned)t[2] << 16) | ((unsigned)t[3] << 24); }
__device__ __forceinline__ f32x4 dq4u8(unsigned w) { return (f32x4){(float)(w & 0xffu), (float)((w >> 8) & 0xffu), (float)((w >> 16) & 0xffu), (float)(w >> 24)}; }
struct EpiSwiglu {
    static constexpr bool PERM = true, AFTER_DRAIN = false;
    bf16_t* H; int ldh;
    __device__ __forceinline__ void operator()(const f32x4 (&acc)[2][2][4][2], const Unit& u, int wr, int wc, int fr, int fq) const {
        const int row0 = u.pm * BM + u.roff + wr * 64 + fr, col0 = u.pn * 128 + wc * 32 + 8 * fq;
#pragma unroll
        for (int ai = 0; ai < 2; ++ai) if (ai < u.nai)
#pragma unroll
            for (int m = 0; m < 4; ++m) { bf16_t* rowp = H + (size_t)(row0 + ai * HALF + m * 16) * ldh + col0;
                const f32x4 g0 = acc[ai][0][m][0], g1 = acc[ai][0][m][1], u0 = acc[ai][1][m][0], u1 = acc[ai][1][m][1];
                const f32x4 h0 = g0 * sigm4(g0) * u0, h1 = g1 * sigm4(g1) * u1;
                *(u32x4*)rowp = pack8(h0, h1); }
    }
};
struct EpiResid {
    static constexpr bool PERM = false, AFTER_DRAIN = true;
    const float* base; float* out; const float* gate;
    bf16_t* xn; const float* ngain; const float* nshift; const float* nscale; float* xbuf; unsigned* cnt; float coef; int donorm;
    __device__ __forceinline__ void fused(f32x4 (&acc)[2][2][4][2], const Unit& u, int wr, int wc, int fr, int fq, PG8_LAS unsigned char* lds, int wid, int lane) const {
        const int row0 = u.pm * BM + wr * 64 + fr, col0 = u.pn * BM + wc * 32 + 4 * fq; const int bo = (u.pm >= 32 ? 9216 : 0); const float* gp = gate + bo + col0;
        f32x4 gv[2][2];
#pragma unroll
        for (int bj = 0; bj < 2; ++bj)
#pragma unroll
            for (int n = 0; n < 2; ++n) gv[bj][n] = *(const f32x4*)(gp + bj * HALF + n * 16) * coef;
#pragma unroll
        for (int ai = 0; ai < 2; ++ai)
#pragma unroll
            for (int m = 0; m < 4; ++m) { const size_t off = (size_t)(row0 + ai * HALF + m * 16) * 1024 + col0;
#pragma unroll
                for (int bj = 0; bj < 2; ++bj)
#pragma unroll
                    for (int n = 0; n < 2; ++n) { const f32x4 bs = *(const f32x4*)(base + off + bj * HALF + n * 16); acc[ai][bj][m][n] = bs + gv[bj][n] * acc[ai][bj][m][n]; *(f32x4*)(out + off + bj * HALF + n * 16) = acc[ai][bj][m][n]; }
                if (m & 1) asm volatile("" ::: "memory"); }
        if (donorm == 0) return;
        f32x4 gmv[2][2], shv[2][2];
        { const float* g2 = ngain + col0; const float* sh2 = nshift + bo + col0; const float* sc2 = nscale + bo + col0;
#pragma unroll
          for (int bj = 0; bj < 2; ++bj)
#pragma unroll
            for (int n = 0; n < 2; ++n) { const f32x4 g = *(const f32x4*)(g2 + bj * HALF + n * 16), sc = *(const f32x4*)(sc2 + bj * HALF + n * 16); shv[bj][n] = *(const f32x4*)(sh2 + bj * HALF + n * 16); gmv[bj][n] = g * (1.0f + sc); } }
        PG8_LAS float* P = (PG8_LAS float*)lds;
        PG8_LAS float* S = (PG8_LAS float*)(lds + 4096);
#pragma unroll
        for (int ai = 0; ai < 2; ++ai)
#pragma unroll
            for (int m = 0; m < 4; ++m) { float q = 0.f;
#pragma unroll
                for (int bj = 0; bj < 2; ++bj)
#pragma unroll
                    for (int n = 0; n < 2; ++n) { const f32x4 x = acc[ai][bj][m][n]; q += (x[0] * x[0] + x[1] * x[1]) + (x[2] * x[2] + x[3] * x[3]); }
                q += __shfl_xor(q, 16); q += __shfl_xor(q, 32);
                if (fq == 0) P[(ai * HALF + wr * 64 + m * 16 + fr) * 4 + wc] = q; }
        asm volatile("s_waitcnt lgkmcnt(0)" ::: "memory"); __builtin_amdgcn_s_barrier(); asm volatile("" ::: "memory");
        const int row = wid * 32 + (lane & 31); float* slot = xbuf + ((size_t)(u.pm * BM + row)) * 4;
        if (lane < 32) { const float t = (P[row * 4 + 0] + P[row * 4 + 1]) + (P[row * 4 + 2] + P[row * 4 + 3]); __hip_atomic_store((unsigned*)slot + u.pn, __float_as_uint(t), __ATOMIC_RELAXED, __HIP_MEMORY_SCOPE_AGENT); }
        asm volatile("s_waitcnt vmcnt(0)" ::: "memory");
        if (lane == 0) __hip_atomic_fetch_add(cnt + 64 * u.pm, 1u, __ATOMIC_RELAXED, __HIP_MEMORY_SCOPE_AGENT);
        if (wid == 0) { for (unsigned sp = 0; sp < (1u << 22); ++sp) { if ((unsigned)__builtin_amdgcn_readfirstlane(__hip_atomic_load(cnt + 64 * u.pm, __ATOMIC_RELAXED, __HIP_MEMORY_SCOPE_AGENT)) >= 32u) break; __builtin_amdgcn_s_sleep(2); }
            __builtin_amdgcn_fence(__ATOMIC_ACQUIRE, "agent"); }
        asm volatile("s_waitcnt vmcnt(0) lgkmcnt(0)" ::: "memory"); __builtin_amdgcn_s_barrier(); asm volatile("" ::: "memory");
        if (lane < 32) { float t = 0.f;
#pragma unroll
            for (int k = 0; k < 4; ++k) t += __uint_as_float(__hip_atomic_load((unsigned*)slot + k, __ATOMIC_RELAXED, __HIP_MEMORY_SCOPE_AGENT));
            S[row] = 1.0f / sqrtf(t * (1.0f / 1024.0f) + 1e-6f); }
        asm volatile("s_waitcnt lgkmcnt(0)" ::: "memory"); __builtin_amdgcn_s_barrier(); asm volatile("" ::: "memory");
        typedef unsigned u32x2v __attribute__((ext_vector_type(2)));
#pragma unroll
        for (int bj = 0; bj < 2; ++bj)
#pragma unroll
            for (int n = 0; n < 2; ++n) { const f32x4 gm = gmv[bj][n], sh = shv[bj][n];
#pragma unroll
                for (int ai = 0; ai < 2; ++ai)
#pragma unroll
                    for (int m = 0; m < 4; ++m) { const int r = ai * HALF + wr * 64 + m * 16 + fr; const float rs = S[r]; const f32x4 v = (acc[ai][bj][m][n] * rs) * gm + sh;
                        u32x2v w; w.x = cvt_pk_bf16(v[0], v[1]); w.y = cvt_pk_bf16(v[2], v[3]);
                        *(u32x2v*)(xn + (size_t)(u.pm * BM + r) * 1024 + col0 + bj * HALF + n * 16) = w; } }
    }
};
struct EpiInproj {
    static constexpr bool PERM = true, AFTER_DRAIN = false;
    bf16_t* base; bf16_t* G; const PG8_LAS float* gain;
    __device__ __forceinline__ void operator()(const f32x4 (&acc)[2][2][4][2], const Unit& u, int wr, int wc, int fr, int fq) const {
        const int row0 = u.pm * BM + u.roff + wr * 64 + fr;
        if (u.pn >= 14) {
            const int col0 = (u.pn - 14) * 256 + 64 * wc + 8 * fq;
#pragma unroll
            for (int ai = 0; ai < 2; ++ai) if (ai < u.nai)
#pragma unroll
                for (int m = 0; m < 4; ++m) { unsigned char* rowp = (unsigned char*)G + (size_t)(row0 + ai * HALF + m * 16) * 3072 + col0;
#pragma unroll
                    for (int bj = 0; bj < 2; ++bj) { typedef unsigned u32x2q __attribute__((ext_vector_type(2))); u32x2q w; w.x = q4u8(sigm4(acc[ai][bj][m][0])); w.y = q4u8(sigm4(acc[ai][bj][m][1])); *(u32x2q*)(rowp + 32 * bj) = w; } }
        } else {
            const int t = u.pn >> 1; const int slot = (t == 0) ? 0 : (t == 4) ? 2 : (t < 4) ? t + 2 : t + 1; bf16_t* O = base + (size_t)slot * ((size_t)16384 * 512);     const int col0 = (u.pn & 1) * 256 + 64 * wc + 8 * fq;
            if (t == 0 || t == 1 || t == 4 || t == 5) {
                const int gi = (t == 0) ? 0 : (t == 1) ? 1 : (t == 4) ? 2 : 3; const float qs = (t == 0 || t == 4) ? EPI_C2 : 1.f;
                f32x4 gv[2][2];
#pragma unroll
                for (int bj = 0; bj < 2; ++bj)
#pragma unroll
                    for (int n = 0; n < 2; ++n) gv[bj][n] = *(const PG8_LAS f32x4*)(gain + gi * 64 + 32 * bj + 8 * fq + 4 * n) * qs;
#pragma unroll
                for (int ai = 0; ai < 2; ++ai) if (ai < u.nai)
#pragma unroll
                    for (int m = 0; m < 4; ++m) { bf16_t* rowp = O + (size_t)(row0 + ai * HALF + m * 16) * 512 + col0;
                        float ss = 0.f;
#pragma unroll
                        for (int bj = 0; bj < 2; ++bj)
#pragma unroll
                            for (int n = 0; n < 2; ++n) { const f32x4 x = acc[ai][bj][m][n]; ss += (x[0] * x[0] + x[1] * x[1]) + (x[2] * x[2] + x[3] * x[3]); }
                        ss += __shfl_xor(ss, 16); ss += __shfl_xor(ss, 32);
                        const float rstd = __builtin_amdgcn_rsqf(ss * (1.0f / 64.0f) + 1e-6f);
#pragma unroll
                        for (int bj = 0; bj < 2; ++bj) *(u32x4*)(rowp + 32 * bj) = pack8(acc[ai][bj][m][0] * rstd * gv[bj][0], acc[ai][bj][m][1] * rstd * gv[bj][1]); }
            } else {
#pragma unroll
                for (int ai = 0; ai < 2; ++ai) if (ai < u.nai)
#pragma unroll
                    for (int m = 0; m < 4; ++m) { bf16_t* rowp = O + (size_t)(row0 + ai * HALF + m * 16) * 512 + col0;
#pragma unroll
                        for (int bj = 0; bj < 2; ++bj) *(u32x4*)(rowp + 32 * bj) = pack8(acc[ai][bj][m][0], acc[ai][bj][m][1]); }
            }
        }
    }
};
struct EpiBranch {
    static constexpr bool PERM = true, AFTER_DRAIN = false;
    bf16_t* MG; const bf16_t* G;
    __device__ __forceinline__ void operator()(f32x4 (&acc)[2][2][4][2], const Unit& u, int wr, int wc, int fr, int fq) const {
        typedef unsigned u32x2q __attribute__((ext_vector_type(2)));
        const int n = u.pn >> 2, pc = u.pn & 3; const int row0 = u.pm * BM + wr * 64 + fr, col0 = pc * 256 + wc * 32 + 8 * fq;
        const int nn = (n < 2) ? n + 1 : n;
#pragma unroll
        for (int ai = 0; ai < 2; ++ai)
#pragma unroll
          for (int mp2 = 0; mp2 < 2; ++mp2) {
            u32x2q ga[2][2], gb[2][2];
#pragma unroll
            for (int q = 0; q < 2; ++q) { const int m = 2 * mp2 + q; const size_t row = (size_t)(row0 + ai * HALF + m * 16); const unsigned char* gp = (const unsigned char*)G + row * 3072 + col0;
#pragma unroll
                for (int bj = 0; bj < 2; ++bj) { ga[q][bj] = *(const u32x2q*)(gp + n * 1024 + bj * HALF); gb[q][bj] = *(const u32x2q*)(gp + nn * 1024 + bj * HALF); } }
            asm volatile("" : "+v"(ga[0][0]), "+v"(ga[0][1]), "+v"(ga[1][0]), "+v"(ga[1][1]), "+v"(gb[0][0]), "+v"(gb[0][1]), "+v"(gb[1][0]), "+v"(gb[1][1]));
#pragma unroll
            for (int q = 0; q < 2; ++q) { const int m = 2 * mp2 + q; const size_t row = (size_t)(row0 + ai * HALF + m * 16);
                if (n < 2) {
#pragma unroll
                    for (int bj = 0; bj < 2; ++bj) { const f32x4 d0 = dq4u8(gb[q][bj].x), d1 = dq4u8(gb[q][bj].y);
                        const f32x4 r0 = dq4u8(ga[q][bj].x) * (f32x4){__builtin_amdgcn_rcpf(d0[0]), __builtin_amdgcn_rcpf(d0[1]), __builtin_amdgcn_rcpf(d0[2]), __builtin_amdgcn_rcpf(d0[3])};
                        const f32x4 r1 = dq4u8(ga[q][bj].y) * (f32x4){__builtin_amdgcn_rcpf(d1[0]), __builtin_amdgcn_rcpf(d1[1]), __builtin_amdgcn_rcpf(d1[2]), __builtin_amdgcn_rcpf(d1[3])};
                        acc[ai][bj][m][0] *= r0; acc[ai][bj][m][1] *= r1; }
                } else { bf16_t* mp = MG + row * 1024 + col0;
#pragma unroll
                    for (int bj = 0; bj < 2; ++bj) *(u32x4*)(mp + bj * HALF) = pack8(dq4u8(ga[q][bj].x) * (acc[ai][bj][m][0] * (1.0f / 255.0f)), dq4u8(ga[q][bj].y) * (acc[ai][bj][m][1] * (1.0f / 255.0f))); } }
          }
    }
};
struct BranchOrder {
    static constexpr bool KEEP = true;
    StaticOrder S0;
    __device__ __forceinline__ bool next(int i, Unit& u) const { Unit t; if (!S0.next(i / 3, t)) return false; u.pm = t.pm; u.pn = 4 * (i % 3) + t.pn; u.roff = 0; u.nai = 2; return true; }
    __device__ __forceinline__ void a_ready(const Unit&) const {}
    __device__ __forceinline__ void done(const Unit&) const {}
};

template <class Epi, class Sched, bool ALIGN_EPI = false, bool SP2 = false>
__device__ __forceinline__ void gemm_phase(PG8_LAS unsigned char* lds, const Gemm g, const Sched& S, const Epi& E) {
    int tid_l = threadIdx.x; asm volatile("" : "+v"(tid_l));
    const int tid = tid_l, wid = __builtin_amdgcn_readfirstlane(tid >> 6), lane = tid & 63, wr = wid >> 2, wc = wid & 3, fr = lane & 15, fq = lane >> 4;
    const int K = g.K, nt = K / BK;
    unsigned voffA[2], voffB[2];
#pragma unroll
    for (int i = 0; i < 2; ++i) { int R, C; stage_rc(tid * 16 + i * 8192, R, C); const int Rb = Epi::PERM ? ((R & ~31) + perm32(R & 31)) : R;
        voffA[i] = (unsigned)(R * K + C) * 2u; voffB[i] = (unsigned)(Rb * K + C) * 2u; }
    const size_t kstep = (size_t)(BK * 2);
    const size_t hstep = (size_t)HALF * K * 2;
    const size_t tstep = 2 * hstep;
    const unsigned ldsw = (unsigned)wid * 1024u;
    const int aoff = lds_byte(wr * 64 + fr, fq * 8), boff = lds_byte(wc * 32 + fr, fq * 8);
#define PG8_SA(b, h) (((b) * 2 + (h)) * HTB)
#define PG8_SB(b, h) ((4 + (b) * 2 + (h)) * HTB)
#define PG8_STAGE(bufoff, gbase, voff) do { _Pragma("unroll") for (int _i = 0; _i < 2; ++_i) \
        __builtin_amdgcn_global_load_lds((const unsigned*)((const char*)(gbase) + (voff)[_i]), (PG8_LAS unsigned*)(lds + (bufoff) + ldsw + _i * 8192), 16, 0, 0); } while (0)
#define PG8_LDA(dst, b, h) do { _Pragma("unroll") for (int m = 0; m < 4; ++m) _Pragma("unroll") for (int k = 0; k < 2; ++k) dst[m][k] = *(const PG8_LAS bf16x8*)(lds + PG8_SA(b, h) + aoff + m * 2048 + k * 1024); } while (0)
#define PG8_LDB(dst, b, h) do { _Pragma("unroll") for (int n = 0; n < 2; ++n) _Pragma("unroll") for (int k = 0; k < 2; ++k) dst[n][k] = *(const PG8_LAS bf16x8*)(lds + PG8_SB(b, h) + boff + n * 2048 + k * 1024); } while (0)
#define PG8_MMA(ai, bj, At, Bt) do { __builtin_amdgcn_s_setprio(1); _Pragma("unroll") for (int m = 0; m < 4; ++m) _Pragma("unroll") for (int n = 0; n < 2; ++n) _Pragma("unroll") for (int k = 0; k < 2; ++k) \
        acc[ai][bj][m][n] = __builtin_amdgcn_mfma_f32_16x16x32_bf16(Bt[n][k], At[m][k], acc[ai][bj][m][n], 0, 0, 0); __builtin_amdgcn_s_setprio(0); } while (0)
#define PG8_WAIT_V(n) asm volatile("s_waitcnt vmcnt(" #n ")" ::: "memory")
#define PG8_WAIT_L(n) asm volatile("s_waitcnt lgkmcnt(" #n ")" ::: "memory")
#define PG8_BAR __builtin_amdgcn_s_barrier()
#define PG8_SCHED __builtin_amdgcn_sched_barrier(0)
    Unit cur, nxt; int ui = 0;
    if (!S.next(0, cur)) return;
    f32x4 acc[2][2][4][2];
#pragma unroll
    for (int a = 0; a < 2; ++a)
#pragma unroll
        for (int b = 0; b < 2; ++b)
#pragma unroll
            for (int m = 0; m < 4; ++m)
#pragma unroll
                for (int n = 0; n < 2; ++n) acc[a][b][m][n] = (f32x4){0.f, 0.f, 0.f, 0.f};
    bf16x8 At[4][2], B0[2][2], B1[2][2];
    const char* cA = (const char*)g.A + (size_t)(cur.pn / g.a_tiles) * g.a_stride + (size_t)cur.pm * tstep + (size_t)cur.roff * K * 2; const char* cB = (const char*)g.Bt + (size_t)cur.pn * tstep;
    S.a_ready(cur);
    if constexpr (SP2) {
        PG8_STAGE(PG8_SB(0, 0), cB, voffB); PG8_STAGE(PG8_SB(0, 1), cB + hstep, voffB); PG8_STAGE(PG8_SA(0, 0), cA, voffA); PG8_STAGE(PG8_SA(0, 1), cA + hstep, voffA);
        if (wr == 1) PG8_BAR;
        PG8_WAIT_V(2); PG8_BAR;
        PG8_STAGE(PG8_SB(1, 0), cB + kstep, voffB); PG8_STAGE(PG8_SA(1, 0), cA + kstep, voffA); PG8_STAGE(PG8_SB(1, 1), cB + hstep + kstep, voffB);
        PG8_WAIT_V(6); PG8_BAR;
    } else {
        PG8_STAGE(PG8_SB(0, 0), cB, voffB); PG8_STAGE(PG8_SA(0, 0), cA, voffA); PG8_STAGE(PG8_SB(0, 1), cB + hstep, voffB); PG8_STAGE(PG8_SA(0, 1), cA + hstep, voffA);
        if (wr == 1) PG8_BAR;
        PG8_WAIT_V(4); PG8_BAR;
        PG8_STAGE(PG8_SB(1, 0), cB + kstep, voffB); PG8_STAGE(PG8_SA(1, 0), cA + kstep, voffA); PG8_STAGE(PG8_SB(1, 1), cB + hstep + kstep, voffB);
        PG8_WAIT_V(6); PG8_BAR;
    }
    for (;;) {
        const bool has_next = S.next(ui + 1, nxt);
        const char* nA = has_next ? (const char*)g.A + (size_t)(nxt.pn / g.a_tiles) * g.a_stride + (size_t)nxt.pm * tstep + (size_t)nxt.roff * K * 2 : cA; const char* nB = has_next ? (const char*)g.Bt + (size_t)nxt.pn * tstep : cB;
        const bool full = (cur.nai == 2);
        for (int t = 0; t < nt; t += 2) {
            const bool last = (t == nt - 2);
            const char* a1 = cA + (size_t)(t + 1) * kstep;
            const char* a2 = last ? nA : cA + (size_t)(t + 2) * kstep; const char* b2 = last ? nB : cB + (size_t)(t + 2) * kstep;
            const char* a3 = a2 + kstep; const char* b3 = b2 + kstep;
            if (last && has_next) S.a_ready(nxt);
            if constexpr (SP2) {
            PG8_LDB(B0, 0, 0); PG8_LDB(B1, 0, 1); PG8_SCHED; PG8_LDA(At, 0, 0); PG8_STAGE(PG8_SA(1, 1), a1 + hstep, voffA);
            PG8_WAIT_V(8); PG8_WAIT_L(0); PG8_BAR; PG8_MMA(0, 0, At, B0); PG8_MMA(0, 1, At, B1); PG8_BAR; PG8_SCHED;
            if (full) PG8_LDA(At, 0, 1); PG8_STAGE(PG8_SB(0, 0), b2, voffB); PG8_STAGE(PG8_SB(0, 1), b2 + hstep, voffB); PG8_STAGE(PG8_SA(0, 0), a2, voffA);
            PG8_WAIT_V(8); PG8_WAIT_L(0); PG8_BAR; if (full) { PG8_MMA(1, 0, At, B0); PG8_MMA(1, 1, At, B1); } PG8_BAR; PG8_SCHED;
            PG8_LDB(B0, 1, 0); PG8_LDB(B1, 1, 1); PG8_SCHED; PG8_LDA(At, 1, 0); PG8_STAGE(PG8_SA(0, 1), a2 + hstep, voffA);
            PG8_WAIT_V(8); PG8_WAIT_L(0); PG8_BAR; PG8_MMA(0, 0, At, B0); PG8_MMA(0, 1, At, B1); PG8_BAR; PG8_SCHED;
            if (full) PG8_LDA(At, 1, 1); PG8_STAGE(PG8_SB(1, 0), b3, voffB); PG8_STAGE(PG8_SB(1, 1), b3 + hstep, voffB); PG8_STAGE(PG8_SA(1, 0), a3, voffA);
            PG8_WAIT_V(8); PG8_WAIT_L(0); PG8_BAR; if (full) { PG8_MMA(1, 0, At, B0); PG8_MMA(1, 1, At, B1); } PG8_BAR; PG8_SCHED;
            } else {
            PG8_LDB(B0, 0, 0); PG8_SCHED; PG8_LDA(At, 0, 0); PG8_STAGE(PG8_SA(1, 1), a1 + hstep, voffA);
            PG8_WAIT_L(8); PG8_BAR; PG8_WAIT_L(0); PG8_MMA(0, 0, At, B0); PG8_BAR; PG8_SCHED;
            PG8_LDB(B1, 0, 1); PG8_STAGE(PG8_SB(0, 0), b2, voffB);
            PG8_BAR; PG8_WAIT_L(0); PG8_MMA(0, 1, At, B1); PG8_BAR;
            PG8_LDA(At, 0, 1); PG8_STAGE(PG8_SA(0, 0), a2, voffA);
            PG8_BAR; PG8_WAIT_L(0); PG8_MMA(1, 0, At, B0); PG8_BAR; PG8_SCHED;
            PG8_STAGE(PG8_SB(0, 1), b2 + hstep, voffB);
            PG8_WAIT_V(6); PG8_BAR; PG8_MMA(1, 1, At, B1); PG8_BAR;
            PG8_LDB(B0, 1, 0); PG8_SCHED; PG8_LDA(At, 1, 0); PG8_STAGE(PG8_SA(0, 1), a2 + hstep, voffA);
            PG8_WAIT_L(8); PG8_BAR; PG8_WAIT_L(0); PG8_MMA(0, 0, At, B0); PG8_BAR; PG8_SCHED;
            PG8_LDB(B1, 1, 1); PG8_STAGE(PG8_SB(1, 0), b3, voffB);
            PG8_BAR; PG8_WAIT_L(0); PG8_MMA(0, 1, At, B1); PG8_BAR;
            PG8_LDA(At, 1, 1); PG8_STAGE(PG8_SA(1, 0), a3, voffA);
            PG8_BAR; PG8_WAIT_L(0); PG8_MMA(1, 0, At, B0); PG8_BAR; PG8_SCHED;
            PG8_STAGE(PG8_SB(1, 1), b3 + hstep, voffB);
            PG8_WAIT_V(6); PG8_BAR; PG8_MMA(1, 1, At, B1); PG8_BAR;
            }
        }
        if constexpr (ALIGN_EPI) { if (wr == 0) PG8_BAR; }
        if constexpr (!Epi::AFTER_DRAIN) { E(acc, cur, wr, wc, fr, fq); S.done(cur); }
        if (!has_next) break;
        if (!Sched::KEEP || (nxt.pn >> 2) == 0) {
#pragma unroll
        for (int a = 0; a < 2; ++a)
#pragma unroll
            for (int b = 0; b < 2; ++b)
#pragma unroll
                for (int m = 0; m < 4; ++m)
#pragma unroll
                    for (int n = 0; n < 2; ++n) acc[a][b][m][n] = (f32x4){0.f, 0.f, 0.f, 0.f};
        }
        cur = nxt; cA = nA; cB = nB; ++ui;
        if constexpr (ALIGN_EPI) { if (wr == 1) PG8_BAR; }
    }
    PG8_WAIT_V(0);
    if constexpr (!ALIGN_EPI) { if (wr == 0) PG8_BAR; }
    PG8_BAR;
    if constexpr (Epi::AFTER_DRAIN) { E.fused(acc, cur, wr, wc, fr, fq, lds, wid, lane); S.done(cur); }
#undef PG8_SA
#undef PG8_SB
#undef PG8_STAGE
#undef PG8_LDA
#undef PG8_LDB
#undef PG8_MMA
#undef PG8_WAIT_V
#undef PG8_WAIT_L
#undef PG8_BAR
#undef PG8_SCHED
}
}

#include <hip/hip_bf16.h>
#include <cmath>
namespace attn_body {
using bf16=__hip_bfloat16;
using bf16x8=__attribute__((ext_vector_type(8)))short;
using s16x4=__attribute__((ext_vector_type(4)))short;
using f32x16=__attribute__((ext_vector_type(16)))float;
using u32x4=__attribute__((ext_vector_type(4)))unsigned;
constexpr int BATCH=2,NHEAD=8,SEQ=8192,D=64,DM=NHEAD*D;
constexpr int NW=8,QBLK=32,QB=QBLK*NW,KVBLK=64,NQB=SEQ/QB;
constexpr int ATTN_PITCH=DM, ATTN_UNIT_ROWS=QB;
__device__ __forceinline__ int crow(int r,int hi){return (r&3)+8*(r>>2)+4*hi;}
#define SBAR() __builtin_amdgcn_sched_barrier(0)
__device__ __forceinline__ void cmask(f32x16&p0,f32x16&p1,int jb,int qrel,int hi){
  const float NEG=-INFINITY; int kb=64*jb+4*hi;
  #pragma unroll
  for(int r=0;r<16;++r){int kv=kb+(r&3)+8*(r>>2); if(kv>qrel)p0[r]=NEG; if(kv+32>qrel)p1[r]=NEG;}
}

constexpr int NSLOT=3, SLOTB=8192;
constexpr int LDS_K=0, LDS_V=NSLOT*SLOTB, LDS_WS=2*NSLOT*SLOTB, LDS_OST=LDS_WS+NW*64*4, LDS_BYTES=LDS_OST+NW*4096;
constexpr float C2=0.125f*1.4426950408889634f; constexpr float LOG2E=1.4426950408889634f; constexpr int TAB_OFF=86016, LDS_BYTES_ALL=TAB_OFF+32768+512; constexpr float NEGBIG=-30000.f;

typedef __attribute__((address_space(3))) float* lds_fptr;
typedef float f32x4a __attribute__((ext_vector_type(4)));
template<int MODE> __device__ __forceinline__ void hook(f32x16&p0,f32x16&p1,int t,int NT,int qrel,int hi,lds_fptr tab,int dbase,int ibase){
  if(MODE==0){
    const lds_fptr tb=tab+64*t+4*hi;
    #pragma unroll
    for(int g=0;g<4;++g){ const f32x4a a=*(const __attribute__((address_space(3))) f32x4a*)(tb+8*g); const f32x4a c=*(const __attribute__((address_space(3))) f32x4a*)(tb+32+8*g);
      p0[4*g+0]+=a.x;p0[4*g+1]+=a.y;p0[4*g+2]+=a.z;p0[4*g+3]+=a.w; p1[4*g+0]+=c.x;p1[4*g+1]+=c.y;p1[4*g+2]+=c.z;p1[4*g+3]+=c.w; }
    const int jb=t-(NT-4); if(jb>=0)cmask(p0,p1,jb,qrel,hi);
  } else {
    const int delta=dbase-t;
    if(delta<0||delta>8){
      #pragma unroll
      for(int r=0;r<16;++r){p0[r]=NEGBIG;p1[r]=NEGBIG;}
    } else if(delta>=3){ const float cf=tab[256];
      #pragma unroll
      for(int r=0;r<16;++r){p0[r]+=cf;p1[r]+=cf;}
    } else { const int ib=64*delta+ibase-4*hi;
      #pragma unroll
      for(int r=0;r<16;++r){ const int kc=(r&3)+8*(r>>2); int i0=ib-kc, i1=ib-32-kc; i0=i0>256?256:i0; i1=i1>256?256:i1; p0[r]+=tab[i0]; p1[r]+=tab[i1]; }
    }
  }
}
__device__ __forceinline__ void glds16(const void*gsrc,unsigned lds_dst){unsigned keep;
  asm volatile("s_mov_b32 %0, m0\n\ts_mov_b32 m0, %2\n\ts_nop 0\n\tglobal_load_lds_dwordx4 %1, off\n\ts_mov_b32 m0, %0":"=&s"(keep):"v"(gsrc),"s"(lds_dst):"memory");}
__device__ __forceinline__ float max3f(float a,float b,float c){float r;asm("v_max3_f32 %0, %1, %2, %3":"=v"(r):"v"(a),"v"(b),"v"(c));return r;}
__device__ __forceinline__ float max2f(float a,float b){float r;asm("v_max_f32_e32 %0, %1, %2":"=v"(r):"v"(a),"v"(b));return r;}
__device__ __forceinline__ float fadd_s(float a,float b){float r;asm("v_add_f32_e32 %0, %1, %2":"=v"(r):"v"(a),"v"(b));return r;}
__device__ __forceinline__ float fsub_s(float a,float b){float r;asm("v_sub_f32_e32 %0, %1, %2":"=v"(r):"v"(a),"v"(b));return r;}
typedef float f32x2_t __attribute__((ext_vector_type(2))); typedef __bf16 bf16x2_t __attribute__((ext_vector_type(2)));
__device__ __forceinline__ unsigned cvtpk_s(float lo,float hi){f32x2_t v={lo,hi};bf16x2_t b=__builtin_convertvector(v,bf16x2_t);return __builtin_bit_cast(unsigned,b);}
#define WAIT_BAR(N) asm volatile("s_waitcnt vmcnt(" #N ") lgkmcnt(0)\n\ts_barrier":::"memory")

__device__ __forceinline__ void qkt(f32x16&p0,f32x16&p1,const char*Kslot,const bf16x8*qr,const f32x16&negm,int r32,int hi){
  const char*kb=Kslot+hi*1024+r32*16;
  #pragma unroll
  for(int d0=0;d0<4;++d0){
    const bf16x8 b0=*reinterpret_cast<const bf16x8*>(kb+d0*2048);
    const bf16x8 b1=*reinterpret_cast<const bf16x8*>(kb+d0*2048+512);
    if(d0==0){p0=__builtin_amdgcn_mfma_f32_32x32x16_bf16(b0,qr[0],negm,0,0,0);p1=__builtin_amdgcn_mfma_f32_32x32x16_bf16(b1,qr[0],negm,0,0,0);}
    else{p0=__builtin_amdgcn_mfma_f32_32x32x16_bf16(b0,qr[d0],p0,0,0,0);p1=__builtin_amdgcn_mfma_f32_32x32x16_bf16(b1,qr[d0],p1,0,0,0);}}
}
typedef __attribute__((address_space(3))) const char* lds_cptr;
typedef short v4i16_t __attribute__((ext_vector_type(4)));
__device__ __forceinline__ void kload8(bf16x8*kf,lds_cptr kp){
  kf[0]=*(const __attribute__((address_space(3))) bf16x8*)(kp);      kf[1]=*(const __attribute__((address_space(3))) bf16x8*)(kp+512);
  kf[2]=*(const __attribute__((address_space(3))) bf16x8*)(kp+2048); kf[3]=*(const __attribute__((address_space(3))) bf16x8*)(kp+2560);
  kf[4]=*(const __attribute__((address_space(3))) bf16x8*)(kp+4096); kf[5]=*(const __attribute__((address_space(3))) bf16x8*)(kp+4608);
  kf[6]=*(const __attribute__((address_space(3))) bf16x8*)(kp+6144); kf[7]=*(const __attribute__((address_space(3))) bf16x8*)(kp+6656);
}
__device__ __forceinline__ void kload2(bf16x8*kf,lds_cptr kp,int j){ kf[2*j]=*(const __attribute__((address_space(3))) bf16x8*)(kp+j*2048); kf[2*j+1]=*(const __attribute__((address_space(3))) bf16x8*)(kp+j*2048+512); }
__device__ __forceinline__ s16x4 vtr(lds_cptr p){ return __builtin_bit_cast(s16x4,__builtin_amdgcn_ds_read_tr16_b64_v4i16((__attribute__((address_space(3))) v4i16_t*)p)); }
__device__ __forceinline__ float rowmax(const f32x16&p0,const f32x16&p1){
  float a=max3f(p0[0],p0[1],p1[0]),b=max3f(p0[2],p0[3],p1[1]);a=max3f(a,p1[2],p1[3]);
  #pragma unroll
  for(int r=4;r<16;r+=4){a=max3f(a,p0[r],p0[r+1]);b=max3f(b,p0[r+2],p0[r+3]);a=max3f(a,p1[r],p1[r+1]);b=max3f(b,p1[r+2],p1[r+3]);}
  const float m=max2f(a,b);
  auto rr=__builtin_amdgcn_permlane32_swap(__float_as_uint(m),__float_as_uint(m),false,false);
  return max2f(__uint_as_float(rr[0]),__uint_as_float(rr[1]));
}
__device__ __forceinline__ void pv(f32x16*o,int vb,bf16x8 pa0,bf16x8 pa1,bf16x8 pa2,bf16x8 pa3){
  #pragma unroll
  for(int d0=0;d0<2;++d0){s16x4 lo[4],hi[4];
    #pragma unroll
    for(int ks=0;ks<4;++ks){
      asm volatile("ds_read_b64_tr_b16 %0,%1 offset:%c2":"=&v"(lo[ks]):"v"(vb),"i"(d0*4096+ks*1024):"memory");
      asm volatile("ds_read_b64_tr_b16 %0,%1 offset:%c2":"=&v"(hi[ks]):"v"(vb),"i"(d0*4096+ks*1024+512):"memory");}
    asm volatile("s_waitcnt lgkmcnt(0)":::"memory");SBAR();
    #define PK(k) (bf16x8){lo[k][0],lo[k][1],lo[k][2],lo[k][3],hi[k][0],hi[k][1],hi[k][2],hi[k][3]}
    o[d0]=__builtin_amdgcn_mfma_f32_32x32x16_bf16(pa0,PK(0),o[d0],0,0,0);
    o[d0]=__builtin_amdgcn_mfma_f32_32x32x16_bf16(pa1,PK(1),o[d0],0,0,0);
    o[d0]=__builtin_amdgcn_mfma_f32_32x32x16_bf16(pa2,PK(2),o[d0],0,0,0);
    o[d0]=__builtin_amdgcn_mfma_f32_32x32x16_bf16(pa3,PK(3),o[d0],0,0,0);
    #undef PK
  }
}

#ifndef ATTN_STORE16
#define ATTN_STORE16(p,v) (*(u32x4*)(p)=(v))
#endif
template<int MODE,int THRL> __device__ __forceinline__ void attn_unit(int b,int h,int qb,const bf16*Q,const bf16*__restrict__ K,const bf16*__restrict__ V,bf16*O,char*shm,const float*aux0,const float*aux1,const float*aux2){
  int tid_l=threadIdx.x; asm volatile("":"+v"(tid_l)); const int tid=tid_l,lane=tid&63,r32=lane&31,hi=lane>>5; const int wid=__builtin_amdgcn_readfirstlane(tid>>6);
  const long rowbase=(long)b*SEQ; const int q0=qb*QB;
  const bf16*Qw=Q+(rowbase+q0+wid*QBLK)*DM+h*D;
  bf16x8 qr[4];
  #pragma unroll
  for(int d0=0;d0<4;++d0)qr[d0]=*reinterpret_cast<const bf16x8*>(&Qw[(long)r32*DM+d0*16+hi*8]);
  float cvk[16];
  int T0;
  if(MODE==1){ T0=(4*qb-8)>0?(4*qb-8):0; }
  else {
    const lds_fptr bp0=(lds_fptr)((lds_cptr)shm+TAB_OFF)+8192;
    const float*cum0=aux0+(long)(b*NHEAD+h)*SEQ; const int ntp=q0/KVBLK, nkeys0=q0+QB;
    #pragma unroll
    for(int u=0;u<16;++u){ const int jj=tid+512*u; cvk[u]=(jj<nkeys0)?cum0[jj]:0.f; }
    float gq=fabsf(aux2[128+lane]), gk=fabsf(aux2[192+lane]); const float cq0=cum0[q0];
    const float ce0=(lane<ntp)?cum0[64*lane+63]:0.f, ce1=(lane+64<ntp)?cum0[64*(lane+64)+63]:0.f;
    if(wid==0){ const float a=aux1[(b*128+lane)*32+h], c=aux1[(b*128+64+lane)*32+h]; float sa=a, sc=c;
      #pragma unroll
      for(int o=1;o<64;o<<=1){ const float ta=__shfl_up(sa,o), tc=__shfl_up(sc,o); if(lane>=o){sa+=ta;sc+=tc;} }
      const float tot=__shfl(sa,63); bp0[lane]=sa-a; bp0[64+lane]=tot+sc-c; }
    asm volatile("s_waitcnt vmcnt(0) lgkmcnt(0)\n\ts_barrier":::"memory");
    #pragma unroll
    for(int o=1;o<64;o<<=1){ gq=fmaxf(gq,__shfl_xor(gq,o)); gk=fmaxf(gk,__shfl_xor(gk,o)); }
    const float thr=-(cq0+bp0[q0>>6])*LOG2E-(2.05f*8.f*LOG2E*gq*gk+44.f);
    bool c0=false,c1=false;
    if(lane<ntp) c0=(-(ce0+bp0[lane])*LOG2E<thr);
    if(lane+64<ntp) c1=(-(ce1+bp0[lane+64])*LOG2E<thr);
    const int cnt=__popcll(__ballot(c0))+__popcll(__ballot(c1));
    T0=__builtin_amdgcn_readfirstlane(cnt&~1);
  }
  const bf16*Kh=K+(rowbase+(long)T0*KVBLK)*DM+h*D,*Vh=V+(rowbase+(long)T0*KVBLK)*DM+h*D;
  const unsigned lds0=(unsigned)(uintptr_t)shm;
  float*wsf=(float*)(shm+LDS_WS)+wid*64;
  const bf16*ksrc=Kh+(long)lane*DM+wid*8;
  const bf16*vsrc=Vh+(long)(16*(wid&3)+(lane>>2))*DM+(wid>>2)*32+(lane&3)*8;
  const unsigned kdst=lds0+LDS_K+wid*1024, vdst=lds0+LDS_V+wid*1024;
  #define DMA_K(t,slot) glds16(ksrc+(long)(t)*KVBLK*DM,(unsigned)__builtin_amdgcn_readfirstlane(kdst+(slot)))
  #define DMA_V(t,slot) glds16(vsrc+(long)(t)*KVBLK*DM,(unsigned)__builtin_amdgcn_readfirstlane(vdst+(slot)))
  const int vb0=(int)(lds0+LDS_V)+((lane>>4)&1)*32+(lane&3)*8+(4*hi+((lane&15)>>2))*64;
  const char*Kbase=shm+LDS_K; bf16x8 kf[8];
  const lds_cptr shm3=(lds_cptr)shm; const lds_cptr kp0=shm3+LDS_K+hi*1024+r32*16; const lds_cptr vp0=shm3+LDS_V+((lane>>4)&1)*32+(lane&3)*8+(4*hi+((lane&15)>>2))*64;
  const int NT=(q0+QB)/KVBLK-T0;
  const lds_fptr tab=(lds_fptr)(shm3+TAB_OFF);
  const int dbase=4*qb+(wid>>1)-T0, ibase=32*(wid&1)+r32+128; const lds_fptr tabh=(MODE==0)?tab+64*T0:tab;
  if(MODE==0){
    const lds_fptr bp=tab+8192;
    const int nkeys=q0+QB;
    #pragma unroll
    for(int u=0;u<16;++u){ const int jj=tid+512*u; if(jj>=64*T0&&jj<nkeys) tab[jj]=-(cvk[u]+bp[jj>>6])*LOG2E; }
  } else {
    if(tid<257) tab[tid]=aux0[tid]*LOG2E;
  }
  DMA_K(0,0);DMA_V(0,0);DMA_K(1,SLOTB);
  float mhat=0.f,l_reg=0.f;f32x16 o[2];o[0]=f32x16{};o[1]=f32x16{};f32x16 negm=f32x16{};asm volatile("":"+v"(negm));
  const int qrel=wid*QBLK+r32;
  #define CMASK(P0,P1,t) hook<MODE>(P0,P1,(t),NT,qrel,hi,tabh,dbase,ibase)
  bool resc=false;
  #define START(P0,P1) do{ const float rm=rowmax(P0,P1); resc=false; \
    { const float dl=rm; mhat=fadd_s(mhat,dl); \
      _Pragma("unroll") for(int r=0;r<16;++r){P0[r]=fsub_s(P0[r],dl);P1[r]=fsub_s(P1[r],dl);} \
      _Pragma("unroll") for(int r=0;r<16;++r)negm[r]=-mhat; asm volatile("":"+v"(negm)); } \
    _Pragma("unroll") for(int r=0;r<16;++r)P0[r]=__builtin_amdgcn_exp2f(P0[r]); }while(0)
  #define RESC() do{ if(resc){ asm volatile("s_waitcnt lgkmcnt(0)":::"memory"); \
      _Pragma("unroll") for(int d_=0;d_<2;++d_) _Pragma("unroll") for(int r=0;r<16;++r)o[d_][r]*=wsf[crow(r,hi)]; } }while(0)
  f32x16 pA0,pA1,pB0,pB1;
  int sl_prev=0,sl_cur=0,sl_next=SLOTB;
  #define ROT() do{sl_prev=sl_cur;sl_cur=sl_next;sl_next=(sl_next==(NSLOT-1)*SLOTB)?0:sl_next+SLOTB;}while(0)
  DMA_K(2,2*SLOTB);
  WAIT_BAR(3);
  qkt(pA0,pA1,Kbase,qr,negm,r32,hi);asm volatile("s_nop 15\n\ts_nop 7":"+v"(pA0),"+v"(pA1));CMASK(pA0,pA1,0);
  START(pA0,pA1);
  _Pragma("unroll") for(int r=0;r<16;++r)pA1[r]=__builtin_amdgcn_exp2f(pA1[r]);
  WAIT_BAR(0);
  DMA_K(3,0);DMA_V(1,SLOTB);
  ROT();
  kload8(kf,kp0+sl_cur);
  WAIT_BAR(2);
  s16x4 vlo[8],vhi[8]; u32x4 pw0,pw1,pw2,pw3;
  #define PKW(P,B) cvtpk_s(P[B],P[B+1])
  #define PAF(k) __builtin_bit_cast(bf16x8,pw##k)
  #define VFR(i) (bf16x8){vlo[i][0],vlo[i][1],vlo[i][2],vlo[i][3],vhi[i][0],vhi[i][1],vhi[i][2],vhi[i][3]}
  #define PIN(x) asm volatile("":"+v"(x))
  #define MX3(a,b,c) __builtin_fmaxf(__builtin_fmaxf((a),(b)),(c))
  #define GAPA(MF,A0,A1,A2,A3,W0,W1,PW) do{ MF; sacc+=A0; sacc+=A1; sacc+=A2; sacc+=A3; PIN(sacc); W0; W1; PIN(PW); SBAR(); }while(0)
  #define EX(v) __builtin_amdgcn_exp2f(v)
  #define GAPB(MF,X,B) do{ MF; X[B]=EX(X[B]); X[B+1]=EX(X[B+1]); X[B+2]=EX(X[B+2]); X[B+3]=EX(X[B+3]); PIN(X); SBAR(); }while(0)
  #define VRD(i) do{ vlo[i]=vtr(vp_+(((i)>>2)*4096+((i)&3)*1024)); vhi[i]=vtr(vp_+(((i)>>2)*4096+((i)&3)*1024+512)); }while(0)
  #define KRD(G,j) do{ if(G){ kload2(kf,kp0+sl_next,j); SBAR(); } }while(0)
  #define STEP(C0,C1,P0,P1,t,GK,GV,GL) do{ SBAR(); \
    const lds_cptr vp_=vp0+sl_prev; \
    VRD(0); SBAR(); float sacc=(P0[0]+P0[1]); \
    GAPA(C0=__builtin_amdgcn_mfma_f32_32x32x16_bf16(kf[0],qr[0],negm,0,0,0), P0[2],P0[3],P0[4],P0[5],     pw0[0]=PKW(P0,0), pw0[1]=PKW(P0,2), pw0); \
    VRD(4); SBAR(); GAPA(C1=__builtin_amdgcn_mfma_f32_32x32x16_bf16(kf[1],qr[0],negm,0,0,0), P0[6],P0[7],P0[8],P0[9],     pw0[2]=PKW(P0,4), pw0[3]=PKW(P0,6), pw0); \
    VRD(1); SBAR(); GAPA(C0=__builtin_amdgcn_mfma_f32_32x32x16_bf16(kf[2],qr[1],C0,0,0,0),   P0[10],P0[11],P0[12],P0[13], pw1[0]=PKW(P0,8), pw1[1]=PKW(P0,10), pw1); \
    VRD(5); SBAR(); GAPA(C1=__builtin_amdgcn_mfma_f32_32x32x16_bf16(kf[3],qr[1],C1,0,0,0),   P0[14],P0[15],P1[0],P1[1],   pw1[2]=PKW(P0,12),pw1[3]=PKW(P0,14), pw1); \
    VRD(2); SBAR(); GAPA(C0=__builtin_amdgcn_mfma_f32_32x32x16_bf16(kf[4],qr[2],C0,0,0,0),   P1[2],P1[3],P1[4],P1[5],     pw2[0]=PKW(P1,0), pw2[1]=PKW(P1,2), pw2); \
    VRD(6); SBAR(); GAPA(C1=__builtin_amdgcn_mfma_f32_32x32x16_bf16(kf[5],qr[2],C1,0,0,0),   P1[6],P1[7],P1[8],P1[9],     pw2[2]=PKW(P1,4), pw2[3]=PKW(P1,6), pw2); \
    VRD(3); SBAR(); GAPA(C0=__builtin_amdgcn_mfma_f32_32x32x16_bf16(kf[6],qr[3],C0,0,0,0),   P1[10],P1[11],P1[12],P1[13], pw3[0]=PKW(P1,8), pw3[1]=PKW(P1,10), pw3); \
    VRD(7); SBAR(); GAPA(C1=__builtin_amdgcn_mfma_f32_32x32x16_bf16(kf[7],qr[3],C1,0,0,0),   P1[14],P1[15],0.f,0.f,       pw3[2]=PKW(P1,12),pw3[3]=PKW(P1,14), pw3); \
    l_reg+=sacc; \
    if(GK){DMA_K((t)+3,sl_cur);} if(GV){DMA_V((t)+1,sl_next);} \
    CMASK(C0,C1,t); \
    { float a=MX3(C0[0],C0[1],C1[0]),b=MX3(C0[2],C0[3],C1[1]); a=MX3(a,C1[2],C1[3]); \
      _Pragma("unroll") for(int r=4;r<16;r+=4){a=MX3(a,C0[r],C0[r+1]);b=MX3(b,C0[r+2],C0[r+3]);a=MX3(a,C1[r],C1[r+1]);b=MX3(b,C1[r+2],C1[r+3]);} \
      float rm=__builtin_fmaxf(a,b); { auto rr=__builtin_amdgcn_permlane32_swap(__float_as_uint(rm),__float_as_uint(rm),false,false); rm=__builtin_fmaxf(__uint_as_float(rr[0]),__uint_as_float(rr[1])); } \
      resc=false; \
      if(__builtin_expect(__any(rm>(float)THRL),0)){ const float dl=__builtin_fmaxf(rm,0.f); mhat+=dl; \
        _Pragma("unroll") for(int r=0;r<16;++r){C0[r]-=dl;C1[r]-=dl;} \
        _Pragma("unroll") for(int r=0;r<16;++r)negm[r]=-mhat; asm volatile("":"+v"(negm)); \
        const float f=__builtin_amdgcn_exp2f(-dl); l_reg*=f; if(hi==0)wsf[r32]=f; resc=true; } } \
    SBAR(); \
    GAPB(o[0]=__builtin_amdgcn_mfma_f32_32x32x16_bf16(PAF(0),VFR(0),o[0],0,0,0), C0,0); \
    GAPB(o[1]=__builtin_amdgcn_mfma_f32_32x32x16_bf16(PAF(0),VFR(4),o[1],0,0,0), C0,4); \
    KRD(GL,0); GAPB(o[0]=__builtin_amdgcn_mfma_f32_32x32x16_bf16(PAF(1),VFR(1),o[0],0,0,0), C0,8); \
    KRD(GL,1); GAPB(o[1]=__builtin_amdgcn_mfma_f32_32x32x16_bf16(PAF(1),VFR(5),o[1],0,0,0), C0,12); \
    KRD(GL,2); GAPB(o[0]=__builtin_amdgcn_mfma_f32_32x32x16_bf16(PAF(2),VFR(2),o[0],0,0,0), C1,0); \
    KRD(GL,3); GAPB(o[1]=__builtin_amdgcn_mfma_f32_32x32x16_bf16(PAF(2),VFR(6),o[1],0,0,0), C1,4); \
    GAPB(o[0]=__builtin_amdgcn_mfma_f32_32x32x16_bf16(PAF(3),VFR(3),o[0],0,0,0), C1,8); \
    GAPB(o[1]=__builtin_amdgcn_mfma_f32_32x32x16_bf16(PAF(3),VFR(7),o[1],0,0,0), C1,12); \
    }while(0)
  int t=1;
  for(;t+5<NT;t+=2){
    STEP(pB0,pB1,pA0,pA1,t,true,true,true);     WAIT_BAR(2); RESC(); ROT();
    STEP(pA0,pA1,pB0,pB1,t+1,true,true,true);   WAIT_BAR(2); RESC(); ROT();
  }
  #define ENDW(tt) do{ if((tt)+3<NT){WAIT_BAR(2);} else if((tt)+2<NT){WAIT_BAR(1);} else {WAIT_BAR(0);} }while(0)
  for(;t+1<NT;t+=2){
    STEP(pB0,pB1,pA0,pA1,t,(t+3<NT),(t+1<NT),(t+1<NT));       ENDW(t);   RESC(); ROT();
    STEP(pA0,pA1,pB0,pB1,t+1,(t+4<NT),(t+2<NT),(t+2<NT));     ENDW(t+1); RESC(); ROT();
  }
  STEP(pB0,pB1,pA0,pA1,NT-1,false,false,false); RESC();
  { float sacc=pB0[0]+pB0[1]; _Pragma("unroll") for(int r=2;r<16;++r)sacc+=pB0[r]; _Pragma("unroll") for(int r=0;r<16;++r)sacc+=pB1[r]; l_reg+=sacc;
    pw0=(u32x4){PKW(pB0,0),PKW(pB0,2),PKW(pB0,4),PKW(pB0,6)};pw1=(u32x4){PKW(pB0,8),PKW(pB0,10),PKW(pB0,12),PKW(pB0,14)};pw2=(u32x4){PKW(pB1,0),PKW(pB1,2),PKW(pB1,4),PKW(pB1,6)};pw3=(u32x4){PKW(pB1,8),PKW(pB1,10),PKW(pB1,12),PKW(pB1,14)};
    SBAR(); pv(o,vb0+sl_cur,PAF(0),PAF(1),PAF(2),PAF(3)); }
  #undef PKW
  #undef PAF
  #undef VFR
  #undef PIN
  #undef MX3
  #undef GAPA
  #undef GAPB
  #undef EX
  #undef VRD
  #undef KRD
  #undef STEP
  #undef ENDW
  {auto rr=__builtin_amdgcn_permlane32_swap(__float_as_uint(l_reg),__float_as_uint(l_reg),false,false);l_reg=__uint_as_float(rr[0])+__uint_as_float(rr[1]);}
  if(hi==0)wsf[32+r32]=l_reg;asm volatile("s_waitcnt lgkmcnt(0)":::"memory");
  float rli[16];
  #pragma unroll
  for(int r=0;r<16;++r)rli[r]=__builtin_amdgcn_rcpf(wsf[32+crow(r,hi)]);
  bf16*Ow=O+(rowbase+q0+wid*QBLK)*DM+h*D;
  { bf16*stg=(bf16*)(shm+LDS_OST)+wid*2048;
    #pragma unroll
    for(int r=0;r<16;++r){const int orow=crow(r,hi);
      #pragma unroll
      for(int d0=0;d0<2;++d0)stg[orow*64+d0*32+r32]=__float2bfloat16(o[d0][r]*rli[r]);}
    asm volatile("s_waitcnt lgkmcnt(0)":::"memory");
    #pragma unroll
    for(int i=0;i<4;++i){const int row=i*8+(lane>>3),ch=lane&7; const u32x4 v=*(const u32x4*)(stg+row*64+ch*8); ATTN_STORE16(Ow+(long)row*DM+ch*8,v);} }
  asm volatile("s_waitcnt lgkmcnt(0)\n\ts_barrier":::"memory");
  #undef DMA_K
  #undef DMA_V
  #undef CMASK
  #undef START
  #undef RESC
  #undef ROT
}
constexpr int ATTN_LDS_BYTES=LDS_BYTES_ALL;
#undef SBAR
#undef WAIT_BAR
}

constexpr int NWAVES = 8;
constexpr int M = 16384, D = 1024, FF = 2816, NGU = 5632, NIN = 6656, DIN = 6664, SEQ = 8192;
constexpr size_t MiB = 1u << 20;
constexpr size_t WS_MOD = 0;
constexpr size_t WS_WF = 256 * 1024;
constexpr size_t WS_BT = 320 * 1024;
constexpr size_t WS_CTL = 1536 * 1024, CTL_ZERO_BYTES = 131072;
constexpr size_t WS_XBUF = WS_CTL + 131072;
constexpr size_t WS_CUM = 1 * MiB;
constexpr size_t WS_WGU = 2 * MiB;
constexpr size_t WS_WD = WS_WGU + 22 * MiB;
constexpr size_t WS_WIN = WS_WD + 11 * MiB;
constexpr size_t WS_WBR = WS_WIN + 13 * MiB;
constexpr size_t WS_WO = WS_WBR + 3 * MiB;
constexpr size_t WS_XN = 54 * MiB;
constexpr size_t WS_BIG = 86 * MiB;
constexpr size_t SLOT = 16 * MiB;
constexpr size_t WS_G = WS_BIG + 8 * SLOT;
constexpr size_t WS_MG = WS_BIG + 3 * SLOT;
constexpr size_t WS_END = WS_G + 96 * MiB;
static_assert(WS_WO + 2 * MiB <= WS_XN, "weights fit");
constexpr int LDS_BYTES = 147456;

#define LAS __attribute__((address_space(3)))
typedef unsigned short bf16;
typedef unsigned v4u __attribute__((ext_vector_type(4)));
typedef float f32x4 __attribute__((ext_vector_type(4)));
#define LDS_WAIT() asm volatile("s_waitcnt lgkmcnt(0)" ::: "memory")
__device__ __forceinline__ unsigned f2bf(float f) { unsigned u = __builtin_bit_cast(unsigned, f); return (u + 0x7fffu + ((u >> 16) & 1u)) >> 16; }
__device__ __forceinline__ unsigned pk2(float lo, float hi) { return f2bf(lo) | (f2bf(hi) << 16); }
__device__ __forceinline__ float wave_sum(float v) {
#pragma unroll
    for (int o = 1; o < 64; o <<= 1) v += __shfl_xor(v, o);
    return v;
}
__device__ __forceinline__ float silu_f(float x) { return x / (1.0f + __expf(-x)); }

__device__ __forceinline__ void transpose_item(const float* __restrict__ W, int ldw, int k0, int c0, bf16* WT, int K, int drow0, LAS float* scr, int lane) {
    { const int kr = lane >> 3, n4 = lane & 7;
      f32x4 v[8];
#pragma unroll
      for (int i = 0; i < 8; ++i) v[i] = *(const f32x4*)(W + (size_t)(k0 + 8 * i + kr) * ldw + c0 + 4 * n4);
#pragma unroll
      for (int i = 0; i < 8; ++i) { LAS float* p = scr + (8 * i + kr) * 33 + 4 * n4; p[0] = v[i].x; p[1] = v[i].y; p[2] = v[i].z; p[3] = v[i].w; } }
    LDS_WAIT(); asm volatile("" ::: "memory");
    const int c = lane & 7;
#pragma unroll
    for (int j = 0; j < 4; ++j) { const int n = (lane >> 3) + 8 * j; const LAS float* s = scr + (8 * c) * 33 + n;
        v4u o; o.x = pk2(s[0 * 33], s[1 * 33]); o.y = pk2(s[2 * 33], s[3 * 33]); o.z = pk2(s[4 * 33], s[5 * 33]); o.w = pk2(s[6 * 33], s[7 * 33]);
        *(v4u*)(WT + (size_t)(drow0 + n) * K + k0 + 8 * c) = o; }
    LDS_WAIT(); asm volatile("" ::: "memory");
}

#define XB_TMO      128
#define XB_XCNT(j)  (256  + 64 * (j))
#define XB_XSUB(j)  (1280 + 64 * (j))
#define XB_XGEN(j)  (2304 + 64 * (j))
#define XB_TOP      3328
#define XB_TOPGEN   3392
#define XCD_BAR_WORDS 3456
#define XB_SPIN_CAP (1u << 18)

__device__ __forceinline__ unsigned xb_ld(unsigned* p)              { return __hip_atomic_load(p, __ATOMIC_RELAXED, __HIP_MEMORY_SCOPE_AGENT); }
__device__ __forceinline__ unsigned xb_add(unsigned* p, unsigned v) { return __hip_atomic_fetch_add(p, v, __ATOMIC_RELAXED, __HIP_MEMORY_SCOPE_AGENT); }
__device__ __forceinline__ unsigned xb_xcc_id() { return (unsigned)__builtin_amdgcn_s_getreg((3 << 11) | 20) & 0xFu; }
#define XB_SPIN(cond, bar) do { unsigned _sp = 0; while (cond) { __builtin_amdgcn_s_sleep(1); \
    if ((++_sp & 255u) == 0u) { if (xb_ld(&(bar)[XB_TMO])) break; if (_sp > XB_SPIN_CAP) { atomicAdd(&(bar)[XB_TMO], 1u); break; } } } } while (0)

struct XcdBarrier {
    unsigned* bar; unsigned x;
    volatile LAS unsigned* st;
};

__device__ __forceinline__ XcdBarrier xcd_barrier_post(unsigned* bar, volatile LAS unsigned* st) {
    XcdBarrier b; b.bar = bar; b.x = xb_xcc_id(); b.st = st;
    if (threadIdx.x == 0) (void)xb_add(&bar[XB_XCNT(b.x)], 1u);
    return b;
}
__device__ __forceinline__ void xcd_barrier_complete(unsigned* bar, unsigned x, unsigned& nloc, unsigned& nx) {
    const unsigned G = gridDim.x * gridDim.y * gridDim.z;
    unsigned sum, cnt, mine, sp = 0u;
    for (;;) {
        sum = 0u; cnt = 0u; mine = 0u;
#pragma unroll
        for (unsigned j = 0; j < 16; ++j) { const unsigned c = xb_ld(&bar[XB_XCNT(j)]); sum += c; cnt += (c > 0u) ? 1u : 0u; mine = (j == x) ? c : mine; }
        if (sum == G) break;
        __builtin_amdgcn_s_sleep(1);
        if ((++sp & 255u) == 0u) { if (xb_ld(&bar[XB_TMO])) break; if (sp > XB_SPIN_CAP) { atomicAdd(&bar[XB_TMO], 1u); break; } }
    }
    nloc = mine > 0u ? mine : 1u; nx = cnt > 0u ? cnt : 1u;
}

__device__ __forceinline__ void xcd_barrier(const XcdBarrier& b) {
    asm volatile("s_waitcnt vmcnt(0)" ::: "memory");
    __syncthreads();
    if (threadIdx.x == 0) {
        unsigned* bar = b.bar;
        __builtin_amdgcn_s_waitcnt(0);
        unsigned nloc = b.st[0], nx = b.st[1];
        if (nloc == 0u) { xcd_barrier_complete(bar, b.x, nloc, nx); b.st[0] = nloc; b.st[1] = nx; }
        const unsigned old = xb_add(&bar[XB_XSUB(b.x)], 1u);
        const unsigned gen = old / nloc;
        if (old + 1u == (gen + 1u) * nloc) {
            __builtin_amdgcn_fence(__ATOMIC_RELEASE, "agent");
            asm volatile("s_waitcnt vmcnt(0)" ::: "memory");
            const unsigned og = xb_add(&bar[XB_TOP], 1u);
            const unsigned tg = og / nx;
            if (og + 1u == (tg + 1u) * nx) xb_add(&bar[XB_TOPGEN], 1u);
            else XB_SPIN(xb_ld(&bar[XB_TOPGEN]) == tg, bar);
            __builtin_amdgcn_fence(__ATOMIC_ACQUIRE, "agent");
            xb_add(&bar[XB_XGEN(b.x)], 1u);
            asm volatile("s_waitcnt vmcnt(0)" ::: "memory");
        } else {
            XB_SPIN(xb_ld(&bar[XB_XGEN(b.x)]) == gen, bar);
            __builtin_amdgcn_fence(__ATOMIC_ACQUIRE, "agent");
            asm volatile("s_waitcnt vmcnt(0)" ::: "memory");
        }
    }
    __syncthreads();
}

struct Args { const float* in[16]; float* out; unsigned char* ws; int cg_seam, pad; };
__device__ __forceinline__ const float* argp(int i) { auto ka = __builtin_amdgcn_kernarg_segment_ptr(); const __attribute__((address_space(1))) float* r; asm volatile("s_load_dwordx2 %0, %1, %2\n\ts_waitcnt lgkmcnt(0)" : "=s"(r) : "s"(ka), "i"(i * 8) : "memory"); return (const float*)r; }
#define ARG_IN(i) argp(i)
#define ARG_OUT ((float*)argp(16))
#define ARG_WS ((unsigned char*)argp(17))
__device__ __forceinline__ int arg_cg_seam() { auto ka = __builtin_amdgcn_kernarg_segment_ptr(); int r; asm volatile("s_load_dword %0, %1, 144\n\ts_waitcnt lgkmcnt(0)" : "=s"(r) : "s"(ka) : "memory"); return r; }

__device__ __forceinline__ void mod_phase(int j0, int j1, LAS unsigned char* lds, int vcu, int G, int tid, int wave, int lane) {
    unsigned char* ws_ = ARG_WS; float* MOD = (float*)(ws_ + WS_MOD); const float* c = ARG_IN(1); const float* w_ada = ARG_IN(2); const float* b_ada = ARG_IN(3);
    LAS float* part = (LAS float*)lds;
    for (int job = j0 + vcu; job < j1; job += G) {
        const int lm = job / 144, colbase = (job % 144) * 64, kk = lane >> 4, c4 = lane & 15;
        f32x4 acc0 = {0.f, 0.f, 0.f, 0.f}, acc1 = {0.f, 0.f, 0.f, 0.f};
        const float* wp = w_ada + ((size_t)lm * 1024 + wave * 128 + kk) * 9216 + colbase + 4 * c4;
#pragma unroll 8
        for (int i = 0; i < 32; ++i) { const int k = wave * 128 + 4 * i + kk; const f32x4 wv = *(const f32x4*)(wp + (size_t)i * 4 * 9216); const float a0 = silu_f(c[k]), a1 = silu_f(c[1024 + k]); acc0 += a0 * wv; acc1 += a1 * wv; }
#pragma unroll
        for (int e = 0; e < 4; ++e) { acc0[e] += __shfl_xor(acc0[e], 16); acc0[e] += __shfl_xor(acc0[e], 32); acc1[e] += __shfl_xor(acc1[e], 16); acc1[e] += __shfl_xor(acc1[e], 32); }
        if (kk == 0) { *(LAS f32x4*)(part + (wave * 2 + 0) * 64 + 4 * c4) = acc0; *(LAS f32x4*)(part + (wave * 2 + 1) * 64 + 4 * c4) = acc1; }
        __syncthreads();
        if (tid < 128) { const int b = tid >> 6, col = tid & 63; float s = b_ada[lm * 9216 + colbase + col];
#pragma unroll
          for (int w = 0; w < 8; ++w) s += part[(w * 2 + b) * 64 + col];
          MOD[(size_t)(lm * 2 + b) * 9216 + colbase + col] = s; }
        __syncthreads();
    }
}

__device__ __forceinline__ void weights_phase(int l, LAS unsigned char* lds, int vcu, int G, int wave, int lane) {
    LAS float* scr = (LAS float*)(lds + wave * 16384); unsigned char* ws_ = ARG_WS;
    bf16* WGU = (bf16*)(ws_ + WS_WGU); bf16* WD = (bf16*)(ws_ + WS_WD); bf16* WIN = (bf16*)(ws_ + WS_WIN); bf16* WBR = (bf16*)(ws_ + WS_WBR); bf16* WO = (bf16*)(ws_ + WS_WO);
    constexpr int IT_EFF = 1024, IT_GU = 2 * 2 * 16 * 88, IT_DN = 2 * 44 * 32, IT_IN = 16 * 208, IT_BR = 2 * 8 * 32, IT_WO = 16 * 32, IT_WF = 128, NITEMS = IT_EFF + IT_GU + IT_DN + IT_IN + IT_BR + IT_WO + IT_WF;
    const int gw = vcu * NWAVES + wave, NGW = G * NWAVES;
    for (int it = gw; it < NITEMS; it += NGW) {
        int r = it;
        if (r < IT_EFF) {
            const int cblk = r & 127, kh = (r >> 7) & 1, g = r >> 8, ci = kh * 64 + lane;
            const float* wp = ARG_IN(12) + ((size_t)(l * 4 + g) * 128 + ci) * 128; const float* ps = ARG_IN(13) + l * 512 + g * 128;
            const float* wb = ARG_IN(14) + ((size_t)(l * 3 + 1) * 512 + g * 128) * 1024 + cblk * 8;
            f32x4 a0 = {0.f, 0.f, 0.f, 0.f}, a1 = {0.f, 0.f, 0.f, 0.f};
#pragma unroll 16
            for (int e = 0; e < 128; ++e) { const float cf = wp[e] * ps[e]; a0 += cf * *(const f32x4*)(wb + (size_t)e * 1024); a1 += cf * *(const f32x4*)(wb + (size_t)e * 1024 + 4); }
            bf16* dst = WBR + (size_t)(1024 + cblk * 8) * 512 + g * 128 + ci;
            dst[0 * 512] = (bf16)f2bf(a0.x); dst[1 * 512] = (bf16)f2bf(a0.y); dst[2 * 512] = (bf16)f2bf(a0.z); dst[3 * 512] = (bf16)f2bf(a0.w);
            dst[4 * 512] = (bf16)f2bf(a1.x); dst[5 * 512] = (bf16)f2bf(a1.y); dst[6 * 512] = (bf16)f2bf(a1.z); dst[7 * 512] = (bf16)f2bf(a1.w);
        } else if ((r -= IT_EFF) < IT_GU) { const int j = r / 2816; r %= 2816; const int isup = r / 1408; r %= 1408; const int kb = r / 88, nb = r % 88, f0 = 32 * nb;
            const float* src = (isup ? ARG_IN(6) : ARG_IN(5)) + (size_t)(l * 2 + j) * 1024 * 2816;
            transpose_item(src, 2816, 64 * kb, f0, WGU + (size_t)j * NGU * 1024, 1024, 256 * (f0 >> 7) + 128 * isup + (f0 & 127), scr, lane);
        } else if ((r -= IT_GU) < IT_DN) { const int j = r / 1408; r %= 1408; const int kb = r / 32, nb = r % 32;
            transpose_item(ARG_IN(7) + (size_t)(l * 2 + j) * 2816 * 1024, 1024, 64 * kb, 32 * nb, WD + (size_t)j * 1024 * 2816, 2816, 32 * nb, scr, lane);
        } else if ((r -= IT_DN) < IT_IN) { const int kb = r / 208, nb = r % 208, L0 = 32 * nb, c0 = L0 < 3584 ? L0 : L0 + 8, pn = L0 >> 8, w = L0 & 255, hh = w >> 6, dh = (w >> 5) & 1;
            transpose_item(ARG_IN(8) + (size_t)l * 1024 * DIN, DIN, 64 * kb, c0, WIN, 1024, 256 * pn + 128 * dh + 32 * hh, scr, lane);
        } else if ((r -= IT_IN) < IT_BR) { const int n = (r / 256) * 2; r %= 256; const int kb = r / 32, nb = r % 32;
            transpose_item(ARG_IN(14) + (size_t)(l * 3 + n) * 512 * 1024, 1024, 64 * kb, 32 * nb, WBR, 512, n * 1024 + 32 * nb, scr, lane);
        } else if ((r -= IT_BR) < IT_WO) { const int kb = r / 32, nb = r % 32; transpose_item(ARG_IN(15) + (size_t)l * 1024 * 1024, 1024, 64 * kb, 32 * nb, WO, 1024, 32 * nb, scr, lane);
        } else { r -= IT_WO; float* WF = (float*)(ws_ + WS_WF); const int i = r * 64 + lane, hh = i >> 10, k = i & 1023; WF[i] = (ARG_IN(8) + (size_t)l * 1024 * DIN)[(size_t)k * DIN + 3584 + hh]; }
    }
}

__device__ __forceinline__ float log_sigmoid_f(float x) { return fminf(x, 0.f) - log1pf(__expf(-fabsf(x))); }

template <bool MIX>
__device__ __forceinline__ void norm_phase(const float* xin, int l, int sub, LAS unsigned char* lds, int vcu, int G, int tid, int wave, int lane) {
    unsigned char* ws_ = ARG_WS; const float* gain = ARG_IN(4) + (size_t)(l * 3 + sub) * 1024; const float* MOD = (const float*)(ws_ + WS_MOD);
    const float* shift = MOD + (size_t)(l * 2) * 9216 + (3 * sub) * 1024; const float* scale = shift + 1024;
    bf16* XN = (bf16*)(ws_ + WS_XN);
    LAS float* wfs = (LAS float*)lds; LAS float* lfs = (LAS float*)(lds + 32768);
    if (MIX) { const float* WF = (const float*)(ws_ + WS_WF); for (int i = tid; i < 8192; i += 512) wfs[i] = WF[i]; __syncthreads(); }
    for (int blk = vcu; blk < 256; blk += G) {
        const int b = blk >> 7;
#pragma unroll (MIX ? 2 : 4)
        for (int i = 0; i < 8; ++i) { const int rl = wave * 8 + i, row = blk * 64 + rl;
            const f32x4* xr = (const f32x4*)(xin + (size_t)row * 1024) + lane;
            f32x4 v[4]; float ss = 0.f;
#pragma unroll
            for (int j = 0; j < 4; ++j) { v[j] = xr[64 * j]; ss += (v[j].x * v[j].x + v[j].y * v[j].y) + (v[j].z * v[j].z + v[j].w * v[j].w); }
            const float rstd = 1.0f / sqrtf(wave_sum(ss) * (1.0f / 1024.0f) + 1e-6f);
            unsigned long long* o8 = (unsigned long long*)(XN + (size_t)row * 1024) + lane;
#pragma unroll
            for (int j = 0; j < 4; ++j) { const f32x4 g = ((const f32x4*)gain)[64 * j + lane], sc = ((const f32x4*)(scale + b * 9216))[64 * j + lane], sh = ((const f32x4*)(shift + b * 9216))[64 * j + lane];
                v[j] = (v[j] * rstd * g) * (1.0f + sc) + sh;
                o8[64 * j] = (unsigned long long)pk2(v[j].x, v[j].y) | ((unsigned long long)pk2(v[j].z, v[j].w) << 32); }
            if (MIX) { float keep = 0.f;
#pragma unroll
                for (int hh = 0; hh < 8; ++hh) { float p = 0.f;
#pragma unroll
                    for (int j = 0; j < 4; ++j) { const f32x4 w = *(const LAS f32x4*)(wfs + hh * 1024 + 4 * (64 * j + lane)); p += (v[j].x * w.x + v[j].y * w.y) + (v[j].z * w.z + v[j].w * w.w); }
                    p = wave_sum(p); keep = (lane == hh) ? p : keep; }
                if (lane < 8) lfs[rl * 8 + lane] = log_sigmoid_f(keep + ARG_IN(11)[l * 8 + lane]); }
        }
        if (MIX) { __syncthreads();
            float* CUM = (float*)(ws_ + WS_CUM); float* BT = (float*)(ws_ + WS_BT);
            float s = lfs[lane * 8 + wave];
#pragma unroll
            for (int o = 1; o < 64; o <<= 1) { const float t = __shfl_up(s, o); if (lane >= o) s += t; }
            CUM[(size_t)(b * 8 + wave) * SEQ + (blk & 127) * 64 + lane] = s; if (lane == 63) BT[blk * 32 + wave] = s;
            __syncthreads(); }
    }
}

__device__ __forceinline__ void f_phase(int l, LAS unsigned char* lds, int vcu, int G, int tid, int wave, int lane) {
    unsigned char* ws_ = ARG_WS; const bf16* XN = (const bf16*)(ws_ + WS_XN); const float* fb = ARG_IN(11) + l * 8;
    LAS float* wfs = (LAS float*)lds; LAS float* lfs = (LAS float*)(lds + 32768);
    { const float* WF = (const float*)(ws_ + WS_WF); for (int i = tid; i < 8192; i += 512) wfs[i] = WF[i]; __syncthreads(); }
    for (int blk = vcu; blk < 256; blk += G) {
        const int b = blk >> 7;
#pragma unroll 2
        for (int i = 0; i < 8; ++i) { const int rl = wave * 8 + i, row = blk * 64 + rl;
            const v4u* xr = (const v4u*)(XN + (size_t)row * 1024) + lane;
            const v4u a = xr[0], c = xr[64];
            const f32x4 h0 = {__uint_as_float(a.x << 16), __uint_as_float(a.x & 0xffff0000u), __uint_as_float(a.y << 16), __uint_as_float(a.y & 0xffff0000u)};
            const f32x4 h1 = {__uint_as_float(a.z << 16), __uint_as_float(a.z & 0xffff0000u), __uint_as_float(a.w << 16), __uint_as_float(a.w & 0xffff0000u)};
            const f32x4 h2 = {__uint_as_float(c.x << 16), __uint_as_float(c.x & 0xffff0000u), __uint_as_float(c.y << 16), __uint_as_float(c.y & 0xffff0000u)};
            const f32x4 h3 = {__uint_as_float(c.z << 16), __uint_as_float(c.z & 0xffff0000u), __uint_as_float(c.w << 16), __uint_as_float(c.w & 0xffff0000u)};
            float keep = 0.f;
#pragma unroll
            for (int hh = 0; hh < 8; ++hh) { const LAS f32x4* w = (const LAS f32x4*)(wfs + hh * 1024 + 8 * lane);
                const f32x4 w0 = w[0], w1 = w[1], w2 = w[128], w3 = w[129];
                float p = ((h0.x * w0.x + h0.y * w0.y) + (h0.z * w0.z + h0.w * w0.w)) + ((h1.x * w1.x + h1.y * w1.y) + (h1.z * w1.z + h1.w * w1.w))
                        + ((h2.x * w2.x + h2.y * w2.y) + (h2.z * w2.z + h2.w * w2.w)) + ((h3.x * w3.x + h3.y * w3.y) + (h3.z * w3.z + h3.w * w3.w));
                p = wave_sum(p); keep = (lane == hh) ? p : keep; }
            if (lane < 8) lfs[rl * 8 + lane] = log_sigmoid_f(keep + fb[lane]); }
        __syncthreads();
        { float* CUM = (float*)(ws_ + WS_CUM); float* BT = (float*)(ws_ + WS_BT);
          float s = lfs[lane * 8 + wave];
#pragma unroll
          for (int o = 1; o < 64; o <<= 1) { const float t = __shfl_up(s, o); if (lane >= o) s += t; }
          CUM[(size_t)(b * 8 + wave) * SEQ + (blk & 127) * 64 + lane] = s; if (lane == 63) BT[blk * 32 + wave] = s; }
        __syncthreads();
    }
}

__device__ __forceinline__ void pool_phase(const bf16* UB, bf16* DD, int vcu, int G, int tid) {
    for (int blk = vcu; blk < 256; blk += G) {
        const int t0 = (blk & 127) * 64, ch = (tid & 63) * 8, w = 2 << (ch >> 7);
        for (int i = 0; i < 8; ++i) { const int rl = (tid >> 6) + 8 * i, t = t0 + rl; const size_t row = (size_t)blk * 64 + rl; const int cnt = (t + 1 < w) ? t + 1 : w;
            float s[8], cur[8];
#pragma unroll
            for (int e = 0; e < 8; ++e) { s[e] = 0.f; cur[e] = 0.f; }
#pragma unroll
            for (int q = 0; q < 16; ++q) if (q < cnt) { const v4u u = *(const v4u*)(UB + (row - q) * 512 + ch);
                const float f[8] = {__uint_as_float(u.x << 16), __uint_as_float(u.x & 0xffff0000u), __uint_as_float(u.y << 16), __uint_as_float(u.y & 0xffff0000u), __uint_as_float(u.z << 16), __uint_as_float(u.z & 0xffff0000u), __uint_as_float(u.w << 16), __uint_as_float(u.w & 0xffff0000u)};
#pragma unroll
                for (int e = 0; e < 8; ++e) { s[e] += f[e]; if (q == 0) cur[e] = f[e]; } }
            const float inv = 1.0f / (float)cnt; v4u o;
            o.x = pk2(s[0] * inv - cur[0], s[1] * inv - cur[1]); o.y = pk2(s[2] * inv - cur[2], s[3] * inv - cur[3]); o.z = pk2(s[4] * inv - cur[4], s[5] * inv - cur[5]); o.w = pk2(s[6] * inv - cur[6], s[7] * inv - cur[7]);
            *(v4u*)(DD + row * 512 + ch) = o; }
    }
}

__global__ void __launch_bounds__(NWAVES * 64, 2) mk_fwd(Args) {
    extern __shared__ __attribute__((aligned(16))) unsigned char lds_raw[];
    cg::grid_group grid = cg::this_grid();
    LAS unsigned char* lds = (LAS unsigned char*)lds_raw;
    const int tid = threadIdx.x, lane = tid & 63, wave = __builtin_amdgcn_readfirstlane(tid >> 6);
    const int G = gridDim.x, bx = blockIdx.x, vcu = (G % 8 == 0) ? (bx % 8) * (G / 8) + bx / 8 : bx;
    constexpr size_t SLOT_E = (size_t)M * 512;
    constexpr int NOSPLIT = 1 << 30;
    typedef pg8::bf16_t pbf;
#define CG_SYNC() do { asm volatile("s_waitcnt vmcnt(0) lgkmcnt(0)" ::: "memory"); __syncthreads(); grid.sync(); __builtin_amdgcn_fence(__ATOMIC_ACQUIRE, "agent"); asm volatile("s_waitcnt vmcnt(0)" ::: "memory"); __syncthreads(); } while (0)
#define GRID_SYNC() do { asm volatile("s_waitcnt lgkmcnt(0)" ::: "memory"); XcdBarrier b_; b_.bar = (unsigned*)(ARG_WS + WS_CTL); b_.x = xb_xcc_id(); b_.st = (volatile LAS unsigned*)(lds + 131072 + 256); xcd_barrier(b_); } while (0)
#define FRESH() int G_ = G, bx_ = bx, vcu_ = vcu, tid_ = tid; asm volatile("" : "+s"(G_), "+s"(bx_), "+s"(vcu_), "+v"(tid_)); const int lane_ = tid_ & 63; (void)lane_; (void)bx_
    volatile LAS unsigned* bst = (volatile LAS unsigned*)(lds + 131072 + 256);
    if (tid < 2) bst[tid] = 0u;
    __syncthreads();
    (void)xcd_barrier_post((unsigned*)(ARG_WS + WS_CTL), bst);
    if (arg_cg_seam()) CG_SYNC();
    { FRESH(); mod_phase(0, 32, lds, vcu_, G_, tid_, wave, lane_); }
    GRID_SYNC();
    { FRESH(); norm_phase<false>(ARG_IN(0), 0, 0, lds, vcu_, G_, tid_, wave, lane_); }
    { FRESH(); mod_phase(32, 288, lds, vcu_, G_, tid_, wave, lane_); }
    { FRESH(); weights_phase(0, lds, vcu_, G_, wave, lane_); }
    GRID_SYNC();
    for (int l = 0; l < 2; ++l) {
        if (l == 1) { FRESH(); weights_phase(1, lds, vcu_, G_, wave, lane_); GRID_SYNC(); }
        for (int f = 0; f < 2; ++f) {
#ifndef NO_N
#endif
            {
                FRESH(); unsigned char* ws = ARG_WS;
                pg8::Gemm g{(const pbf*)(ws + WS_XN), (const pbf*)(ws + WS_WGU) + (size_t)f * NGU * 1024, M, NGU, D, NOSPLIT, 0}; pg8::StaticOrder S; S.init(M, NGU, G_, bx_); S.tail = 1;
                pg8::EpiSwiglu E{(pbf*)(ws + WS_BIG), FF};
#ifndef NO_GU
                pg8::gemm_phase<pg8::EpiSwiglu, pg8::StaticOrder, true, true>(lds, g, S, E);
#endif
            }
            GRID_SYNC();
            {
                FRESH(); unsigned char* ws = ARG_WS; float* outp = ARG_OUT;
                pg8::Gemm g{(const pbf*)(ws + WS_BIG), (const pbf*)(ws + WS_WD) + (size_t)f * 1024 * FF, M, D, FF, NOSPLIT, 0}; pg8::StaticOrder S; S.init(M, D, G_, bx_);
                const int nl = (f == 0) ? l : 1, nsub = (f == 0) ? 1 : 0, bank = (f == 0) ? 3 + l : 2, donorm = (f == 0 || l == 0) ? 1 : 0;
                const float* ng_ = ARG_IN(4) + (size_t)(nl * 3 + nsub) * 1024; const float* xin_ = ARG_IN(0);
                const float* nm_ = (const float*)(ws + WS_MOD) + (size_t)(nl * 2) * 9216 + (size_t)(3 * nsub) * 1024;
                pg8::EpiResid E{(f == 0 && l == 0) ? xin_ : (const float*)outp, outp, (const float*)(ws + WS_MOD) + (size_t)(l * 2) * 9216 + (f == 0 ? 2 : 8) * 1024,
                                (pbf*)(ws + WS_XN), ng_, nm_, nm_ + 1024, (float*)(ws + WS_XBUF), (unsigned*)(ws + WS_CTL) + 4096 + bank * 4096, 0.5f, donorm};
#ifndef NO_RES
                pg8::gemm_phase<pg8::EpiResid, pg8::StaticOrder, false, true>(lds, g, S, E);
#endif
            }
            GRID_SYNC();
            if (f == 0) {
                {
                    FRESH(); f_phase(l, lds, vcu_, G_, tid_, wave, lane_); unsigned char* ws = ARG_WS;
                    pg8::Gemm g{(const pbf*)(ws + WS_XN), (const pbf*)(ws + WS_WIN), M, NIN, D, NOSPLIT, 0}; pg8::StaticOrder S; S.init(M, NIN, G_, bx_); S.tail = 1;
                    LAS float* gl = (LAS float*)(lds + 131072 + 1024); if (tid_ < 256) gl[tid_] = (ARG_IN(9) + l * 256)[tid_]; __syncthreads();
                    pg8::EpiInproj E{(pbf*)(ws + WS_BIG), (pbf*)(ws + WS_G), (const LAS float*)gl};
#ifndef NO_IN
                    pg8::gemm_phase<pg8::EpiInproj, pg8::StaticOrder, true, true>(lds, g, S, E);
#endif
                }
                GRID_SYNC();
                {
                    FRESH(); unsigned char* ws = ARG_WS; pbf* SL = (pbf*)(ws + WS_BIG);
#ifndef NO_POOL
                    pool_phase((const bf16*)(SL + 5 * SLOT_E), (bf16*)(SL + 1 * SLOT_E), vcu_, G_, tid_);
#endif
                    using abf = attn_body::bf16;
                    volatile LAS int* hmap = (volatile LAS int*)(lds + 131072 + 288);
                    if (tid_ < 8) { const float* fbp = ARG_IN(11) + l * 8; const float fh = fbp[tid_]; int rank = 0;
#pragma unroll
                        for (int jj = 0; jj < 8; ++jj) { const float fj = fbp[jj]; rank += (fj > fh || (fj == fh && jj < tid_)) ? 1 : 0; }
                        hmap[rank] = tid_; }
                    __syncthreads();
                    for (int uu = vcu_; uu < 256; uu += G_) { const int bh = uu >> 4, s = uu & 15, b = bh >> 3, r = bh & 7;
#ifndef NO_ATTN0
                        for (int i = 0; i < 2; ++i) { const int h = __builtin_amdgcn_readfirstlane(hmap[i ? 7 - r : r]);
                            attn_body::attn_unit<0, 24>(b, h, i ? s : 31 - s, (const abf*)(SL + 2 * SLOT_E), (const abf*)(SL + 6 * SLOT_E), (const abf*)(SL + 7 * SLOT_E), (abf*)(SL + 2 * SLOT_E), (char*)lds_raw, (const float*)(ws + WS_CUM), (const float*)(ws + WS_BT), ARG_IN(9) + l * 256); }
#endif
#ifndef NO_ATTN1
                        for (int i = 0; i < 2; ++i)
                            attn_body::attn_unit<1, 8>(b, r, i ? s : 31 - s, (const abf*)(SL + 0 * SLOT_E), (const abf*)(SL + 3 * SLOT_E), (const abf*)(SL + 4 * SLOT_E), (abf*)(SL + 0 * SLOT_E), (char*)lds_raw, ARG_IN(10) + (size_t)(l * 8 + r) * 257, nullptr, nullptr);
#endif
                    }
                }
                GRID_SYNC();
                {
                    FRESH(); unsigned char* ws = ARG_WS;
                    pg8::Gemm g{(const pbf*)(ws + WS_BIG), (const pbf*)(ws + WS_WBR), M, 3072, 512, 4, SLOT}; pg8::BranchOrder S; S.S0.init(M, D, G_, bx_);
                    pg8::EpiBranch E{(pbf*)(ws + WS_MG), (const pbf*)(ws + WS_G)};
#ifndef NO_BR
                    pg8::gemm_phase<pg8::EpiBranch, pg8::BranchOrder, true, true>(lds, g, S, E);
#endif
                }
                GRID_SYNC();
                {
                    FRESH(); unsigned char* ws = ARG_WS; float* outp = ARG_OUT;
                    pg8::Gemm g{(const pbf*)(ws + WS_MG), (const pbf*)(ws + WS_WO), M, D, D, NOSPLIT, 0}; pg8::StaticOrder S; S.init(M, D, G_, bx_);
                    const float* ng_ = ARG_IN(4) + (size_t)(l * 3 + 2) * 1024;
                    pg8::EpiResid E{outp, outp, (const float*)(ws + WS_MOD) + (size_t)(l * 2) * 9216 + 5 * 1024,
                                    (pbf*)(ws + WS_XN), ng_, (const float*)(ws + WS_MOD) + (size_t)(l * 2) * 9216 + 6 * 1024, (const float*)(ws + WS_MOD) + (size_t)(l * 2) * 9216 + 7 * 1024, (float*)(ws + WS_XBUF), (unsigned*)(ws + WS_CTL) + 4096 + l * 4096, 1.0f, 1};
#ifndef NO_RES
                    pg8::gemm_phase<pg8::EpiResid, pg8::StaticOrder, false, true>(lds, g, S, E);
#endif
                }
                GRID_SYNC();
            }
        }
    }
}

extern "C" void kernel_launch(void* const* d_in, const int* in_sizes, int n_in, void* d_out, int out_size, void* d_ws, size_t ws_size, hipStream_t stream) {
    static int grid = 0;
    if (grid == 0) {
        if (n_in != 16 || out_size != M * D || ws_size < WS_END) { fprintf(stderr, "kernel_launch: unexpected shapes (n_in %d out %d ws %zu need %zu)\n", n_in, out_size, ws_size, (size_t)WS_END); grid = -1; return; }
        int dev = 0, cus = 0, per_cu = 0;
        if (hipGetDevice(&dev) != hipSuccess || hipDeviceGetAttribute(&cus, hipDeviceAttributeMultiprocessorCount, dev) != hipSuccess) { grid = -1; return; }
        if (hipFuncSetAttribute((const void*)mk_fwd, hipFuncAttributeMaxDynamicSharedMemorySize, LDS_BYTES) != hipSuccess) { fprintf(stderr, "kernel_launch: hipFuncSetAttribute failed\n"); grid = -1; return; }
        if (hipOccupancyMaxActiveBlocksPerMultiprocessor(&per_cu, (const void*)mk_fwd, NWAVES * 64, LDS_BYTES) != hipSuccess || per_cu < 1) { fprintf(stderr, "kernel_launch: occupancy query says %d\n", per_cu); per_cu = 1; }
        (void)hipGetLastError();
        grid = cus;
    }
    if (grid < 0) return;
    Args a{};
    for (int i = 0; i < 16; ++i) a.in[i] = (const float*)d_in[i];
    a.out = (float*)d_out; a.ws = (unsigned char*)d_ws; a.cg_seam = 0; a.pad = 0;
    if (hipMemsetAsync((char*)d_ws + WS_CTL, 0, CTL_ZERO_BYTES, stream) != hipSuccess) { fprintf(stderr, "kernel_launch: hipMemsetAsync failed\n"); return; }
    void* params[] = {&a};
    const hipError_t e = hipLaunchCooperativeKernel((const void*)mk_fwd, dim3(grid), dim3(NWAVES * 64), params, LDS_BYTES, stream);
    if (e != hipSuccess) fprintf(stderr, "kernel_launch: cooperative launch failed: %s (grid %d)\n", hipGetErrorString(e), grid);
}
```

```cpp
#include <hip/hip_runtime.h>
#include <hip/hip_cooperative_groups.h>
#include <hip/hip_bf16.h>
#include <cstdio>
#include <cstdint>
#include <cmath>
namespace cg = cooperative_groups;

namespace pg8 {
#define PG8_LAS __attribute__((address_space(3)))
typedef unsigned short bf16_t;
typedef short bf16x8 __attribute__((ext_vector_type(8)));
typedef float f32x4 __attribute__((ext_vector_type(4)));
typedef unsigned u32x4 __attribute__((ext_vector_type(4)));
constexpr int BM = 256, BK = 64, HALF = 128, HTB = HALF * BK * 2  , STAGE_BYTES = 8 * HTB, NXCD = 8, WGM = 8;

__host__ __device__ __forceinline__ int lds_byte(int r, int c) { const int st = (r >> 4) * 2 + (c >> 5), rr = r & 15, cc = c & 31, ob = rr * 64 + cc * 2; return st * 1024 + (ob ^ (((ob >> 9) & 1) << 5)); }
__host__ __device__ __forceinline__ void stage_rc(int b, int& R, int& C) { const int st = b / 1024, sb = b % 1024, swz = sb ^ (((sb >> 9) & 1) << 5); R = (st >> 1) * 16 + swz / 64; C = (st & 1) * 32 + (swz % 64) / 2; }
__host__ __device__ __forceinline__ int perm32(int rho) { const int n = rho >> 4, i = rho & 15; return 8 * (i >> 2) + 4 * n + (i & 3); }

struct Unit { int pm, pn, roff, nai; };
struct Gemm { const bf16_t* A; const bf16_t* Bt; int M, N, K; int a_tiles; size_t a_stride; };

struct StaticOrder {
    static constexpr bool KEEP = false;
    int nM, nN, nwg, G, c;
    __host__ __device__ void init(int M, int N, int G_, int c_) { nM = M / BM; nN = N / BM; nwg = nM * nN; G = G_; c = c_; tail = 0; }
    int tail;
    __host__ __device__ bool next(int i, Unit& u) const {
        long L = (long)i * G + c; u.roff = 0; u.nai = 2;
        const int full = nwg / G;
        if (tail && (nwg - full * G) * 2 == G && i >= full) { if (i > full) return false; L = (long)full * G + (c >> 1); u.roff = 128 * (c & 1); u.nai = 1; }
        if (L >= nwg) return false;
        int wgid = (int)L; { const int q = nwg / NXCD, r = nwg % NXCD, xcd = wgid % NXCD, off = wgid / NXCD; wgid = (xcd < r ? xcd * (q + 1) : r * (q + 1) + (xcd - r) * q) + off; }
        const int nig = WGM * nN, gid = wgid / nig, fm = gid * WGM, gsz = (nM - fm) < WGM ? (nM - fm) : WGM;
        u.pm = fm + ((wgid % nig) % gsz); u.pn = (wgid % nig) / gsz; return true;
    }
    __device__ __forceinline__ void a_ready(const Unit&) const {}
    __device__ __forceinline__ void done(const Unit&) const {}
};

typedef float f32x2c __attribute__((ext_vector_type(2))); typedef __bf16 bf16x2c __attribute__((ext_vector_type(2)));
__device__ __forceinline__ unsigned cvt_pk_bf16(float lo, float hi) { f32x2c v = {lo, hi}; bf16x2c b = __builtin_convertvector(v, bf16x2c); return __builtin_bit_cast(unsigned, b); }

typedef float f32x2 __attribute__((ext_vector_type(2)));
constexpr float EPI_LOG2E = 1.4426950408889634f;
constexpr float EPI_C2 = 0.125f * 1.4426950408889634f;
__device__ __forceinline__ float sigm(float x) { return __builtin_amdgcn_rcpf(1.0f + __builtin_amdgcn_exp2f(-x * EPI_LOG2E)); }
__device__ __forceinline__ f32x4 sigm4(f32x4 v) { return (f32x4){sigm(v[0]), sigm(v[1]), sigm(v[2]), sigm(v[3])}; }
__device__ __forceinline__ u32x4 pack8(f32x4 v0, f32x4 v1) { u32x4 w; w.x = cvt_pk_bf16(v0[0], v0[1]); w.y = cvt_pk_bf16(v0[2], v0[3]); w.z = cvt_pk_bf16(v1[0], v1[1]); w.w = cvt_pk_bf16(v1[2], v1[3]); return w; }
__device__ __forceinline__ f32x4 bf_lo4(unsigned a, unsigned b) { return (f32x4){__uint_as_float(a << 16), __uint_as_float(a & 0xffff0000u), __uint_as_float(b << 16), __uint_as_float(b & 0xffff0000u)}; }

__device__ __forceinline__ unsigned q4u8(f32x4 g) { f32x4 t = g * 255.0f + 0.5f; t[0] = fmaxf(t[0], 1.0f); t[1] = fmaxf(t[1], 1.0f); t[2] = fmaxf(t[2], 1.0f); t[3] = fmaxf(t[3], 1.0f);     return (unsigned)t[0] | ((unsigned)t[1] << 8) | ((unsigned)t[2] << 16) | ((unsigned)t[3] << 24); }
__device__ __forceinline__ f32x4 dq4u8(unsigned w) { return (f32x4){(float)(w & 0xffu), (float)((w >> 8) & 0xffu), (float)((w >> 16) & 0xffu), (float)(w >> 24)}; }
struct EpiSwiglu {
    static constexpr bool PERM = true, AFTER_DRAIN = false;
    bf16_t* H; int ldh;
    __device__ __forceinline__ void operator()(const f32x4 (&acc)[2][2][4][2], const Unit& u, int wr, int wc, int fr, int fq) const {
        const int row0 = u.pm * BM + u.roff + wr * 64 + fr, col0 = u.pn * 128 + wc * 32 + 8 * fq;
#pragma unroll
        for (int ai = 0; ai < 2; ++ai) if (ai < u.nai)
#pragma unroll
            for (int m = 0; m < 4; ++m) { bf16_t* rowp = H + (size_t)(row0 + ai * HALF + m * 16) * ldh + col0;
                const f32x4 g0 = acc[ai][0][m][0], g1 = acc[ai][0][m][1], u0 = acc[ai][1][m][0], u1 = acc[ai][1][m][1];
                const f32x4 h0 = g0 * sigm4(g0) * u0, h1 = g1 * sigm4(g1) * u1;
                *(u32x4*)rowp = pack8(h0, h1); }
    }
};
struct EpiResid {
    static constexpr bool PERM = false, AFTER_DRAIN = true;
    const float* base; float* out; const float* gate;
    bf16_t* xn; const float* ngain; const float* nshift; const float* nscale; float* xbuf; unsigned* cnt; float coef; int donorm;
    __device__ __forceinline__ void fused(f32x4 (&acc)[2][2][4][2], const Unit& u, int wr, int wc, int fr, int fq, PG8_LAS unsigned char* lds, int wid, int lane) const {
        const int row0 = u.pm * BM + wr * 64 + fr, col0 = u.pn * BM + wc * 32 + 4 * fq; const int bo = (u.pm >= 32 ? 9216 : 0); const float* gp = gate + bo + col0;
        f32x4 gv[2][2];
#pragma unroll
        for (int bj = 0; bj < 2; ++bj)
#pragma unroll
            for (int n = 0; n < 2; ++n) gv[bj][n] = *(const f32x4*)(gp + bj * HALF + n * 16) * coef;
#pragma unroll
        for (int ai = 0; ai < 2; ++ai)
#pragma unroll
            for (int m = 0; m < 4; ++m) { const size_t off = (size_t)(row0 + ai * HALF + m * 16) * 1024 + col0;
#pragma unroll
                for (int bj = 0; bj < 2; ++bj)
#pragma unroll
                    for (int n = 0; n < 2; ++n) { const f32x4 bs = *(const f32x4*)(base + off + bj * HALF + n * 16); acc[ai][bj][m][n] = bs + gv[bj][n] * acc[ai][bj][m][n]; *(f32x4*)(out + off + bj * HALF + n * 16) = acc[ai][bj][m][n]; }
                if (m & 1) asm volatile("" ::: "memory"); }
        if (donorm == 0) return;
        PG8_LAS float* P = (PG8_LAS float*)lds;
        PG8_LAS float* S = (PG8_LAS float*)(lds + 4096);
#pragma unroll
        for (int ai = 0; ai < 2; ++ai)
#pragma unroll
            for (int m = 0; m < 4; ++m) { float q = 0.f;
#pragma unroll
                for (int bj = 0; bj < 2; ++bj)
#pragma unroll
                    for (int n = 0; n < 2; ++n) { const f32x4 x = acc[ai][bj][m][n]; q += (x[0] * x[0] + x[1] * x[1]) + (x[2] * x[2] + x[3] * x[3]); }
                q += __shfl_xor(q, 16); q += __shfl_xor(q, 32);
                if (fq == 0) P[(ai * HALF + wr * 64 + m * 16 + fr) * 4 + wc] = q; }
        asm volatile("s_waitcnt lgkmcnt(0)" ::: "memory"); __builtin_amdgcn_s_barrier(); asm volatile("" ::: "memory");
        const int row = wid * 32 + (lane & 31); float* slot = xbuf + ((size_t)(u.pm * BM + row)) * 4;
        if (lane < 32) { const float t = (P[row * 4 + 0] + P[row * 4 + 1]) + (P[row * 4 + 2] + P[row * 4 + 3]); __hip_atomic_store((unsigned*)slot + u.pn, __float_as_uint(t), __ATOMIC_RELAXED, __HIP_MEMORY_SCOPE_AGENT); }
        asm volatile("s_waitcnt vmcnt(0)" ::: "memory");
        if (lane == 0) __hip_atomic_fetch_add(cnt + 64 * u.pm, 1u, __ATOMIC_RELAXED, __HIP_MEMORY_SCOPE_AGENT);
        if (wid == 0) { for (unsigned sp = 0; sp < (1u << 22); ++sp) { if ((unsigned)__builtin_amdgcn_readfirstlane(__hip_atomic_load(cnt + 64 * u.pm, __ATOMIC_RELAXED, __HIP_MEMORY_SCOPE_AGENT)) >= 32u) break; __builtin_amdgcn_s_sleep(2); }
            __builtin_amdgcn_fence(__ATOMIC_ACQUIRE, "agent"); }
        asm volatile("s_waitcnt vmcnt(0) lgkmcnt(0)" ::: "memory"); __builtin_amdgcn_s_barrier(); asm volatile("" ::: "memory");
        if (lane < 32) { float t = 0.f;
#pragma unroll
            for (int k = 0; k < 4; ++k) t += __uint_as_float(__hip_atomic_load((unsigned*)slot + k, __ATOMIC_RELAXED, __HIP_MEMORY_SCOPE_AGENT));
            S[row] = 1.0f / sqrtf(t * (1.0f / 1024.0f) + 1e-6f); }
        asm volatile("s_waitcnt lgkmcnt(0)" ::: "memory"); __builtin_amdgcn_s_barrier(); asm volatile("" ::: "memory");
        typedef unsigned u32x2v __attribute__((ext_vector_type(2)));
        const float* g2 = ngain + col0; const float* sh2 = nshift + bo + col0; const float* sc2 = nscale + bo + col0;
#pragma unroll
        for (int bj = 0; bj < 2; ++bj)
#pragma unroll
            for (int n = 0; n < 2; ++n) { const f32x4 g = *(const f32x4*)(g2 + bj * HALF + n * 16), sc = *(const f32x4*)(sc2 + bj * HALF + n * 16), sh = *(const f32x4*)(sh2 + bj * HALF + n * 16); const f32x4 gm = g * (1.0f + sc);
#pragma unroll
                for (int ai = 0; ai < 2; ++ai)
#pragma unroll
                    for (int m = 0; m < 4; ++m) { const int r = ai * HALF + wr * 64 + m * 16 + fr; const float rs = S[r]; const f32x4 v = (acc[ai][bj][m][n] * rs) * gm + sh;
                        u32x2v w; w.x = cvt_pk_bf16(v[0], v[1]); w.y = cvt_pk_bf16(v[2], v[3]);
                        *(u32x2v*)(xn + (size_t)(u.pm * BM + r) * 1024 + col0 + bj * HALF + n * 16) = w; } }
    }
};
struct EpiInproj {
    static constexpr bool PERM = true, AFTER_DRAIN = false;
    bf16_t* base; bf16_t* G; const PG8_LAS float* gain;
    __device__ __forceinline__ void operator()(const f32x4 (&acc)[2][2][4][2], const Unit& u, int wr, int wc, int fr, int fq) const {
        const int row0 = u.pm * BM + u.roff + wr * 64 + fr;
        if (u.pn >= 14) {
            const int col0 = (u.pn - 14) * 256 + 64 * wc + 8 * fq;
#pragma unroll
            for (int ai = 0; ai < 2; ++ai) if (ai < u.nai)
#pragma unroll
                for (int m = 0; m < 4; ++m) { unsigned char* rowp = (unsigned char*)G + (size_t)(row0 + ai * HALF + m * 16) * 3072 + col0;
#pragma unroll
                    for (int bj = 0; bj < 2; ++bj) { typedef unsigned u32x2q __attribute__((ext_vector_type(2))); u32x2q w; w.x = q4u8(sigm4(acc[ai][bj][m][0])); w.y = q4u8(sigm4(acc[ai][bj][m][1])); *(u32x2q*)(rowp + 32 * bj) = w; } }
        } else {
            const int t = u.pn >> 1; const int slot = (t == 0) ? 0 : (t == 4) ? 2 : (t < 4) ? t + 2 : t + 1; bf16_t* O = base + (size_t)slot * ((size_t)16384 * 512);     const int col0 = (u.pn & 1) * 256 + 64 * wc + 8 * fq;
            if (t == 0 || t == 1 || t == 4 || t == 5) {
                const int gi = (t == 0) ? 0 : (t == 1) ? 1 : (t == 4) ? 2 : 3; const float qs = (t == 0 || t == 4) ? EPI_C2 : 1.f;
                f32x4 gv[2][2];
#pragma unroll
                for (int bj = 0; bj < 2; ++bj)
#pragma unroll
                    for (int n = 0; n < 2; ++n) gv[bj][n] = *(const PG8_LAS f32x4*)(gain + gi * 64 + 32 * bj + 8 * fq + 4 * n) * qs;
#pragma unroll
                for (int ai = 0; ai < 2; ++ai) if (ai < u.nai)
#pragma unroll
                    for (int m = 0; m < 4; ++m) { bf16_t* rowp = O + (size_t)(row0 + ai * HALF + m * 16) * 512 + col0;
                        float ss = 0.f;
#pragma unroll
                        for (int bj = 0; bj < 2; ++bj)
#pragma unroll
                            for (int n = 0; n < 2; ++n) { const f32x4 x = acc[ai][bj][m][n]; ss += (x[0] * x[0] + x[1] * x[1]) + (x[2] * x[2] + x[3] * x[3]); }
                        ss += __shfl_xor(ss, 16); ss += __shfl_xor(ss, 32);
                        const float rstd = __builtin_amdgcn_rsqf(ss * (1.0f / 64.0f) + 1e-6f);
#pragma unroll
                        for (int bj = 0; bj < 2; ++bj) *(u32x4*)(rowp + 32 * bj) = pack8(acc[ai][bj][m][0] * rstd * gv[bj][0], acc[ai][bj][m][1] * rstd * gv[bj][1]); }
            } else {
#pragma unroll
                for (int ai = 0; ai < 2; ++ai) if (ai < u.nai)
#pragma unroll
                    for (int m = 0; m < 4; ++m) { bf16_t* rowp = O + (size_t)(row0 + ai * HALF + m * 16) * 512 + col0;
#pragma unroll
                        for (int bj = 0; bj < 2; ++bj) *(u32x4*)(rowp + 32 * bj) = pack8(acc[ai][bj][m][0], acc[ai][bj][m][1]); }
            }
        }
    }
};
struct EpiBranch {
    static constexpr bool PERM = true, AFTER_DRAIN = false;
    bf16_t* MG; const bf16_t* G;
    __device__ __forceinline__ void operator()(f32x4 (&acc)[2][2][4][2], const Unit& u, int wr, int wc, int fr, int fq) const {
        typedef unsigned u32x2q __attribute__((ext_vector_type(2)));
        const int n = u.pn >> 2, pc = u.pn & 3; const int row0 = u.pm * BM + wr * 64 + fr, col0 = pc * 256 + wc * 32 + 8 * fq;
        const int nn = (n < 2) ? n + 1 : n;
#pragma unroll
        for (int ai = 0; ai < 2; ++ai)
#pragma unroll
          for (int mp2 = 0; mp2 < 2; ++mp2) {
            u32x2q ga[2][2], gb[2][2];
#pragma unroll
            for (int q = 0; q < 2; ++q) { const int m = 2 * mp2 + q; const size_t row = (size_t)(row0 + ai * HALF + m * 16); const unsigned char* gp = (const unsigned char*)G + row * 3072 + col0;
#pragma unroll
                for (int bj = 0; bj < 2; ++bj) { ga[q][bj] = *(const u32x2q*)(gp + n * 1024 + bj * HALF); gb[q][bj] = *(const u32x2q*)(gp + nn * 1024 + bj * HALF); } }
            asm volatile("" : "+v"(ga[0][0]), "+v"(ga[0][1]), "+v"(ga[1][0]), "+v"(ga[1][1]), "+v"(gb[0][0]), "+v"(gb[0][1]), "+v"(gb[1][0]), "+v"(gb[1][1]));
#pragma unroll
            for (int q = 0; q < 2; ++q) { const int m = 2 * mp2 + q; const size_t row = (size_t)(row0 + ai * HALF + m * 16);
                if (n < 2) {
#pragma unroll
                    for (int bj = 0; bj < 2; ++bj) { const f32x4 d0 = dq4u8(gb[q][bj].x), d1 = dq4u8(gb[q][bj].y);
                        const f32x4 r0 = dq4u8(ga[q][bj].x) * (f32x4){__builtin_amdgcn_rcpf(d0[0]), __builtin_amdgcn_rcpf(d0[1]), __builtin_amdgcn_rcpf(d0[2]), __builtin_amdgcn_rcpf(d0[3])};
                        const f32x4 r1 = dq4u8(ga[q][bj].y) * (f32x4){__builtin_amdgcn_rcpf(d1[0]), __builtin_amdgcn_rcpf(d1[1]), __builtin_amdgcn_rcpf(d1[2]), __builtin_amdgcn_rcpf(d1[3])};
                        acc[ai][bj][m][0] *= r0; acc[ai][bj][m][1] *= r1; }
                } else { bf16_t* mp = MG + row * 1024 + col0;
#pragma unroll
                    for (int bj = 0; bj < 2; ++bj) *(u32x4*)(mp + bj * HALF) = pack8(dq4u8(ga[q][bj].x) * (acc[ai][bj][m][0] * (1.0f / 255.0f)), dq4u8(ga[q][bj].y) * (acc[ai][bj][m][1] * (1.0f / 255.0f))); } }
          }
    }
};
struct BranchOrder {
    static constexpr bool KEEP = true;
    StaticOrder S0;
    __device__ __forceinline__ bool next(int i, Unit& u) const { Unit t; if (!S0.next(i / 3, t)) return false; u.pm = t.pm; u.pn = 4 * (i % 3) + t.pn; u.roff = 0; u.nai = 2; return true; }
    __device__ __forceinline__ void a_ready(const Unit&) const {}
    __device__ __forceinline__ void done(const Unit&) const {}
};

template <class Epi, class Sched, bool ALIGN_EPI = false, bool SP2 = false>
__device__ __forceinline__ void gemm_phase(PG8_LAS unsigned char* lds, const Gemm g, const Sched& S, const Epi& E) {
    int tid_l = threadIdx.x; asm volatile("" : "+v"(tid_l));
    const int tid = tid_l, wid = __builtin_amdgcn_readfirstlane(tid >> 6), lane = tid & 63, wr = wid >> 2, wc = wid & 3, fr = lane & 15, fq = lane >> 4;
    const int K = g.K, nt = K / BK;
    unsigned voffA[2], voffB[2];
#pragma unroll
    for (int i = 0; i < 2; ++i) { int R, C; stage_rc(tid * 16 + i * 8192, R, C); const int Rb = Epi::PERM ? ((R & ~31) + perm32(R & 31)) : R;
        voffA[i] = (unsigned)(R * K + C) * 2u; voffB[i] = (unsigned)(Rb * K + C) * 2u; }
    const size_t kstep = (size_t)(BK * 2);
    const size_t hstep = (size_t)HALF * K * 2;
    const size_t tstep = 2 * hstep;
    const unsigned ldsw = (unsigned)wid * 1024u;
    const int aoff = lds_byte(wr * 64 + fr, fq * 8), boff = lds_byte(wc * 32 + fr, fq * 8);
#define PG8_SA(b, h) (((b) * 2 + (h)) * HTB)
#define PG8_SB(b, h) ((4 + (b) * 2 + (h)) * HTB)
#define PG8_STAGE(bufoff, gbase, voff) do { _Pragma("unroll") for (int _i = 0; _i < 2; ++_i) \
        __builtin_amdgcn_global_load_lds((const unsigned*)((const char*)(gbase) + (voff)[_i]), (PG8_LAS unsigned*)(lds + (bufoff) + ldsw + _i * 8192), 16, 0, 0); } while (0)
#define PG8_LDA(dst, b, h) do { _Pragma("unroll") for (int m = 0; m < 4; ++m) _Pragma("unroll") for (int k = 0; k < 2; ++k) dst[m][k] = *(const PG8_LAS bf16x8*)(lds + PG8_SA(b, h) + aoff + m * 2048 + k * 1024); } while (0)
#define PG8_LDB(dst, b, h) do { _Pragma("unroll") for (int n = 0; n < 2; ++n) _Pragma("unroll") for (int k = 0; k < 2; ++k) dst[n][k] = *(const PG8_LAS bf16x8*)(lds + PG8_SB(b, h) + boff + n * 2048 + k * 1024); } while (0)
#define PG8_MMA(ai, bj, At, Bt) do { __builtin_amdgcn_s_setprio(1); _Pragma("unroll") for (int m = 0; m < 4; ++m) _Pragma("unroll") for (int n = 0; n < 2; ++n) _Pragma("unroll") for (int k = 0; k < 2; ++k) \
        acc[ai][bj][m][n] = __builtin_amdgcn_mfma_f32_16x16x32_bf16(Bt[n][k], At[m][k], acc[ai][bj][m][n], 0, 0, 0); __builtin_amdgcn_s_setprio(0); } while (0)
#define PG8_WAIT_V(n) asm volatile("s_waitcnt vmcnt(" #n ")" ::: "memory")
#define PG8_WAIT_L(n) asm volatile("s_waitcnt lgkmcnt(" #n ")" ::: "memory")
#define PG8_BAR __builtin_amdgcn_s_barrier()
#define PG8_SCHED __builtin_amdgcn_sched_barrier(0)
    Unit cur, nxt; int ui = 0;
    if (!S.next(0, cur)) return;
    f32x4 acc[2][2][4][2];
#pragma unroll
    for (int a = 0; a < 2; ++a)
#pragma unroll
        for (int b = 0; b < 2; ++b)
#pragma unroll
            for (int m = 0; m < 4; ++m)
#pragma unroll
                for (int n = 0; n < 2; ++n) acc[a][b][m][n] = (f32x4){0.f, 0.f, 0.f, 0.f};
    bf16x8 At[4][2], B0[2][2], B1[2][2];
    const char* cA = (const char*)g.A + (size_t)(cur.pn / g.a_tiles) * g.a_stride + (size_t)cur.pm * tstep + (size_t)cur.roff * K * 2; const char* cB = (const char*)g.Bt + (size_t)cur.pn * tstep;
    S.a_ready(cur);
    if constexpr (SP2) {
        PG8_STAGE(PG8_SB(0, 0), cB, voffB); PG8_STAGE(PG8_SB(0, 1), cB + hstep, voffB); PG8_STAGE(PG8_SA(0, 0), cA, voffA); PG8_STAGE(PG8_SA(0, 1), cA + hstep, voffA);
        if (wr == 1) PG8_BAR;
        PG8_WAIT_V(2); PG8_BAR;
        PG8_STAGE(PG8_SB(1, 0), cB + kstep, voffB); PG8_STAGE(PG8_SA(1, 0), cA + kstep, voffA); PG8_STAGE(PG8_SB(1, 1), cB + hstep + kstep, voffB);
        PG8_WAIT_V(6); PG8_BAR;
    } else {
        PG8_STAGE(PG8_SB(0, 0), cB, voffB); PG8_STAGE(PG8_SA(0, 0), cA, voffA); PG8_STAGE(PG8_SB(0, 1), cB + hstep, voffB); PG8_STAGE(PG8_SA(0, 1), cA + hstep, voffA);
        if (wr == 1) PG8_BAR;
        PG8_WAIT_V(4); PG8_BAR;
        PG8_STAGE(PG8_SB(1, 0), cB + kstep, voffB); PG8_STAGE(PG8_SA(1, 0), cA + kstep, voffA); PG8_STAGE(PG8_SB(1, 1), cB + hstep + kstep, voffB);
        PG8_WAIT_V(6); PG8_BAR;
    }
    for (;;) {
        const bool has_next = S.next(ui + 1, nxt);
        const char* nA = has_next ? (const char*)g.A + (size_t)(nxt.pn / g.a_tiles) * g.a_stride + (size_t)nxt.pm * tstep + (size_t)nxt.roff * K * 2 : cA; const char* nB = has_next ? (const char*)g.Bt + (size_t)nxt.pn * tstep : cB;
        const bool full = (cur.nai == 2);
        for (int t = 0; t < nt; t += 2) {
            const bool last = (t == nt - 2);
            const char* a1 = cA + (size_t)(t + 1) * kstep;
            const char* a2 = last ? nA : cA + (size_t)(t + 2) * kstep; const char* b2 = last ? nB : cB + (size_t)(t + 2) * kstep;
            const char* a3 = a2 + kstep; const char* b3 = b2 + kstep;
            if (last && has_next) S.a_ready(nxt);
            if constexpr (SP2) {
            PG8_LDB(B0, 0, 0); PG8_LDB(B1, 0, 1); PG8_SCHED; PG8_LDA(At, 0, 0); PG8_STAGE(PG8_SA(1, 1), a1 + hstep, voffA);
            PG8_WAIT_V(8); PG8_WAIT_L(0); PG8_BAR; PG8_MMA(0, 0, At, B0); PG8_MMA(0, 1, At, B1); PG8_BAR; PG8_SCHED;
            if (full) PG8_LDA(At, 0, 1); PG8_STAGE(PG8_SB(0, 0), b2, voffB); PG8_STAGE(PG8_SB(0, 1), b2 + hstep, voffB); PG8_STAGE(PG8_SA(0, 0), a2, voffA);
            PG8_WAIT_V(8); PG8_WAIT_L(0); PG8_BAR; if (full) { PG8_MMA(1, 0, At, B0); PG8_MMA(1, 1, At, B1); } PG8_BAR; PG8_SCHED;
            PG8_LDB(B0, 1, 0); PG8_LDB(B1, 1, 1); PG8_SCHED; PG8_LDA(At, 1, 0); PG8_STAGE(PG8_SA(0, 1), a2 + hstep, voffA);
            PG8_WAIT_V(8); PG8_WAIT_L(0); PG8_BAR; PG8_MMA(0, 0, At, B0); PG8_MMA(0, 1, At, B1); PG8_BAR; PG8_SCHED;
            if (full) PG8_LDA(At, 1, 1); PG8_STAGE(PG8_SB(1, 0), b3, voffB); PG8_STAGE(PG8_SB(1, 1), b3 + hstep, voffB); PG8_STAGE(PG8_SA(1, 0), a3, voffA);
            PG8_WAIT_V(8); PG8_WAIT_L(0); PG8_BAR; if (full) { PG8_MMA(1, 0, At, B0); PG8_MMA(1, 1, At, B1); } PG8_BAR; PG8_SCHED;
            } else {
            PG8_LDB(B0, 0, 0); PG8_SCHED; PG8_LDA(At, 0, 0); PG8_STAGE(PG8_SA(1, 1), a1 + hstep, voffA);
            PG8_WAIT_L(8); PG8_BAR; PG8_WAIT_L(0); PG8_MMA(0, 0, At, B0); PG8_BAR; PG8_SCHED;
            PG8_LDB(B1, 0, 1); PG8_STAGE(PG8_SB(0, 0), b2, voffB);
            PG8_BAR; PG8_WAIT_L(0); PG8_MMA(0, 1, At, B1); PG8_BAR;
            PG8_LDA(At, 0, 1); PG8_STAGE(PG8_SA(0, 0), a2, voffA);
            PG8_BAR; PG8_WAIT_L(0); PG8_MMA(1, 0, At, B0); PG8_BAR; PG8_SCHED;
            PG8_STAGE(PG8_SB(0, 1), b2 + hstep, voffB);
            PG8_WAIT_V(6); PG8_BAR; PG8_MMA(1, 1, At, B1); PG8_BAR;
            PG8_LDB(B0, 1, 0); PG8_SCHED; PG8_LDA(At, 1, 0); PG8_STAGE(PG8_SA(0, 1), a2 + hstep, voffA);
            PG8_WAIT_L(8); PG8_BAR; PG8_WAIT_L(0); PG8_MMA(0, 0, At, B0); PG8_BAR; PG8_SCHED;
            PG8_LDB(B1, 1, 1); PG8_STAGE(PG8_SB(1, 0), b3, voffB);
            PG8_BAR; PG8_WAIT_L(0); PG8_MMA(0, 1, At, B1); PG8_BAR;
            PG8_LDA(At, 1, 1); PG8_STAGE(PG8_SA(1, 0), a3, voffA);
            PG8_BAR; PG8_WAIT_L(0); PG8_MMA(1, 0, At, B0); PG8_BAR; PG8_SCHED;
            PG8_STAGE(PG8_SB(1, 1), b3 + hstep, voffB);
            PG8_WAIT_V(6); PG8_BAR; PG8_MMA(1, 1, At, B1); PG8_BAR;
            }
        }
        if constexpr (ALIGN_EPI) { if (wr == 0) PG8_BAR; }
        if constexpr (!Epi::AFTER_DRAIN) { E(acc, cur, wr, wc, fr, fq); S.done(cur); }
        if (!has_next) break;
        if (!Sched::KEEP || (nxt.pn >> 2) == 0) {
#pragma unroll
        for (int a = 0; a < 2; ++a)
#pragma unroll
            for (int b = 0; b < 2; ++b)
#pragma unroll
                for (int m = 0; m < 4; ++m)
#pragma unroll
                    for (int n = 0; n < 2; ++n) acc[a][b][m][n] = (f32x4){0.f, 0.f, 0.f, 0.f};
        }
        cur = nxt; cA = nA; cB = nB; ++ui;
        if constexpr (ALIGN_EPI) { if (wr == 1) PG8_BAR; }
    }
    PG8_WAIT_V(0);
    if constexpr (!ALIGN_EPI) { if (wr == 0) PG8_BAR; }
    PG8_BAR;
    if constexpr (Epi::AFTER_DRAIN) { E.fused(acc, cur, wr, wc, fr, fq, lds, wid, lane); S.done(cur); }
#undef PG8_SA
#undef PG8_SB
#undef PG8_STAGE
#undef PG8_LDA
#undef PG8_LDB
#undef PG8_MMA
#undef PG8_WAIT_V
#undef PG8_WAIT_L
#undef PG8_BAR
#undef PG8_SCHED
}
}

#include <hip/hip_bf16.h>
#include <cmath>
namespace attn_body {
using bf16=__hip_bfloat16;
using bf16x8=__attribute__((ext_vector_type(8)))short;
using s16x4=__attribute__((ext_vector_type(4)))short;
using f32x16=__attribute__((ext_vector_type(16)))float;
using u32x4=__attribute__((ext_vector_type(4)))unsigned;
constexpr int BATCH=2,NHEAD=8,SEQ=8192,D=64,DM=NHEAD*D;
constexpr int NW=8,QBLK=32,QB=QBLK*NW,KVBLK=64,NQB=SEQ/QB;
constexpr int ATTN_PITCH=DM, ATTN_UNIT_ROWS=QB;
__device__ __forceinline__ int crow(int r,int hi){return (r&3)+8*(r>>2)+4*hi;}
#define SBAR() __builtin_amdgcn_sched_barrier(0)
__device__ __forceinline__ void cmask(f32x16&p0,f32x16&p1,int jb,int qrel,int hi){
  const float NEG=-INFINITY; int kb=64*jb+4*hi;
  #pragma unroll
  for(int r=0;r<16;++r){int kv=kb+(r&3)+8*(r>>2); if(kv>qrel)p0[r]=NEG; if(kv+32>qrel)p1[r]=NEG;}
}

constexpr int NSLOT=3, SLOTB=8192;
constexpr int LDS_K=0, LDS_V=NSLOT*SLOTB, LDS_WS=2*NSLOT*SLOTB, LDS_OST=LDS_WS+NW*64*4, LDS_BYTES=LDS_OST+NW*4096;
constexpr float C2=0.125f*1.4426950408889634f; constexpr float LOG2E=1.4426950408889634f; constexpr int TAB_OFF=86016, LDS_BYTES_ALL=TAB_OFF+32768+512; constexpr float NEGBIG=-30000.f;

typedef __attribute__((address_space(3))) float* lds_fptr;
typedef float f32x4a __attribute__((ext_vector_type(4)));
template<int MODE> __device__ __forceinline__ void hook(f32x16&p0,f32x16&p1,int t,int NT,int qrel,int hi,lds_fptr tab,int dbase,int ibase){
  if(MODE==0){
    const lds_fptr tb=tab+64*t+4*hi;
    #pragma unroll
    for(int g=0;g<4;++g){ const f32x4a a=*(const __attribute__((address_space(3))) f32x4a*)(tb+8*g); const f32x4a c=*(const __attribute__((address_space(3))) f32x4a*)(tb+32+8*g);
      p0[4*g+0]+=a.x;p0[4*g+1]+=a.y;p0[4*g+2]+=a.z;p0[4*g+3]+=a.w; p1[4*g+0]+=c.x;p1[4*g+1]+=c.y;p1[4*g+2]+=c.z;p1[4*g+3]+=c.w; }
    const int jb=t-(NT-4); if(jb>=0)cmask(p0,p1,jb,qrel,hi);
  } else {
    const int delta=dbase-t;
    if(delta<0||delta>8){
      #pragma unroll
      for(int r=0;r<16;++r){p0[r]=NEGBIG;p1[r]=NEGBIG;}
    } else if(delta>=3){ const float cf=tab[256];
      #pragma unroll
      for(int r=0;r<16;++r){p0[r]+=cf;p1[r]+=cf;}
    } else { const int ib=64*delta+ibase-4*hi;
      #pragma unroll
      for(int r=0;r<16;++r){ const int kc=(r&3)+8*(r>>2); int i0=ib-kc, i1=ib-32-kc; i0=i0>256?256:i0; i1=i1>256?256:i1; p0[r]+=tab[i0]; p1[r]+=tab[i1]; }
    }
  }
}
__device__ __forceinline__ void glds16(const void*gsrc,unsigned lds_dst){unsigned keep;
  asm volatile("s_mov_b32 %0, m0\n\ts_mov_b32 m0, %2\n\ts_nop 0\n\tglobal_load_lds_dwordx4 %1, off\n\ts_mov_b32 m0, %0":"=&s"(keep):"v"(gsrc),"s"(lds_dst):"memory");}
__device__ __forceinline__ float max3f(float a,float b,float c){float r;asm("v_max3_f32 %0, %1, %2, %3":"=v"(r):"v"(a),"v"(b),"v"(c));return r;}
__device__ __forceinline__ float max2f(float a,float b){float r;asm("v_max_f32_e32 %0, %1, %2":"=v"(r):"v"(a),"v"(b));return r;}
__device__ __forceinline__ float fadd_s(float a,float b){float r;asm("v_add_f32_e32 %0, %1, %2":"=v"(r):"v"(a),"v"(b));return r;}
__device__ __forceinline__ float fsub_s(float a,float b){float r;asm("v_sub_f32_e32 %0, %1, %2":"=v"(r):"v"(a),"v"(b));return r;}
typedef float f32x2_t __attribute__((ext_vector_type(2))); typedef __bf16 bf16x2_t __attribute__((ext_vector_type(2)));
__device__ __forceinline__ unsigned cvtpk_s(float lo,float hi){f32x2_t v={lo,hi};bf16x2_t b=__builtin_convertvector(v,bf16x2_t);return __builtin_bit_cast(unsigned,b);}
#define WAIT_BAR(N) asm volatile("s_waitcnt vmcnt(" #N ") lgkmcnt(0)\n\ts_barrier":::"memory")

__device__ __forceinline__ void qkt(f32x16&p0,f32x16&p1,const char*Kslot,const bf16x8*qr,const f32x16&negm,int r32,int hi){
  const char*kb=Kslot+hi*1024+r32*16;
  #pragma unroll
  for(int d0=0;d0<4;++d0){
    const bf16x8 b0=*reinterpret_cast<const bf16x8*>(kb+d0*2048);
    const bf16x8 b1=*reinterpret_cast<const bf16x8*>(kb+d0*2048+512);
    if(d0==0){p0=__builtin_amdgcn_mfma_f32_32x32x16_bf16(b0,qr[0],negm,0,0,0);p1=__builtin_amdgcn_mfma_f32_32x32x16_bf16(b1,qr[0],negm,0,0,0);}
    else{p0=__builtin_amdgcn_mfma_f32_32x32x16_bf16(b0,qr[d0],p0,0,0,0);p1=__builtin_amdgcn_mfma_f32_32x32x16_bf16(b1,qr[d0],p1,0,0,0);}}
}
typedef __attribute__((address_space(3))) const char* lds_cptr;
typedef short v4i16_t __attribute__((ext_vector_type(4)));
__device__ __forceinline__ void kload8(bf16x8*kf,lds_cptr kp){
  kf[0]=*(const __attribute__((address_space(3))) bf16x8*)(kp);      kf[1]=*(const __attribute__((address_space(3))) bf16x8*)(kp+512);
  kf[2]=*(const __attribute__((address_space(3))) bf16x8*)(kp+2048); kf[3]=*(const __attribute__((address_space(3))) bf16x8*)(kp+2560);
  kf[4]=*(const __attribute__((address_space(3))) bf16x8*)(kp+4096); kf[5]=*(const __attribute__((address_space(3))) bf16x8*)(kp+4608);
  kf[6]=*(const __attribute__((address_space(3))) bf16x8*)(kp+6144); kf[7]=*(const __attribute__((address_space(3))) bf16x8*)(kp+6656);
}
__device__ __forceinline__ void kload2(bf16x8*kf,lds_cptr kp,int j){ kf[2*j]=*(const __attribute__((address_space(3))) bf16x8*)(kp+j*2048); kf[2*j+1]=*(const __attribute__((address_space(3))) bf16x8*)(kp+j*2048+512); }
__device__ __forceinline__ s16x4 vtr(lds_cptr p){ return __builtin_bit_cast(s16x4,__builtin_amdgcn_ds_read_tr16_b64_v4i16((__attribute__((address_space(3))) v4i16_t*)p)); }
__device__ __forceinline__ float rowmax(const f32x16&p0,const f32x16&p1){
  float a=max3f(p0[0],p0[1],p1[0]),b=max3f(p0[2],p0[3],p1[1]);a=max3f(a,p1[2],p1[3]);
  #pragma unroll
  for(int r=4;r<16;r+=4){a=max3f(a,p0[r],p0[r+1]);b=max3f(b,p0[r+2],p0[r+3]);a=max3f(a,p1[r],p1[r+1]);b=max3f(b,p1[r+2],p1[r+3]);}
  const float m=max2f(a,b);
  auto rr=__builtin_amdgcn_permlane32_swap(__float_as_uint(m),__float_as_uint(m),false,false);
  return max2f(__uint_as_float(rr[0]),__uint_as_float(rr[1]));
}
__device__ __forceinline__ void pv(f32x16*o,int vb,bf16x8 pa0,bf16x8 pa1,bf16x8 pa2,bf16x8 pa3){
  #pragma unroll
  for(int d0=0;d0<2;++d0){s16x4 lo[4],hi[4];
    #pragma unroll
    for(int ks=0;ks<4;++ks){
      asm volatile("ds_read_b64_tr_b16 %0,%1 offset:%c2":"=&v"(lo[ks]):"v"(vb),"i"(d0*4096+ks*1024):"memory");
      asm volatile("ds_read_b64_tr_b16 %0,%1 offset:%c2":"=&v"(hi[ks]):"v"(vb),"i"(d0*4096+ks*1024+512):"memory");}
    asm volatile("s_waitcnt lgkmcnt(0)":::"memory");SBAR();
    #define PK(k) (bf16x8){lo[k][0],lo[k][1],lo[k][2],lo[k][3],hi[k][0],hi[k][1],hi[k][2],hi[k][3]}
    o[d0]=__builtin_amdgcn_mfma_f32_32x32x16_bf16(pa0,PK(0),o[d0],0,0,0);
    o[d0]=__builtin_amdgcn_mfma_f32_32x32x16_bf16(pa1,PK(1),o[d0],0,0,0);
    o[d0]=__builtin_amdgcn_mfma_f32_32x32x16_bf16(pa2,PK(2),o[d0],0,0,0);
    o[d0]=__builtin_amdgcn_mfma_f32_32x32x16_bf16(pa3,PK(3),o[d0],0,0,0);
    #undef PK
  }
}

#ifndef ATTN_STORE16
#define ATTN_STORE16(p,v) (*(u32x4*)(p)=(v))
#endif
template<int MODE,int THRL> __device__ __forceinline__ void attn_unit(int b,int h,int qb,const bf16*Q,const bf16*__restrict__ K,const bf16*__restrict__ V,bf16*O,char*shm,const float*aux0,const float*aux1,const float*aux2){
  int tid_l=threadIdx.x; asm volatile("":"+v"(tid_l)); const int tid=tid_l,lane=tid&63,r32=lane&31,hi=lane>>5; const int wid=__builtin_amdgcn_readfirstlane(tid>>6);
  const long rowbase=(long)b*SEQ; const int q0=qb*QB;
  const bf16*Qw=Q+(rowbase+q0+wid*QBLK)*DM+h*D;
  int T0;
  if(MODE==1){ T0=(4*qb-8)>0?(4*qb-8):0; }
  else {
    const lds_fptr bp0=(lds_fptr)((lds_cptr)shm+TAB_OFF)+8192;
    if(wid==0){ const float a=aux1[(b*128+lane)*32+h], c=aux1[(b*128+64+lane)*32+h]; float sa=a, sc=c;
      #pragma unroll
      for(int o=1;o<64;o<<=1){ const float ta=__shfl_up(sa,o), tc=__shfl_up(sc,o); if(lane>=o){sa+=ta;sc+=tc;} }
      const float tot=__shfl(sa,63); bp0[lane]=sa-a; bp0[64+lane]=tot+sc-c; }
    asm volatile("s_waitcnt vmcnt(0) lgkmcnt(0)\n\ts_barrier":::"memory");
    const float*cum0=aux0+(long)(b*NHEAD+h)*SEQ; const int ntp=q0/KVBLK;
    float gq=fabsf(aux2[128+lane]), gk=fabsf(aux2[192+lane]);
    #pragma unroll
    for(int o=1;o<64;o<<=1){ gq=fmaxf(gq,__shfl_xor(gq,o)); gk=fmaxf(gk,__shfl_xor(gk,o)); }
    const float thr=-(cum0[q0]+bp0[q0>>6])*LOG2E-(2.05f*8.f*LOG2E*gq*gk+44.f);
    bool c0=false,c1=false;
    if(lane<ntp) c0=(-(cum0[64*lane+63]+bp0[lane])*LOG2E<thr);
    if(lane+64<ntp) c1=(-(cum0[64*(lane+64)+63]+bp0[lane+64])*LOG2E<thr);
    const int cnt=__popcll(__ballot(c0))+__popcll(__ballot(c1));
    T0=__builtin_amdgcn_readfirstlane(cnt&~1);
  }
  const bf16*Kh=K+(rowbase+(long)T0*KVBLK)*DM+h*D,*Vh=V+(rowbase+(long)T0*KVBLK)*DM+h*D;
  const unsigned lds0=(unsigned)(uintptr_t)shm;
  float*wsf=(float*)(shm+LDS_WS)+wid*64;
  const bf16*ksrc=Kh+(long)lane*DM+wid*8;
  const bf16*vsrc=Vh+(long)(16*(wid&3)+(lane>>2))*DM+(wid>>2)*32+(lane&3)*8;
  const unsigned kdst=lds0+LDS_K+wid*1024, vdst=lds0+LDS_V+wid*1024;
  #define DMA_K(t,slot) glds16(ksrc+(long)(t)*KVBLK*DM,(unsigned)__builtin_amdgcn_readfirstlane(kdst+(slot)))
  #define DMA_V(t,slot) glds16(vsrc+(long)(t)*KVBLK*DM,(unsigned)__builtin_amdgcn_readfirstlane(vdst+(slot)))
  const int vb0=(int)(lds0+LDS_V)+((lane>>4)&1)*32+(lane&3)*8+(4*hi+((lane&15)>>2))*64;
  const char*Kbase=shm+LDS_K; bf16x8 kf[8];
  const lds_cptr shm3=(lds_cptr)shm; const lds_cptr kp0=shm3+LDS_K+hi*1024+r32*16; const lds_cptr vp0=shm3+LDS_V+((lane>>4)&1)*32+(lane&3)*8+(4*hi+((lane&15)>>2))*64;
  const int NT=(q0+QB)/KVBLK-T0;
  const lds_fptr tab=(lds_fptr)(shm3+TAB_OFF);
  const int dbase=4*qb+(wid>>1)-T0, ibase=32*(wid&1)+r32+128; const lds_fptr tabh=(MODE==0)?tab+64*T0:tab;
  if(MODE==0){
    const lds_fptr bp=tab+8192;
    const int nkeys=q0+QB; const float*cum=aux0+(long)(b*NHEAD+h)*SEQ;
    for(int j0=64*T0+tid;j0<nkeys;j0+=2048){ float cv[4];
      #pragma unroll
      for(int u4=0;u4<4;++u4){const int jj=j0+512*u4; cv[u4]=(jj<nkeys)?cum[jj]:0.f;}
      #pragma unroll
      for(int u4=0;u4<4;++u4){const int jj=j0+512*u4; if(jj<nkeys) tab[jj]=-(cv[u4]+bp[jj>>6])*LOG2E;} }
  } else {
    if(tid<257) tab[tid]=aux0[tid]*LOG2E;
  }
  DMA_K(0,0);DMA_V(0,0);DMA_K(1,SLOTB);
  bf16x8 qr[4];
  #pragma unroll
  for(int d0=0;d0<4;++d0)qr[d0]=*reinterpret_cast<const bf16x8*>(&Qw[(long)r32*DM+d0*16+hi*8]);
  float mhat=0.f,l_reg=0.f;f32x16 o[2];o[0]=f32x16{};o[1]=f32x16{};f32x16 negm=f32x16{};asm volatile("":"+v"(negm));
  const int qrel=wid*QBLK+r32;
  #define CMASK(P0,P1,t) hook<MODE>(P0,P1,(t),NT,qrel,hi,tabh,dbase,ibase)
  bool resc=false;
  #define START(P0,P1) do{ const float rm=rowmax(P0,P1); resc=false; \
    { const float dl=rm; mhat=fadd_s(mhat,dl); \
      _Pragma("unroll") for(int r=0;r<16;++r){P0[r]=fsub_s(P0[r],dl);P1[r]=fsub_s(P1[r],dl);} \
      _Pragma("unroll") for(int r=0;r<16;++r)negm[r]=-mhat; asm volatile("":"+v"(negm)); } \
    _Pragma("unroll") for(int r=0;r<16;++r)P0[r]=__builtin_amdgcn_exp2f(P0[r]); }while(0)
  #define RESC() do{ if(resc){ asm volatile("s_waitcnt lgkmcnt(0)":::"memory"); \
      _Pragma("unroll") for(int d_=0;d_<2;++d_) _Pragma("unroll") for(int r=0;r<16;++r)o[d_][r]*=wsf[crow(r,hi)]; } }while(0)
  f32x16 pA0,pA1,pB0,pB1;
  int sl_prev=0,sl_cur=0,sl_next=SLOTB;
  #define ROT() do{sl_prev=sl_cur;sl_cur=sl_next;sl_next=(sl_next==(NSLOT-1)*SLOTB)?0:sl_next+SLOTB;}while(0)
  DMA_K(2,2*SLOTB);
  WAIT_BAR(3);
  qkt(pA0,pA1,Kbase,qr,negm,r32,hi);asm volatile("s_nop 15\n\ts_nop 7":"+v"(pA0),"+v"(pA1));CMASK(pA0,pA1,0);
  START(pA0,pA1);
  _Pragma("unroll") for(int r=0;r<16;++r)pA1[r]=__builtin_amdgcn_exp2f(pA1[r]);
  WAIT_BAR(0);
  DMA_K(3,0);DMA_V(1,SLOTB);
  ROT();
  kload8(kf,kp0+sl_cur);
  WAIT_BAR(2);
  s16x4 vlo[8],vhi[8]; u32x4 pw0,pw1,pw2,pw3;
  #define PKW(P,B) cvtpk_s(P[B],P[B+1])
  #define PAF(k) __builtin_bit_cast(bf16x8,pw##k)
  #define VFR(i) (bf16x8){vlo[i][0],vlo[i][1],vlo[i][2],vlo[i][3],vhi[i][0],vhi[i][1],vhi[i][2],vhi[i][3]}
  #define PIN(x) asm volatile("":"+v"(x))
  #define MX3(a,b,c) __builtin_fmaxf(__builtin_fmaxf((a),(b)),(c))
  #define GAPA(MF,A0,A1,A2,A3,W0,W1,PW) do{ MF; sacc+=A0; sacc+=A1; sacc+=A2; sacc+=A3; PIN(sacc); W0; W1; PIN(PW); SBAR(); }while(0)
  #define EX(v) __builtin_amdgcn_exp2f(v)
  #define GAPB(MF,X,B) do{ MF; X[B]=EX(X[B]); X[B+1]=EX(X[B+1]); X[B+2]=EX(X[B+2]); X[B+3]=EX(X[B+3]); PIN(X); SBAR(); }while(0)
  #define VRD(i) do{ vlo[i]=vtr(vp_+(((i)>>2)*4096+((i)&3)*1024)); vhi[i]=vtr(vp_+(((i)>>2)*4096+((i)&3)*1024+512)); }while(0)
  #define KRD(G,j) do{ if(G){ kload2(kf,kp0+sl_next,j); SBAR(); } }while(0)
  #define STEP(C0,C1,P0,P1,t,GK,GV,GL) do{ SBAR(); \
    const lds_cptr vp_=vp0+sl_prev; \
    VRD(0); SBAR(); float sacc=(P0[0]+P0[1]); \
    GAPA(C0=__builtin_amdgcn_mfma_f32_32x32x16_bf16(kf[0],qr[0],negm,0,0,0), P0[2],P0[3],P0[4],P0[5],     pw0[0]=PKW(P0,0), pw0[1]=PKW(P0,2), pw0); \
    VRD(4); SBAR(); GAPA(C1=__builtin_amdgcn_mfma_f32_32x32x16_bf16(kf[1],qr[0],negm,0,0,0), P0[6],P0[7],P0[8],P0[9],     pw0[2]=PKW(P0,4), pw0[3]=PKW(P0,6), pw0); \
    VRD(1); SBAR(); GAPA(C0=__builtin_amdgcn_mfma_f32_32x32x16_bf16(kf[2],qr[1],C0,0,0,0),   P0[10],P0[11],P0[12],P0[13], pw1[0]=PKW(P0,8), pw1[1]=PKW(P0,10), pw1); \
    VRD(5); SBAR(); GAPA(C1=__builtin_amdgcn_mfma_f32_32x32x16_bf16(kf[3],qr[1],C1,0,0,0),   P0[14],P0[15],P1[0],P1[1],   pw1[2]=PKW(P0,12),pw1[3]=PKW(P0,14), pw1); \
    VRD(2); SBAR(); GAPA(C0=__builtin_amdgcn_mfma_f32_32x32x16_bf16(kf[4],qr[2],C0,0,0,0),   P1[2],P1[3],P1[4],P1[5],     pw2[0]=PKW(P1,0), pw2[1]=PKW(P1,2), pw2); \
    VRD(6); SBAR(); GAPA(C1=__builtin_amdgcn_mfma_f32_32x32x16_bf16(kf[5],qr[2],C1,0,0,0),   P1[6],P1[7],P1[8],P1[9],     pw2[2]=PKW(P1,4), pw2[3]=PKW(P1,6), pw2); \
    VRD(3); SBAR(); GAPA(C0=__builtin_amdgcn_mfma_f32_32x32x16_bf16(kf[6],qr[3],C0,0,0,0),   P1[10],P1[11],P1[12],P1[13], pw3[0]=PKW(P1,8), pw3[1]=PKW(P1,10), pw3); \
    VRD(7); SBAR(); GAPA(C1=__builtin_amdgcn_mfma_f32_32x32x16_bf16(kf[7],qr[3],C1,0,0,0),   P1[14],P1[15],0.f,0.f,       pw3[2]=PKW(P1,12),pw3[3]=PKW(P1,14), pw3); \
    l_reg+=sacc; \
    if(GK){DMA_K((t)+3,sl_cur);} if(GV){DMA_V((t)+1,sl_next);} \
    CMASK(C0,C1,t); \
    { float a=MX3(C0[0],C0[1],C1[0]),b=MX3(C0[2],C0[3],C1[1]); a=MX3(a,C1[2],C1[3]); \
      _Pragma("unroll") for(int r=4;r<16;r+=4){a=MX3(a,C0[r],C0[r+1]);b=MX3(b,C0[r+2],C0[r+3]);a=MX3(a,C1[r],C1[r+1]);b=MX3(b,C1[r+2],C1[r+3]);} \
      float rm=__builtin_fmaxf(a,b); { auto rr=__builtin_amdgcn_permlane32_swap(__float_as_uint(rm),__float_as_uint(rm),false,false); rm=__builtin_fmaxf(__uint_as_float(rr[0]),__uint_as_float(rr[1])); } \
      resc=false; \
      if(__builtin_expect(__any(rm>(float)THRL),0)){ const float dl=__builtin_fmaxf(rm,0.f); mhat+=dl; \
        _Pragma("unroll") for(int r=0;r<16;++r){C0[r]-=dl;C1[r]-=dl;} \
        _Pragma("unroll") for(int r=0;r<16;++r)negm[r]=-mhat; asm volatile("":"+v"(negm)); \
        const float f=__builtin_amdgcn_exp2f(-dl); l_reg*=f; if(hi==0)wsf[r32]=f; resc=true; } } \
    SBAR(); \
    GAPB(o[0]=__builtin_amdgcn_mfma_f32_32x32x16_bf16(PAF(0),VFR(0),o[0],0,0,0), C0,0); \
    GAPB(o[1]=__builtin_amdgcn_mfma_f32_32x32x16_bf16(PAF(0),VFR(4),o[1],0,0,0), C0,4); \
    KRD(GL,0); GAPB(o[0]=__builtin_amdgcn_mfma_f32_32x32x16_bf16(PAF(1),VFR(1),o[0],0,0,0), C0,8); \
    KRD(GL,1); GAPB(o[1]=__builtin_amdgcn_mfma_f32_32x32x16_bf16(PAF(1),VFR(5),o[1],0,0,0), C0,12); \
    KRD(GL,2); GAPB(o[0]=__builtin_amdgcn_mfma_f32_32x32x16_bf16(PAF(2),VFR(2),o[0],0,0,0), C1,0); \
    KRD(GL,3); GAPB(o[1]=__builtin_amdgcn_mfma_f32_32x32x16_bf16(PAF(2),VFR(6),o[1],0,0,0), C1,4); \
    GAPB(o[0]=__builtin_amdgcn_mfma_f32_32x32x16_bf16(PAF(3),VFR(3),o[0],0,0,0), C1,8); \
    GAPB(o[1]=__builtin_amdgcn_mfma_f32_32x32x16_bf16(PAF(3),VFR(7),o[1],0,0,0), C1,12); \
    }while(0)
  int t=1;
  for(;t+5<NT;t+=2){
    STEP(pB0,pB1,pA0,pA1,t,true,true,true);     WAIT_BAR(2); RESC(); ROT();
    STEP(pA0,pA1,pB0,pB1,t+1,true,true,true);   WAIT_BAR(2); RESC(); ROT();
  }
  #define ENDW(tt) do{ if((tt)+3<NT){WAIT_BAR(2);} else if((tt)+2<NT){WAIT_BAR(1);} else {WAIT_BAR(0);} }while(0)
  for(;t+1<NT;t+=2){
    STEP(pB0,pB1,pA0,pA1,t,(t+3<NT),(t+1<NT),(t+1<NT));       ENDW(t);   RESC(); ROT();
    STEP(pA0,pA1,pB0,pB1,t+1,(t+4<NT),(t+2<NT),(t+2<NT));     ENDW(t+1); RESC(); ROT();
  }
  STEP(pB0,pB1,pA0,pA1,NT-1,false,false,false); RESC();
  { float sacc=pB0[0]+pB0[1]; _Pragma("unroll") for(int r=2;r<16;++r)sacc+=pB0[r]; _Pragma("unroll") for(int r=0;r<16;++r)sacc+=pB1[r]; l_reg+=sacc;
    pw0=(u32x4){PKW(pB0,0),PKW(pB0,2),PKW(pB0,4),PKW(pB0,6)};pw1=(u32x4){PKW(pB0,8),PKW(pB0,10),PKW(pB0,12),PKW(pB0,14)};pw2=(u32x4){PKW(pB1,0),PKW(pB1,2),PKW(pB1,4),PKW(pB1,6)};pw3=(u32x4){PKW(pB1,8),PKW(pB1,10),PKW(pB1,12),PKW(pB1,14)};
    SBAR(); pv(o,vb0+sl_cur,PAF(0),PAF(1),PAF(2),PAF(3)); }
  #undef PKW
  #undef PAF
  #undef VFR
  #undef PIN
  #undef MX3
  #undef GAPA
  #undef GAPB
  #undef EX
  #undef VRD
  #undef KRD
  #undef STEP
  #undef ENDW
  {auto rr=__builtin_amdgcn_permlane32_swap(__float_as_uint(l_reg),__float_as_uint(l_reg),false,false);l_reg=__uint_as_float(rr[0])+__uint_as_float(rr[1]);}
  if(hi==0)wsf[32+r32]=l_reg;asm volatile("s_waitcnt lgkmcnt(0)":::"memory");
  float rli[16];
  #pragma unroll
  for(int r=0;r<16;++r)rli[r]=__builtin_amdgcn_rcpf(wsf[32+crow(r,hi)]);
  bf16*Ow=O+(rowbase+q0+wid*QBLK)*DM+h*D;
  { bf16*stg=(bf16*)(shm+LDS_OST)+wid*2048;
    #pragma unroll
    for(int r=0;r<16;++r){const int orow=crow(r,hi);
      #pragma unroll
      for(int d0=0;d0<2;++d0)stg[orow*64+d0*32+r32]=__float2bfloat16(o[d0][r]*rli[r]);}
    asm volatile("s_waitcnt lgkmcnt(0)":::"memory");
    #pragma unroll
    for(int i=0;i<4;++i){const int row=i*8+(lane>>3),ch=lane&7; const u32x4 v=*(const u32x4*)(stg+row*64+ch*8); ATTN_STORE16(Ow+(long)row*DM+ch*8,v);} }
  asm volatile("s_waitcnt lgkmcnt(0)\n\ts_barrier":::"memory");
  #undef DMA_K
  #undef DMA_V
  #undef CMASK
  #undef START
  #undef RESC
  #undef ROT
}
constexpr int ATTN_LDS_BYTES=LDS_BYTES_ALL;
#undef SBAR
#undef WAIT_BAR
}

constexpr int NWAVES = 8;
constexpr int M = 16384, D = 1024, FF = 2816, NGU = 5632, NIN = 6656, DIN = 6664, SEQ = 8192;
constexpr size_t MiB = 1u << 20;
constexpr size_t WS_MOD = 0;
constexpr size_t WS_WF = 256 * 1024;
constexpr size_t WS_BT = 320 * 1024;
constexpr size_t WS_CTL = 1536 * 1024, CTL_ZERO_BYTES = 131072;
constexpr size_t WS_XBUF = WS_CTL + 131072;
constexpr size_t WS_CUM = 1 * MiB;
constexpr size_t WS_WGU = 2 * MiB;
constexpr size_t WS_WD = WS_WGU + 22 * MiB;
constexpr size_t WS_WIN = WS_WD + 11 * MiB;
constexpr size_t WS_WBR = WS_WIN + 13 * MiB;
constexpr size_t WS_WO = WS_WBR + 3 * MiB;
constexpr size_t WS_XN = 54 * MiB;
constexpr size_t WS_BIG = 86 * MiB;
constexpr size_t SLOT = 16 * MiB;
constexpr size_t WS_G = WS_BIG + 8 * SLOT;
constexpr size_t WS_MG = WS_BIG + 3 * SLOT;
constexpr size_t WS_END = WS_G + 96 * MiB;
static_assert(WS_WO + 2 * MiB <= WS_XN, "weights fit");
constexpr int LDS_BYTES = 147456;

#define LAS __attribute__((address_space(3)))
typedef unsigned short bf16;
typedef unsigned v4u __attribute__((ext_vector_type(4)));
typedef float f32x4 __attribute__((ext_vector_type(4)));
#define LDS_WAIT() asm volatile("s_waitcnt lgkmcnt(0)" ::: "memory")
__device__ __forceinline__ unsigned f2bf(float f) { unsigned u = __builtin_bit_cast(unsigned, f); return (u + 0x7fffu + ((u >> 16) & 1u)) >> 16; }
__device__ __forceinline__ unsigned pk2(float lo, float hi) { return f2bf(lo) | (f2bf(hi) << 16); }
__device__ __forceinline__ float wave_sum(float v) {
#pragma unroll
    for (int o = 1; o < 64; o <<= 1) v += __shfl_xor(v, o);
    return v;
}
__device__ __forceinline__ float silu_f(float x) { return x / (1.0f + __expf(-x)); }

__device__ __forceinline__ void transpose_item(const float* __restrict__ W, int ldw, int k0, int c0, bf16* WT, int K, int drow0, LAS float* scr, int lane) {
    { const int kr = lane >> 3, n4 = lane & 7;
      f32x4 v[8];
#pragma unroll
      for (int i = 0; i < 8; ++i) v[i] = *(const f32x4*)(W + (size_t)(k0 + 8 * i + kr) * ldw + c0 + 4 * n4);
#pragma unroll
      for (int i = 0; i < 8; ++i) { LAS float* p = scr + (8 * i + kr) * 33 + 4 * n4; p[0] = v[i].x; p[1] = v[i].y; p[2] = v[i].z; p[3] = v[i].w; } }
    LDS_WAIT(); asm volatile("" ::: "memory");
    const int c = lane & 7;
#pragma unroll
    for (int j = 0; j < 4; ++j) { const int n = (lane >> 3) + 8 * j; const LAS float* s = scr + (8 * c) * 33 + n;
        v4u o; o.x = pk2(s[0 * 33], s[1 * 33]); o.y = pk2(s[2 * 33], s[3 * 33]); o.z = pk2(s[4 * 33], s[5 * 33]); o.w = pk2(s[6 * 33], s[7 * 33]);
        *(v4u*)(WT + (size_t)(drow0 + n) * K + k0 + 8 * c) = o; }
    LDS_WAIT(); asm volatile("" ::: "memory");
}

#define XB_TMO      128
#define XB_XCNT(j)  (256  + 64 * (j))
#define XB_XSUB(j)  (1280 + 64 * (j))
#define XB_XGEN(j)  (2304 + 64 * (j))
#define XB_TOP      3328
#define XB_TOPGEN   3392
#define XCD_BAR_WORDS 3456
#define XB_SPIN_CAP (1u << 18)

__device__ __forceinline__ unsigned xb_ld(unsigned* p)              { return __hip_atomic_load(p, __ATOMIC_RELAXED, __HIP_MEMORY_SCOPE_AGENT); }
__device__ __forceinline__ unsigned xb_add(unsigned* p, unsigned v) { return __hip_atomic_fetch_add(p, v, __ATOMIC_RELAXED, __HIP_MEMORY_SCOPE_AGENT); }
__device__ __forceinline__ unsigned xb_xcc_id() { return (unsigned)__builtin_amdgcn_s_getreg((3 << 11) | 20) & 0xFu; }
#define XB_SPIN(cond, bar) do { unsigned _sp = 0; while (cond) { __builtin_amdgcn_s_sleep(1); \
    if ((++_sp & 255u) == 0u) { if (xb_ld(&(bar)[XB_TMO])) break; if (_sp > XB_SPIN_CAP) { atomicAdd(&(bar)[XB_TMO], 1u); break; } } } } while (0)

struct XcdBarrier {
    unsigned* bar; unsigned x;
    volatile LAS unsigned* st;
};

__device__ __forceinline__ XcdBarrier xcd_barrier_post(unsigned* bar, volatile LAS unsigned* st) {
    XcdBarrier b; b.bar = bar; b.x = xb_xcc_id(); b.st = st;
    if (threadIdx.x == 0) (void)xb_add(&bar[XB_XCNT(b.x)], 1u);
    return b;
}
__device__ __forceinline__ void xcd_barrier_complete(unsigned* bar, unsigned x, unsigned& nloc, unsigned& nx) {
    const unsigned G = gridDim.x * gridDim.y * gridDim.z;
    unsigned sum, cnt, mine, sp = 0u;
    for (;;) {
        sum = 0u; cnt = 0u; mine = 0u;
#pragma unroll
        for (unsigned j = 0; j < 16; ++j) { const unsigned c = xb_ld(&bar[XB_XCNT(j)]); sum += c; cnt += (c > 0u) ? 1u : 0u; mine = (j == x) ? c : mine; }
        if (sum == G) break;
        __builtin_amdgcn_s_sleep(1);
        if ((++sp & 255u) == 0u) { if (xb_ld(&bar[XB_TMO])) break; if (sp > XB_SPIN_CAP) { atomicAdd(&bar[XB_TMO], 1u); break; } }
    }
    nloc = mine > 0u ? mine : 1u; nx = cnt > 0u ? cnt : 1u;
}

__device__ __forceinline__ void xcd_barrier(const XcdBarrier& b) {
    asm volatile("s_waitcnt vmcnt(0)" ::: "memory");
    __syncthreads();
    if (threadIdx.x == 0) {
        unsigned* bar = b.bar;
        __builtin_amdgcn_s_waitcnt(0);
        unsigned nloc = b.st[0], nx = b.st[1];
        if (nloc == 0u) { xcd_barrier_complete(bar, b.x, nloc, nx); b.st[0] = nloc; b.st[1] = nx; }
        const unsigned old = xb_add(&bar[XB_XSUB(b.x)], 1u);
        const unsigned gen = old / nloc;
        if (old + 1u == (gen + 1u) * nloc) {
            __builtin_amdgcn_fence(__ATOMIC_RELEASE, "agent");
            asm volatile("s_waitcnt vmcnt(0)" ::: "memory");
            const unsigned og = xb_add(&bar[XB_TOP], 1u);
            const unsigned tg = og / nx;
            if (og + 1u == (tg + 1u) * nx) xb_add(&bar[XB_TOPGEN], 1u);
            else XB_SPIN(xb_ld(&bar[XB_TOPGEN]) == tg, bar);
            __builtin_amdgcn_fence(__ATOMIC_ACQUIRE, "agent");
            xb_add(&bar[XB_XGEN(b.x)], 1u);
            asm volatile("s_waitcnt vmcnt(0)" ::: "memory");
        } else {
            XB_SPIN(xb_ld(&bar[XB_XGEN(b.x)]) == gen, bar);
            __builtin_amdgcn_fence(__ATOMIC_ACQUIRE, "agent");
            asm volatile("s_waitcnt vmcnt(0)" ::: "memory");
        }
    }
    __syncthreads();
}

struct Args { const float* in[16]; float* out; unsigned char* ws; int cg_seam, pad; };
__device__ __forceinline__ const float* argp(int i) { auto ka = __builtin_amdgcn_kernarg_segment_ptr(); const __attribute__((address_space(1))) float* r; asm volatile("s_load_dwordx2 %0, %1, %2\n\ts_waitcnt lgkmcnt(0)" : "=s"(r) : "s"(ka), "i"(i * 8) : "memory"); return (const float*)r; }
#define ARG_IN(i) argp(i)
#define ARG_OUT ((float*)argp(16))
#define ARG_WS ((unsigned char*)argp(17))
__device__ __forceinline__ int arg_cg_seam() { auto ka = __builtin_amdgcn_kernarg_segment_ptr(); int r; asm volatile("s_load_dword %0, %1, 144\n\ts_waitcnt lgkmcnt(0)" : "=s"(r) : "s"(ka) : "memory"); return r; }

__device__ __forceinline__ void mod_phase(int j0, int j1, LAS unsigned char* lds, int vcu, int G, int tid, int wave, int lane) {
    unsigned char* ws_ = ARG_WS; float* MOD = (float*)(ws_ + WS_MOD); const float* c = ARG_IN(1); const float* w_ada = ARG_IN(2); const float* b_ada = ARG_IN(3);
    LAS float* part = (LAS float*)lds;
    for (int job = j0 + vcu; job < j1; job += G) {
        const int lm = job / 144, colbase = (job % 144) * 64, kk = lane >> 4, c4 = lane & 15;
        f32x4 acc0 = {0.f, 0.f, 0.f, 0.f}, acc1 = {0.f, 0.f, 0.f, 0.f};
        const float* wp = w_ada + ((size_t)lm * 1024 + wave * 128 + kk) * 9216 + colbase + 4 * c4;
#pragma unroll 8
        for (int i = 0; i < 32; ++i) { const int k = wave * 128 + 4 * i + kk; const f32x4 wv = *(const f32x4*)(wp + (size_t)i * 4 * 9216); const float a0 = silu_f(c[k]), a1 = silu_f(c[1024 + k]); acc0 += a0 * wv; acc1 += a1 * wv; }
#pragma unroll
        for (int e = 0; e < 4; ++e) { acc0[e] += __shfl_xor(acc0[e], 16); acc0[e] += __shfl_xor(acc0[e], 32); acc1[e] += __shfl_xor(acc1[e], 16); acc1[e] += __shfl_xor(acc1[e], 32); }
        if (kk == 0) { *(LAS f32x4*)(part + (wave * 2 + 0) * 64 + 4 * c4) = acc0; *(LAS f32x4*)(part + (wave * 2 + 1) * 64 + 4 * c4) = acc1; }
        __syncthreads();
        if (tid < 128) { const int b = tid >> 6, col = tid & 63; float s = b_ada[lm * 9216 + colbase + col];
#pragma unroll
          for (int w = 0; w < 8; ++w) s += part[(w * 2 + b) * 64 + col];
          MOD[(size_t)(lm * 2 + b) * 9216 + colbase + col] = s; }
        __syncthreads();
    }
}

__device__ __forceinline__ void weights_phase(int l, LAS unsigned char* lds, int vcu, int G, int wave, int lane) {
    LAS float* scr = (LAS float*)(lds + wave * 16384); unsigned char* ws_ = ARG_WS;
    bf16* WGU = (bf16*)(ws_ + WS_WGU); bf16* WD = (bf16*)(ws_ + WS_WD); bf16* WIN = (bf16*)(ws_ + WS_WIN); bf16* WBR = (bf16*)(ws_ + WS_WBR); bf16* WO = (bf16*)(ws_ + WS_WO);
    constexpr int IT_EFF = 1024, IT_GU = 2 * 2 * 16 * 88, IT_DN = 2 * 44 * 32, IT_IN = 16 * 208, IT_BR = 2 * 8 * 32, IT_WO = 16 * 32, IT_WF = 128, NITEMS = IT_EFF + IT_GU + IT_DN + IT_IN + IT_BR + IT_WO + IT_WF;
    const int gw = vcu * NWAVES + wave, NGW = G * NWAVES;
    for (int it = gw; it < NITEMS; it += NGW) {
        int r = it;
        if (r < IT_EFF) {
            const int cblk = r & 127, kh = (r >> 7) & 1, g = r >> 8, ci = kh * 64 + lane;
            const float* wp = ARG_IN(12) + ((size_t)(l * 4 + g) * 128 + ci) * 128; const float* ps = ARG_IN(13) + l * 512 + g * 128;
            const float* wb = ARG_IN(14) + ((size_t)(l * 3 + 1) * 512 + g * 128) * 1024 + cblk * 8;
            f32x4 a0 = {0.f, 0.f, 0.f, 0.f}, a1 = {0.f, 0.f, 0.f, 0.f};
#pragma unroll 16
            for (int e = 0; e < 128; ++e) { const float cf = wp[e] * ps[e]; a0 += cf * *(const f32x4*)(wb + (size_t)e * 1024); a1 += cf * *(const f32x4*)(wb + (size_t)e * 1024 + 4); }
            bf16* dst = WBR + (size_t)(1024 + cblk * 8) * 512 + g * 128 + ci;
            dst[0 * 512] = (bf16)f2bf(a0.x); dst[1 * 512] = (bf16)f2bf(a0.y); dst[2 * 512] = (bf16)f2bf(a0.z); dst[3 * 512] = (bf16)f2bf(a0.w);
            dst[4 * 512] = (bf16)f2bf(a1.x); dst[5 * 512] = (bf16)f2bf(a1.y); dst[6 * 512] = (bf16)f2bf(a1.z); dst[7 * 512] = (bf16)f2bf(a1.w);
        } else if ((r -= IT_EFF) < IT_GU) { const int j = r / 2816; r %= 2816; const int isup = r / 1408; r %= 1408; const int kb = r / 88, nb = r % 88, f0 = 32 * nb;
            const float* src = (isup ? ARG_IN(6) : ARG_IN(5)) + (size_t)(l * 2 + j) * 1024 * 2816;
            transpose_item(src, 2816, 64 * kb, f0, WGU + (size_t)j * NGU * 1024, 1024, 256 * (f0 >> 7) + 128 * isup + (f0 & 127), scr, lane);
        } else if ((r -= IT_GU) < IT_DN) { const int j = r / 1408; r %= 1408; const int kb = r / 32, nb = r % 32;
            transpose_item(ARG_IN(7) + (size_t)(l * 2 + j) * 2816 * 1024, 1024, 64 * kb, 32 * nb, WD + (size_t)j * 1024 * 2816, 2816, 32 * nb, scr, lane);
        } else if ((r -= IT_DN) < IT_IN) { const int kb = r / 208, nb = r % 208, L0 = 32 * nb, c0 = L0 < 3584 ? L0 : L0 + 8, pn = L0 >> 8, w = L0 & 255, hh = w >> 6, dh = (w >> 5) & 1;
            transpose_item(ARG_IN(8) + (size_t)l * 1024 * DIN, DIN, 64 * kb, c0, WIN, 1024, 256 * pn + 128 * dh + 32 * hh, scr, lane);
        } else if ((r -= IT_IN) < IT_BR) { const int n = (r / 256) * 2; r %= 256; const int kb = r / 32, nb = r % 32;
            transpose_item(ARG_IN(14) + (size_t)(l * 3 + n) * 512 * 1024, 1024, 64 * kb, 32 * nb, WBR, 512, n * 1024 + 32 * nb, scr, lane);
        } else if ((r -= IT_BR) < IT_WO) { const int kb = r / 32, nb = r % 32; transpose_item(ARG_IN(15) + (size_t)l * 1024 * 1024, 1024, 64 * kb, 32 * nb, WO, 1024, 32 * nb, scr, lane);
        } else { r -= IT_WO; float* WF = (float*)(ws_ + WS_WF); const int i = r * 64 + lane, hh = i >> 10, k = i & 1023; WF[i] = (ARG_IN(8) + (size_t)l * 1024 * DIN)[(size_t)k * DIN + 3584 + hh]; }
    }
}

__device__ __forceinline__ float log_sigmoid_f(float x) { return fminf(x, 0.f) - log1pf(__expf(-fabsf(x))); }

template <bool MIX>
__device__ __forceinline__ void norm_phase(const float* xin, int l, int sub, LAS unsigned char* lds, int vcu, int G, int tid, int wave, int lane) {
    unsigned char* ws_ = ARG_WS; const float* gain = ARG_IN(4) + (size_t)(l * 3 + sub) * 1024; const float* MOD = (const float*)(ws_ + WS_MOD);
    const float* shift = MOD + (size_t)(l * 2) * 9216 + (3 * sub) * 1024; const float* scale = shift + 1024;
    bf16* XN = (bf16*)(ws_ + WS_XN);
    LAS float* wfs = (LAS float*)lds; LAS float* lfs = (LAS float*)(lds + 32768);
    if (MIX) { const float* WF = (const float*)(ws_ + WS_WF); for (int i = tid; i < 8192; i += 512) wfs[i] = WF[i]; __syncthreads(); }
    for (int blk = vcu; blk < 256; blk += G) {
        const int b = blk >> 7;
#pragma unroll (MIX ? 2 : 4)
        for (int i = 0; i < 8; ++i) { const int rl = wave * 8 + i, row = blk * 64 + rl;
            const f32x4* xr = (const f32x4*)(xin + (size_t)row * 1024) + lane;
            f32x4 v[4]; float ss = 0.f;
#pragma unroll
            for (int j = 0; j < 4; ++j) { v[j] = xr[64 * j]; ss += (v[j].x * v[j].x + v[j].y * v[j].y) + (v[j].z * v[j].z + v[j].w * v[j].w); }
            const float rstd = 1.0f / sqrtf(wave_sum(ss) * (1.0f / 1024.0f) + 1e-6f);
            unsigned long long* o8 = (unsigned long long*)(XN + (size_t)row * 1024) + lane;
#pragma unroll
            for (int j = 0; j < 4; ++j) { const f32x4 g = ((const f32x4*)gain)[64 * j + lane], sc = ((const f32x4*)(scale + b * 9216))[64 * j + lane], sh = ((const f32x4*)(shift + b * 9216))[64 * j + lane];
                v[j] = (v[j] * rstd * g) * (1.0f + sc) + sh;
                o8[64 * j] = (unsigned long long)pk2(v[j].x, v[j].y) | ((unsigned long long)pk2(v[j].z, v[j].w) << 32); }
            if (MIX) { float keep = 0.f;
#pragma unroll
                for (int hh = 0; hh < 8; ++hh) { float p = 0.f;
#pragma unroll
                    for (int j = 0; j < 4; ++j) { const f32x4 w = *(const LAS f32x4*)(wfs + hh * 1024 + 4 * (64 * j + lane)); p += (v[j].x * w.x + v[j].y * w.y) + (v[j].z * w.z + v[j].w * w.w); }
                    p = wave_sum(p); keep = (lane == hh) ? p : keep; }
                if (lane < 8) lfs[rl * 8 + lane] = log_sigmoid_f(keep + ARG_IN(11)[l * 8 + lane]); }
        }
        if (MIX) { __syncthreads();
            float* CUM = (float*)(ws_ + WS_CUM); float* BT = (float*)(ws_ + WS_BT);
            float s = lfs[lane * 8 + wave];
#pragma unroll
            for (int o = 1; o < 64; o <<= 1) { const float t = __shfl_up(s, o); if (lane >= o) s += t; }
            CUM[(size_t)(b * 8 + wave) * SEQ + (blk & 127) * 64 + lane] = s; if (lane == 63) BT[blk * 32 + wave] = s;
            __syncthreads(); }
    }
}

__device__ __forceinline__ void f_phase(int l, LAS unsigned char* lds, int vcu, int G, int tid, int wave, int lane) {
    unsigned char* ws_ = ARG_WS; const bf16* XN = (const bf16*)(ws_ + WS_XN); const float* fb = ARG_IN(11) + l * 8;
    LAS float* wfs = (LAS float*)lds; LAS float* lfs = (LAS float*)(lds + 32768);
    { const float* WF = (const float*)(ws_ + WS_WF); for (int i = tid; i < 8192; i += 512) wfs[i] = WF[i]; __syncthreads(); }
    for (int blk = vcu; blk < 256; blk += G) {
        const int b = blk >> 7;
#pragma unroll 2
        for (int i = 0; i < 8; ++i) { const int rl = wave * 8 + i, row = blk * 64 + rl;
            const v4u* xr = (const v4u*)(XN + (size_t)row * 1024) + lane;
            const v4u a = xr[0], c = xr[64];
            const f32x4 h0 = {__uint_as_float(a.x << 16), __uint_as_float(a.x & 0xffff0000u), __uint_as_float(a.y << 16), __uint_as_float(a.y & 0xffff0000u)};
            const f32x4 h1 = {__uint_as_float(a.z << 16), __uint_as_float(a.z & 0xffff0000u), __uint_as_float(a.w << 16), __uint_as_float(a.w & 0xffff0000u)};
            const f32x4 h2 = {__uint_as_float(c.x << 16), __uint_as_float(c.x & 0xffff0000u), __uint_as_float(c.y << 16), __uint_as_float(c.y & 0xffff0000u)};
            const f32x4 h3 = {__uint_as_float(c.z << 16), __uint_as_float(c.z & 0xffff0000u), __uint_as_float(c.w << 16), __uint_as_float(c.w & 0xffff0000u)};
            float keep = 0.f;
#pragma unroll
            for (int hh = 0; hh < 8; ++hh) { const LAS f32x4* w = (const LAS f32x4*)(wfs + hh * 1024 + 8 * lane);
                const f32x4 w0 = w[0], w1 = w[1], w2 = w[128], w3 = w[129];
                float p = ((h0.x * w0.x + h0.y * w0.y) + (h0.z * w0.z + h0.w * w0.w)) + ((h1.x * w1.x + h1.y * w1.y) + (h1.z * w1.z + h1.w * w1.w))
                        + ((h2.x * w2.x + h2.y * w2.y) + (h2.z * w2.z + h2.w * w2.w)) + ((h3.x * w3.x + h3.y * w3.y) + (h3.z * w3.z + h3.w * w3.w));
                p = wave_sum(p); keep = (lane == hh) ? p : keep; }
            if (lane < 8) lfs[rl * 8 + lane] = log_sigmoid_f(keep + fb[lane]); }
        __syncthreads();
        { float* CUM = (float*)(ws_ + WS_CUM); float* BT = (float*)(ws_ + WS_BT);
          float s = lfs[lane * 8 + wave];
#pragma unroll
          for (int o = 1; o < 64; o <<= 1) { const float t = __shfl_up(s, o); if (lane >= o) s += t; }
          CUM[(size_t)(b * 8 + wave) * SEQ + (blk & 127) * 64 + lane] = s; if (lane == 63) BT[blk * 32 + wave] = s; }
        __syncthreads();
    }
}

__device__ __forceinline__ void pool_un8(const v4u u, float (&f)[8]) {
    f[0] = __uint_as_float(u.x << 16); f[1] = __uint_as_float(u.x & 0xffff0000u); f[2] = __uint_as_float(u.y << 16); f[3] = __uint_as_float(u.y & 0xffff0000u);
    f[4] = __uint_as_float(u.z << 16); f[5] = __uint_as_float(u.z & 0xffff0000u); f[6] = __uint_as_float(u.w << 16); f[7] = __uint_as_float(u.w & 0xffff0000u);
}
__device__ __forceinline__ void pool_phase(const bf16* UB, bf16* DD, int vcu, int G, int tid) {
    for (int blk = vcu; blk < 256; blk += G) {
        const int ch = (tid & 63) * 8, lg = ch >> 7, w = 2 << lg, wv = tid >> 6, tr0 = (blk & 127) * 64 + wv * 8; const size_t row0 = (size_t)blk * 64 + wv * 8;
        v4u u[23];
#pragma unroll
        for (int k = 0; k < 23; ++k) { const int d = k - 15; const bool need = (d >= 1 - w) && (tr0 + d >= 0);
            u[k] = (v4u){0u, 0u, 0u, 0u}; if (need) u[k] = *(const v4u*)(UB + (row0 + d) * 512 + ch); }
        float s[8];
#pragma unroll
        for (int e = 0; e < 8; ++e) s[e] = 0.f;
#pragma unroll
        for (int k = 0; k < 16; ++k) { float f[8]; pool_un8(u[k], f);
#pragma unroll
            for (int e = 0; e < 8; ++e) s[e] += f[e]; }
#pragma unroll
        for (int i = 0; i < 8; ++i) { float cur[8]; pool_un8(u[15 + i], cur);
            if (i > 0) {
                const v4u uo = (lg == 0) ? u[13 + i] : (lg == 1) ? u[11 + i] : (lg == 2) ? u[7 + i] : u[i - 1]; float old[8]; pool_un8(uo, old);
#pragma unroll
                for (int e = 0; e < 8; ++e) s[e] += cur[e] - old[e]; }
            const int t = tr0 + i, cnt = (t + 1 < w) ? t + 1 : w; const float inv = 1.0f / (float)cnt; v4u o;
            o.x = pk2(s[0] * inv - cur[0], s[1] * inv - cur[1]); o.y = pk2(s[2] * inv - cur[2], s[3] * inv - cur[3]); o.z = pk2(s[4] * inv - cur[4], s[5] * inv - cur[5]); o.w = pk2(s[6] * inv - cur[6], s[7] * inv - cur[7]);
            *(v4u*)(DD + (row0 + i) * 512 + ch) = o; }
    }
}

__global__ void __launch_bounds__(NWAVES * 64, 2) mk_fwd(Args) {
    extern __shared__ __attribute__((aligned(16))) unsigned char lds_raw[];
    cg::grid_group grid = cg::this_grid();
    LAS unsigned char* lds = (LAS unsigned char*)lds_raw;
    const int tid = threadIdx.x, lane = tid & 63, wave = __builtin_amdgcn_readfirstlane(tid >> 6);
    const int G = gridDim.x, bx = blockIdx.x, vcu = (G % 8 == 0) ? (bx % 8) * (G / 8) + bx / 8 : bx;
    constexpr size_t SLOT_E = (size_t)M * 512;
    constexpr int NOSPLIT = 1 << 30;
    typedef pg8::bf16_t pbf;
#define CG_SYNC() do { asm volatile("s_waitcnt vmcnt(0) lgkmcnt(0)" ::: "memory"); __syncthreads(); grid.sync(); __builtin_amdgcn_fence(__ATOMIC_ACQUIRE, "agent"); asm volatile("s_waitcnt vmcnt(0)" ::: "memory"); __syncthreads(); } while (0)
#define GRID_SYNC() do { asm volatile("s_waitcnt lgkmcnt(0)" ::: "memory"); XcdBarrier b_; b_.bar = (unsigned*)(ARG_WS + WS_CTL); b_.x = xb_xcc_id(); b_.st = (volatile LAS unsigned*)(lds + 131072 + 256); xcd_barrier(b_); } while (0)
#define FRESH() int G_ = G, bx_ = bx, vcu_ = vcu, tid_ = tid; asm volatile("" : "+s"(G_), "+s"(bx_), "+s"(vcu_), "+v"(tid_)); const int lane_ = tid_ & 63; (void)lane_; (void)bx_
    volatile LAS unsigned* bst = (volatile LAS unsigned*)(lds + 131072 + 256);
    if (tid < 2) bst[tid] = 0u;
    __syncthreads();
    (void)xcd_barrier_post((unsigned*)(ARG_WS + WS_CTL), bst);
    if (arg_cg_seam()) CG_SYNC();
    { FRESH(); mod_phase(0, 32, lds, vcu_, G_, tid_, wave, lane_); }
    GRID_SYNC();
    { FRESH(); norm_phase<false>(ARG_IN(0), 0, 0, lds, vcu_, G_, tid_, wave, lane_); }
    { FRESH(); mod_phase(32, 288, lds, vcu_, G_, tid_, wave, lane_); }
    { FRESH(); weights_phase(0, lds, vcu_, G_, wave, lane_); }
    GRID_SYNC();
    for (int l = 0; l < 2; ++l) {
        if (l == 1) { FRESH(); weights_phase(1, lds, vcu_, G_, wave, lane_); GRID_SYNC(); }
        for (int f = 0; f < 2; ++f) {
#ifndef NO_N
#endif
            {
                FRESH(); unsigned char* ws = ARG_WS;
                pg8::Gemm g{(const pbf*)(ws + WS_XN), (const pbf*)(ws + WS_WGU) + (size_t)f * NGU * 1024, M, NGU, D, NOSPLIT, 0}; pg8::StaticOrder S; S.init(M, NGU, G_, bx_); S.tail = 1;
                pg8::EpiSwiglu E{(pbf*)(ws + WS_BIG), FF};
#ifndef NO_GU
                pg8::gemm_phase<pg8::EpiSwiglu, pg8::StaticOrder, true, true>(lds, g, S, E);
#endif
            }
            GRID_SYNC();
            {
                FRESH(); unsigned char* ws = ARG_WS; float* outp = ARG_OUT;
                pg8::Gemm g{(const pbf*)(ws + WS_BIG), (const pbf*)(ws + WS_WD) + (size_t)f * 1024 * FF, M, D, FF, NOSPLIT, 0}; pg8::StaticOrder S; S.init(M, D, G_, bx_);
                const int nl = (f == 0) ? l : 1, nsub = (f == 0) ? 1 : 0, bank = (f == 0) ? 3 + l : 2, donorm = (f == 0 || l == 0) ? 1 : 0;
                const float* ng_ = ARG_IN(4) + (size_t)(nl * 3 + nsub) * 1024; const float* xin_ = ARG_IN(0);
                const float* nm_ = (const float*)(ws + WS_MOD) + (size_t)(nl * 2) * 9216 + (size_t)(3 * nsub) * 1024;
                pg8::EpiResid E{(f == 0 && l == 0) ? xin_ : (const float*)outp, outp, (const float*)(ws + WS_MOD) + (size_t)(l * 2) * 9216 + (f == 0 ? 2 : 8) * 1024,
                                (pbf*)(ws + WS_XN), ng_, nm_, nm_ + 1024, (float*)(ws + WS_XBUF), (unsigned*)(ws + WS_CTL) + 4096 + bank * 4096, 0.5f, donorm};
#ifndef NO_RES
                pg8::gemm_phase<pg8::EpiResid, pg8::StaticOrder, false, true>(lds, g, S, E);
#endif
            }
            GRID_SYNC();
            if (f == 0) {
                {
                    FRESH(); f_phase(l, lds, vcu_, G_, tid_, wave, lane_); unsigned char* ws = ARG_WS;
                    pg8::Gemm g{(const pbf*)(ws + WS_XN), (const pbf*)(ws + WS_WIN), M, NIN, D, NOSPLIT, 0}; pg8::StaticOrder S; S.init(M, NIN, G_, bx_); S.tail = 1;
                    LAS float* gl = (LAS float*)(lds + 131072 + 1024); if (tid_ < 256) gl[tid_] = (ARG_IN(9) + l * 256)[tid_]; __syncthreads();
                    pg8::EpiInproj E{(pbf*)(ws + WS_BIG), (pbf*)(ws + WS_G), (const LAS float*)gl};
#ifndef NO_IN
                    pg8::gemm_phase<pg8::EpiInproj, pg8::StaticOrder, true, true>(lds, g, S, E);
#endif
                }
                GRID_SYNC();
                {
                    FRESH(); unsigned char* ws = ARG_WS; pbf* SL = (pbf*)(ws + WS_BIG);
#ifndef NO_POOL
                    pool_phase((const bf16*)(SL + 5 * SLOT_E), (bf16*)(SL + 1 * SLOT_E), vcu_, G_, tid_);
#endif
                    using abf = attn_body::bf16;
                    volatile LAS int* hmap = (volatile LAS int*)(lds + 131072 + 288);
                    if (tid_ < 8) { const float* fbp = ARG_IN(11) + l * 8; const float fh = fbp[tid_]; int rank = 0;
#pragma unroll
                        for (int jj = 0; jj < 8; ++jj) { const float fj = fbp[jj]; rank += (fj > fh || (fj == fh && jj < tid_)) ? 1 : 0; }
                        hmap[rank] = tid_; }
                    __syncthreads();
                    for (int uu = vcu_; uu < 256; uu += G_) { const int bh = uu >> 4, s = uu & 15, b = bh >> 3, r = bh & 7;
#ifndef NO_ATTN0
                        for (int i = 0; i < 2; ++i) { const int h = __builtin_amdgcn_readfirstlane(hmap[i ? 7 - r : r]);
                            attn_body::attn_unit<0, 24>(b, h, i ? s : 31 - s, (const abf*)(SL + 2 * SLOT_E), (const abf*)(SL + 6 * SLOT_E), (const abf*)(SL + 7 * SLOT_E), (abf*)(SL + 2 * SLOT_E), (char*)lds_raw, (const float*)(ws + WS_CUM), (const float*)(ws + WS_BT), ARG_IN(9) + l * 256); }
#endif
#ifndef NO_ATTN1
                        for (int i = 0; i < 2; ++i)
                            attn_body::attn_unit<1, 8>(b, r, i ? s : 31 - s, (const abf*)(SL + 0 * SLOT_E), (const abf*)(SL + 3 * SLOT_E), (const abf*)(SL + 4 * SLOT_E), (abf*)(SL + 0 * SLOT_E), (char*)lds_raw, ARG_IN(10) + (size_t)(l * 8 + r) * 257, nullptr, nullptr);
#endif
                    }
                }
                GRID_SYNC();
                {
                    FRESH(); unsigned char* ws = ARG_WS;
                    pg8::Gemm g{(const pbf*)(ws + WS_BIG), (const pbf*)(ws + WS_WBR), M, 3072, 512, 4, SLOT}; pg8::BranchOrder S; S.S0.init(M, D, G_, bx_);
                    pg8::EpiBranch E{(pbf*)(ws + WS_MG), (const pbf*)(ws + WS_G)};
#ifndef NO_BR
                    pg8::gemm_phase<pg8::EpiBranch, pg8::BranchOrder, true, true>(lds, g, S, E);
#endif
                }
                GRID_SYNC();
                {
                    FRESH(); unsigned char* ws = ARG_WS; float* outp = ARG_OUT;
                    pg8::Gemm g{(const pbf*)(ws + WS_MG), (const pbf*)(ws + WS_WO), M, D, D, NOSPLIT, 0}; pg8::StaticOrder S; S.init(M, D, G_, bx_);
                    const float* ng_ = ARG_IN(4) + (size_t)(l * 3 + 2) * 1024;
                    pg8::EpiResid E{outp, outp, (const float*)(ws + WS_MOD) + (size_t)(l * 2) * 9216 + 5 * 1024,
                                    (pbf*)(ws + WS_XN), ng_, (const float*)(ws + WS_MOD) + (size_t)(l * 2) * 9216 + 6 * 1024, (const float*)(ws + WS_MOD) + (size_t)(l * 2) * 9216 + 7 * 1024, (float*)(ws + WS_XBUF), (unsigned*)(ws + WS_CTL) + 4096 + l * 4096, 1.0f, 1};
#ifndef NO_RES
                    pg8::gemm_phase<pg8::EpiResid, pg8::StaticOrder, false, true>(lds, g, S, E);
#endif
                }
                GRID_SYNC();
            }
        }
    }
}

extern "C" void kernel_launch(void* const* d_in, const int* in_sizes, int n_in, void* d_out, int out_size, void* d_ws, size_t ws_size, hipStream_t stream) {
    static int grid = 0;
    if (grid == 0) {
        if (n_in != 16 || out_size != M * D || ws_size < WS_END) { fprintf(stderr, "kernel_launch: unexpected shapes (n_in %d out %d ws %zu need %zu)\n", n_in, out_size, ws_size, (size_t)WS_END); grid = -1; return; }
        int dev = 0, cus = 0, per_cu = 0;
        if (hipGetDevice(&dev) != hipSuccess || hipDeviceGetAttribute(&cus, hipDeviceAttributeMultiprocessorCount, dev) != hipSuccess) { grid = -1; return; }
        if (hipFuncSetAttribute((const void*)mk_fwd, hipFuncAttributeMaxDynamicSharedMemorySize, LDS_BYTES) != hipSuccess) { fprintf(stderr, "kernel_launch: hipFuncSetAttribute failed\n"); grid = -1; return; }
        if (hipOccupancyMaxActiveBlocksPerMultiprocessor(&per_cu, (const void*)mk_fwd, NWAVES * 64, LDS_BYTES) != hipSuccess || per_cu < 1) { fprintf(stderr, "kernel_launch: occupancy query says %d\n", per_cu); per_cu = 1; }
        (void)hipGetLastError();
        grid = cus;
    }
    if (grid < 0) return;
    Args a{};
    for (int i = 0; i < 16; ++i) a.in[i] = (const float*)d_in[i];
    a.out = (float*)d_out; a.ws = (unsigned char*)d_ws; a.cg_seam = 0; a.pad = 0;
    if (hipMemsetAsync((char*)d_ws + WS_CTL, 0, CTL_ZERO_BYTES, stream) != hipSuccess) { fprintf(stderr, "kernel_launch: hipMemsetAsync failed\n"); return; }
    void* params[] = {&a};
    const hipError_t e = hipLaunchCooperativeKernel((const void*)mk_fwd, dim3(grid), dim3(NWAVES * 64), params, LDS_BYTES, stream);
    if (e != hipSuccess) fprintf(stderr, "kernel_launch: cooperative launch failed: %s (grid %d)\n", hipGetErrorString(e), grid);
}
```

```cpp
#include <hip/hip_runtime.h>
#include <hip/hip_cooperative_groups.h>
#include <hip/hip_bf16.h>
#include <cstdio>
#include <cstdint>
#include <cmath>
namespace cg = cooperative_groups;

namespace pg8 {
#define PG8_LAS __attribute__((address_space(3)))
typedef unsigned short bf16_t;
typedef short bf16x8 __attribute__((ext_vector_type(8)));
typedef float f32x4 __attribute__((ext_vector_type(4)));
typedef unsigned u32x4 __attribute__((ext_vector_type(4)));
constexpr int BM = 256, BK = 64, HALF = 128, HTB = HALF * BK * 2  , STAGE_BYTES = 8 * HTB, NXCD = 8, WGM = 8;

__host__ __device__ __forceinline__ int lds_byte(int r, int c) { const int st = (r >> 4) * 2 + (c >> 5), rr = r & 15, cc = c & 31, ob = rr * 64 + cc * 2; return st * 1024 + (ob ^ (((ob >> 9) & 1) << 5)); }
__host__ __device__ __forceinline__ void stage_rc(int b, int& R, int& C) { const int st = b / 1024, sb = b % 1024, swz = sb ^ (((sb >> 9) & 1) << 5); R = (st >> 1) * 16 + swz / 64; C = (st & 1) * 32 + (swz % 64) / 2; }
__host__ __device__ __forceinline__ int perm32(int rho) { const int n = rho >> 4, i = rho & 15; return 8 * (i >> 2) + 4 * n + (i & 3); }

struct Unit { int pm, pn, roff, nai; };
struct Gemm { const bf16_t* A; const bf16_t* Bt; int M, N, K; int a_tiles; size_t a_stride; };

struct StaticOrder {
    static constexpr bool KEEP = false;
    int nM, nN, nwg, G, c;
    __host__ __device__ void init(int M, int N, int G_, int c_) { nM = M / BM; nN = N / BM; nwg = nM * nN; G = G_; c = c_; tail = 0; }
    int tail;
    __host__ __device__ bool next(int i, Unit& u) const {
        long L = (long)i * G + c; u.roff = 0; u.nai = 2;
        const int full = nwg / G;
        if (tail && (nwg - full * G) * 2 == G && i >= full) { if (i > full) return false; L = (long)full * G + (c >> 1); u.roff = 128 * (c & 1); u.nai = 1; }
        if (L >= nwg) return false;
        int wgid = (int)L; { const int q = nwg / NXCD, r = nwg % NXCD, xcd = wgid % NXCD, off = wgid / NXCD; wgid = (xcd < r ? xcd * (q + 1) : r * (q + 1) + (xcd - r) * q) + off; }
        const int nig = WGM * nN, gid = wgid / nig, fm = gid * WGM, gsz = (nM - fm) < WGM ? (nM - fm) : WGM;
        u.pm = fm + ((wgid % nig) % gsz); u.pn = (wgid % nig) / gsz; return true;
    }
    __device__ __forceinline__ void a_ready(const Unit&) const {}
    __device__ __forceinline__ void done(const Unit&) const {}
};

typedef float f32x2c __attribute__((ext_vector_type(2))); typedef __bf16 bf16x2c __attribute__((ext_vector_type(2)));
__device__ __forceinline__ unsigned cvt_pk_bf16(float lo, float hi) { f32x2c v = {lo, hi}; bf16x2c b = __builtin_convertvector(v, bf16x2c); return __builtin_bit_cast(unsigned, b); }

typedef float f32x2 __attribute__((ext_vector_type(2)));
constexpr float EPI_LOG2E = 1.4426950408889634f;
constexpr float EPI_C2 = 0.125f * 1.4426950408889634f;
__device__ __forceinline__ float sigm(float x) { return __builtin_amdgcn_rcpf(1.0f + __builtin_amdgcn_exp2f(-x * EPI_LOG2E)); }
__device__ __forceinline__ f32x4 sigm4(f32x4 v) { return (f32x4){sigm(v[0]), sigm(v[1]), sigm(v[2]), sigm(v[3])}; }
__device__ __forceinline__ u32x4 pack8(f32x4 v0, f32x4 v1) { u32x4 w; w.x = cvt_pk_bf16(v0[0], v0[1]); w.y = cvt_pk_bf16(v0[2], v0[3]); w.z = cvt_pk_bf16(v1[0], v1[1]); w.w = cvt_pk_bf16(v1[2], v1[3]); return w; }
__device__ __forceinline__ f32x4 bf_lo4(unsigned a, unsigned b) { return (f32x4){__uint_as_float(a << 16), __uint_as_float(a & 0xffff0000u), __uint_as_float(b << 16), __uint_as_float(b & 0xffff0000u)}; }

__device__ __forceinline__ unsigned q4u8(f32x4 g) { f32x4 t = g * 255.0f + 0.5f; t[0] = fmaxf(t[0], 1.0f); t[1] = fmaxf(t[1], 1.0f); t[2] = fmaxf(t[2], 1.0f); t[3] = fmaxf(t[3], 1.0f);     return (unsigned)t[0] | ((unsigned)t[1] << 8) | ((unsigned)t[2] << 16) | ((unsigned)t[3] << 24); }
__device__ __forceinline__ f32x4 dq4u8(unsigned w) { return (f32x4){(float)(w & 0xffu), (float)((w >> 8) & 0xffu), (float)((w >> 16) & 0xffu), (float)(w >> 24)}; }
struct EpiSwiglu {
    static constexpr bool PERM = true, AFTER_DRAIN = false;
    bf16_t* H; int ldh;
    __device__ __forceinline__ void operator()(const f32x4 (&acc)[2][2][4][2], const Unit& u, int wr, int wc, int fr, int fq) const {
        const int row0 = u.pm * BM + u.roff + wr * 64 + fr, col0 = u.pn * 128 + wc * 32 + 8 * fq;
#pragma unroll
        for (int ai = 0; ai < 2; ++ai) if (ai < u.nai)
#pragma unroll
            for (int m = 0; m < 4; ++m) { bf16_t* rowp = H + (size_t)(row0 + ai * HALF + m * 16) * ldh + col0;
                const f32x4 g0 = acc[ai][0][m][0], g1 = acc[ai][0][m][1], u0 = acc[ai][1][m][0], u1 = acc[ai][1][m][1];
                const f32x4 h0 = g0 * sigm4(g0) * u0, h1 = g1 * sigm4(g1) * u1;
                *(u32x4*)rowp = pack8(h0, h1); }
    }
};
struct EpiResid {
    static constexpr bool PERM = false, AFTER_DRAIN = true;
    const float* base; float* out; const float* gate;
    bf16_t* xn; const float* ngain; const float* nshift; const float* nscale; float* xbuf; unsigned* cnt; float coef; int donorm;
    __device__ __forceinline__ void fused(f32x4 (&acc)[2][2][4][2], const Unit& u, int wr, int wc, int fr, int fq, PG8_LAS unsigned char* lds, int wid, int lane) const {
        const int row0 = u.pm * BM + wr * 64 + fr, col0 = u.pn * BM + wc * 32 + 4 * fq; const int bo = (u.pm >= 32 ? 9216 : 0); const float* gp = gate + bo + col0;
        f32x4 gv[2][2];
#pragma unroll
        for (int bj = 0; bj < 2; ++bj)
#pragma unroll
            for (int n = 0; n < 2; ++n) gv[bj][n] = *(const f32x4*)(gp + bj * HALF + n * 16) * coef;
#pragma unroll
        for (int ai = 0; ai < 2; ++ai)
#pragma unroll
            for (int m = 0; m < 4; ++m) { const size_t off = (size_t)(row0 + ai * HALF + m * 16) * 1024 + col0;
#pragma unroll
                for (int bj = 0; bj < 2; ++bj)
#pragma unroll
                    for (int n = 0; n < 2; ++n) { const f32x4 bs = *(const f32x4*)(base + off + bj * HALF + n * 16); acc[ai][bj][m][n] = bs + gv[bj][n] * acc[ai][bj][m][n]; *(f32x4*)(out + off + bj * HALF + n * 16) = acc[ai][bj][m][n]; }
                if (m & 1) asm volatile("" ::: "memory"); }
        if (donorm == 0) return;
        PG8_LAS float* P = (PG8_LAS float*)lds;
        PG8_LAS float* S = (PG8_LAS float*)(lds + 4096);
#pragma unroll
        for (int ai = 0; ai < 2; ++ai)
#pragma unroll
            for (int m = 0; m < 4; ++m) { float q = 0.f;
#pragma unroll
                for (int bj = 0; bj < 2; ++bj)
#pragma unroll
                    for (int n = 0; n < 2; ++n) { const f32x4 x = acc[ai][bj][m][n]; q += (x[0] * x[0] + x[1] * x[1]) + (x[2] * x[2] + x[3] * x[3]); }
                q += __shfl_xor(q, 16); q += __shfl_xor(q, 32);
                if (fq == 0) P[(ai * HALF + wr * 64 + m * 16 + fr) * 4 + wc] = q; }
        asm volatile("s_waitcnt lgkmcnt(0)" ::: "memory"); __builtin_amdgcn_s_barrier(); asm volatile("" ::: "memory");
        const int row = wid * 32 + (lane & 31); float* slot = xbuf + ((size_t)(u.pm * BM + row)) * 4;
        if (lane < 32) { const float t = (P[row * 4 + 0] + P[row * 4 + 1]) + (P[row * 4 + 2] + P[row * 4 + 3]); __hip_atomic_store((unsigned*)slot + u.pn, __float_as_uint(t), __ATOMIC_RELAXED, __HIP_MEMORY_SCOPE_AGENT); }
        asm volatile("s_waitcnt vmcnt(0)" ::: "memory");
        if (lane == 0) __hip_atomic_fetch_add(cnt + 64 * u.pm, 1u, __ATOMIC_RELAXED, __HIP_MEMORY_SCOPE_AGENT);
        if (wid == 0) { for (unsigned sp = 0; sp < (1u << 22); ++sp) { if ((unsigned)__builtin_amdgcn_readfirstlane(__hip_atomic_load(cnt + 64 * u.pm, __ATOMIC_RELAXED, __HIP_MEMORY_SCOPE_AGENT)) >= 32u) break; __builtin_amdgcn_s_sleep(2); }
            __builtin_amdgcn_fence(__ATOMIC_ACQUIRE, "agent"); }
        asm volatile("s_waitcnt vmcnt(0) lgkmcnt(0)" ::: "memory"); __builtin_amdgcn_s_barrier(); asm volatile("" ::: "memory");
        if (lane < 32) { float t = 0.f;
#pragma unroll
            for (int k = 0; k < 4; ++k) t += __uint_as_float(__hip_atomic_load((unsigned*)slot + k, __ATOMIC_RELAXED, __HIP_MEMORY_SCOPE_AGENT));
            S[row] = 1.0f / sqrtf(t * (1.0f / 1024.0f) + 1e-6f); }
        asm volatile("s_waitcnt lgkmcnt(0)" ::: "memory"); __builtin_amdgcn_s_barrier(); asm volatile("" ::: "memory");
        typedef unsigned u32x2v __attribute__((ext_vector_type(2)));
        const float* g2 = ngain + col0; const float* sh2 = nshift + bo + col0; const float* sc2 = nscale + bo + col0;
#pragma unroll
        for (int bj = 0; bj < 2; ++bj)
#pragma unroll
            for (int n = 0; n < 2; ++n) { const f32x4 g = *(const f32x4*)(g2 + bj * HALF + n * 16), sc = *(const f32x4*)(sc2 + bj * HALF + n * 16), sh = *(const f32x4*)(sh2 + bj * HALF + n * 16); const f32x4 gm = g * (1.0f + sc);
#pragma unroll
                for (int ai = 0; ai < 2; ++ai)
#pragma unroll
                    for (int m = 0; m < 4; ++m) { const int r = ai * HALF + wr * 64 + m * 16 + fr; const float rs = S[r]; const f32x4 v = (acc[ai][bj][m][n] * rs) * gm + sh;
                        u32x2v w; w.x = cvt_pk_bf16(v[0], v[1]); w.y = cvt_pk_bf16(v[2], v[3]);
                        *(u32x2v*)(xn + (size_t)(u.pm * BM + r) * 1024 + col0 + bj * HALF + n * 16) = w; } }
    }
};
struct EpiInproj {
    static constexpr bool PERM = true, AFTER_DRAIN = false;
    bf16_t* base; bf16_t* G; const PG8_LAS float* gain;
    __device__ __forceinline__ void operator()(const f32x4 (&acc)[2][2][4][2], const Unit& u, int wr, int wc, int fr, int fq) const {
        const int row0 = u.pm * BM + u.roff + wr * 64 + fr;
        if (u.pn >= 14) {
            const int col0 = (u.pn - 14) * 256 + 64 * wc + 8 * fq;
#pragma unroll
            for (int ai = 0; ai < 2; ++ai) if (ai < u.nai)
#pragma unroll
                for (int m = 0; m < 4; ++m) { unsigned char* rowp = (unsigned char*)G + (size_t)(row0 + ai * HALF + m * 16) * 3072 + col0;
#pragma unroll
                    for (int bj = 0; bj < 2; ++bj) { typedef unsigned u32x2q __attribute__((ext_vector_type(2))); u32x2q w; w.x = q4u8(sigm4(acc[ai][bj][m][0])); w.y = q4u8(sigm4(acc[ai][bj][m][1])); *(u32x2q*)(rowp + 32 * bj) = w; } }
        } else {
            const int t = u.pn >> 1; const int slot = (t == 0) ? 0 : (t == 4) ? 2 : (t < 4) ? t + 2 : t + 1; bf16_t* O = base + (size_t)slot * ((size_t)16384 * 512);     const int col0 = (u.pn & 1) * 256 + 64 * wc + 8 * fq;
            if (t == 0 || t == 1 || t == 4 || t == 5) {
                const int gi = (t == 0) ? 0 : (t == 1) ? 1 : (t == 4) ? 2 : 3; const float qs = (t == 0 || t == 4) ? EPI_C2 : 1.f;
                f32x4 gv[2][2];
#pragma unroll
                for (int bj = 0; bj < 2; ++bj)
#pragma unroll
                    for (int n = 0; n < 2; ++n) gv[bj][n] = *(const PG8_LAS f32x4*)(gain + gi * 64 + 32 * bj + 8 * fq + 4 * n) * qs;
#pragma unroll
                for (int ai = 0; ai < 2; ++ai) if (ai < u.nai)
#pragma unroll
                    for (int m = 0; m < 4; ++m) { bf16_t* rowp = O + (size_t)(row0 + ai * HALF + m * 16) * 512 + col0;
                        float ss = 0.f;
#pragma unroll
                        for (int bj = 0; bj < 2; ++bj)
#pragma unroll
                            for (int n = 0; n < 2; ++n) { const f32x4 x = acc[ai][bj][m][n]; ss += (x[0] * x[0] + x[1] * x[1]) + (x[2] * x[2] + x[3] * x[3]); }
                        ss += __shfl_xor(ss, 16); ss += __shfl_xor(ss, 32);
                        const float rstd = __builtin_amdgcn_rsqf(ss * (1.0f / 64.0f) + 1e-6f);
#pragma unroll
                        for (int bj = 0; bj < 2; ++bj) *(u32x4*)(rowp + 32 * bj) = pack8(acc[ai][bj][m][0] * rstd * gv[bj][0], acc[ai][bj][m][1] * rstd * gv[bj][1]); }
            } else {
#pragma unroll
                for (int ai = 0; ai < 2; ++ai) if (ai < u.nai)
#pragma unroll
                    for (int m = 0; m < 4; ++m) { bf16_t* rowp = O + (size_t)(row0 + ai * HALF + m * 16) * 512 + col0;
#pragma unroll
                        for (int bj = 0; bj < 2; ++bj) *(u32x4*)(rowp + 32 * bj) = pack8(acc[ai][bj][m][0], acc[ai][bj][m][1]); }
            }
        }
    }
};
struct EpiBranch {
    static constexpr bool PERM = true, AFTER_DRAIN = false;
    bf16_t* MG; const bf16_t* G;
    __device__ __forceinline__ void operator()(f32x4 (&acc)[2][2][4][2], const Unit& u, int wr, int wc, int fr, int fq) const {
        typedef unsigned u32x2q __attribute__((ext_vector_type(2)));
        const int n = u.pn >> 2, pc = u.pn & 3; const int row0 = u.pm * BM + wr * 64 + fr, col0 = pc * 256 + wc * 32 + 8 * fq;
        const int nn = (n < 2) ? n + 1 : n;
#pragma unroll
        for (int ai = 0; ai < 2; ++ai)
#pragma unroll
          for (int mp2 = 0; mp2 < 2; ++mp2) {
            u32x2q ga[2][2], gb[2][2];
#pragma unroll
            for (int q = 0; q < 2; ++q) { const int m = 2 * mp2 + q; const size_t row = (size_t)(row0 + ai * HALF + m * 16); const unsigned char* gp = (const unsigned char*)G + row * 3072 + col0;
#pragma unroll
                for (int bj = 0; bj < 2; ++bj) { ga[q][bj] = *(const u32x2q*)(gp + n * 1024 + bj * HALF); gb[q][bj] = *(const u32x2q*)(gp + nn * 1024 + bj * HALF); } }
            asm volatile("" : "+v"(ga[0][0]), "+v"(ga[0][1]), "+v"(ga[1][0]), "+v"(ga[1][1]), "+v"(gb[0][0]), "+v"(gb[0][1]), "+v"(gb[1][0]), "+v"(gb[1][1]));
#pragma unroll
            for (int q = 0; q < 2; ++q) { const int m = 2 * mp2 + q; const size_t row = (size_t)(row0 + ai * HALF + m * 16);
                if (n < 2) {
#pragma unroll
                    for (int bj = 0; bj < 2; ++bj) { const f32x4 d0 = dq4u8(gb[q][bj].x), d1 = dq4u8(gb[q][bj].y);
                        const f32x4 r0 = dq4u8(ga[q][bj].x) * (f32x4){__builtin_amdgcn_rcpf(d0[0]), __builtin_amdgcn_rcpf(d0[1]), __builtin_amdgcn_rcpf(d0[2]), __builtin_amdgcn_rcpf(d0[3])};
                        const f32x4 r1 = dq4u8(ga[q][bj].y) * (f32x4){__builtin_amdgcn_rcpf(d1[0]), __builtin_amdgcn_rcpf(d1[1]), __builtin_amdgcn_rcpf(d1[2]), __builtin_amdgcn_rcpf(d1[3])};
                        acc[ai][bj][m][0] *= r0; acc[ai][bj][m][1] *= r1; }
                } else { bf16_t* mp = MG + row * 1024 + col0;
#pragma unroll
                    for (int bj = 0; bj < 2; ++bj) *(u32x4*)(mp + bj * HALF) = pack8(dq4u8(ga[q][bj].x) * (acc[ai][bj][m][0] * (1.0f / 255.0f)), dq4u8(ga[q][bj].y) * (acc[ai][bj][m][1] * (1.0f / 255.0f))); } }
          }
    }
};
struct BranchOrder {
    static constexpr bool KEEP = true;
    StaticOrder S0;
    __device__ __forceinline__ bool next(int i, Unit& u) const { Unit t; if (!S0.next(i / 3, t)) return false; u.pm = t.pm; u.pn = 4 * (i % 3) + t.pn; u.roff = 0; u.nai = 2; return true; }
    __device__ __forceinline__ void a_ready(const Unit&) const {}
    __device__ __forceinline__ void done(const Unit&) const {}
};

template <class Epi, class Sched, bool ALIGN_EPI = false, bool SP2 = false>
__device__ __forceinline__ void gemm_phase(PG8_LAS unsigned char* lds, const Gemm g, const Sched& S, const Epi& E) {
    int tid_l = threadIdx.x; asm volatile("" : "+v"(tid_l));
    const int tid = tid_l, wid = __builtin_amdgcn_readfirstlane(tid >> 6), lane = tid & 63, wr = wid >> 2, wc = wid & 3, fr = lane & 15, fq = lane >> 4;
    const int K = g.K, nt = K / BK;
    unsigned voffA[2], voffB[2];
#pragma unroll
    for (int i = 0; i < 2; ++i) { int R, C; stage_rc(tid * 16 + i * 8192, R, C); const int Rb = Epi::PERM ? ((R & ~31) + perm32(R & 31)) : R;
        voffA[i] = (unsigned)(R * K + C) * 2u; voffB[i] = (unsigned)(Rb * K + C) * 2u; }
    const size_t kstep = (size_t)(BK * 2);
    const size_t hstep = (size_t)HALF * K * 2;
    const size_t tstep = 2 * hstep;
    const unsigned ldsw = (unsigned)wid * 1024u;
    const int aoff = lds_byte(wr * 64 + fr, fq * 8), boff = lds_byte(wc * 32 + fr, fq * 8);
#define PG8_SA(b, h) (((b) * 2 + (h)) * HTB)
#define PG8_SB(b, h) ((4 + (b) * 2 + (h)) * HTB)
#define PG8_STAGE(bufoff, gbase, voff) do { _Pragma("unroll") for (int _i = 0; _i < 2; ++_i) \
        __builtin_amdgcn_global_load_lds((const unsigned*)((const char*)(gbase) + (voff)[_i]), (PG8_LAS unsigned*)(lds + (bufoff) + ldsw + _i * 8192), 16, 0, 0); } while (0)
#define PG8_LDA(dst, b, h) do { _Pragma("unroll") for (int m = 0; m < 4; ++m) _Pragma("unroll") for (int k = 0; k < 2; ++k) dst[m][k] = *(const PG8_LAS bf16x8*)(lds + PG8_SA(b, h) + aoff + m * 2048 + k * 1024); } while (0)
#define PG8_LDB(dst, b, h) do { _Pragma("unroll") for (int n = 0; n < 2; ++n) _Pragma("unroll") for (int k = 0; k < 2; ++k) dst[n][k] = *(const PG8_LAS bf16x8*)(lds + PG8_SB(b, h) + boff + n * 2048 + k * 1024); } while (0)
#define PG8_MMA(ai, bj, At, Bt) do { __builtin_amdgcn_s_setprio(1); _Pragma("unroll") for (int m = 0; m < 4; ++m) _Pragma("unroll") for (int n = 0; n < 2; ++n) _Pragma("unroll") for (int k = 0; k < 2; ++k) \
        acc[ai][bj][m][n] = __builtin_amdgcn_mfma_f32_16x16x32_bf16(Bt[n][k], At[m][k], acc[ai][bj][m][n], 0, 0, 0); __builtin_amdgcn_s_setprio(0); } while (0)
#define PG8_WAIT_V(n) asm volatile("s_waitcnt vmcnt(" #n ")" ::: "memory")
#define PG8_WAIT_L(n) asm volatile("s_waitcnt lgkmcnt(" #n ")" ::: "memory")
#define PG8_BAR __builtin_amdgcn_s_barrier()
#define PG8_SCHED __builtin_amdgcn_sched_barrier(0)
    Unit cur, nxt; int ui = 0;
    if (!S.next(0, cur)) return;
    f32x4 acc[2][2][4][2];
#pragma unroll
    for (int a = 0; a < 2; ++a)
#pragma unroll
        for (int b = 0; b < 2; ++b)
#pragma unroll
            for (int m = 0; m < 4; ++m)
#pragma unroll
                for (int n = 0; n < 2; ++n) acc[a][b][m][n] = (f32x4){0.f, 0.f, 0.f, 0.f};
    bf16x8 At[4][2], B0[2][2], B1[2][2];
    const char* cA = (const char*)g.A + (size_t)(cur.pn / g.a_tiles) * g.a_stride + (size_t)cur.pm * tstep + (size_t)cur.roff * K * 2; const char* cB = (const char*)g.Bt + (size_t)cur.pn * tstep;
    S.a_ready(cur);
    if constexpr (SP2) {
        PG8_STAGE(PG8_SB(0, 0), cB, voffB); PG8_STAGE(PG8_SB(0, 1), cB + hstep, voffB); PG8_STAGE(PG8_SA(0, 0), cA, voffA); PG8_STAGE(PG8_SA(0, 1), cA + hstep, voffA);
        if (wr == 1) PG8_BAR;
        PG8_WAIT_V(2); PG8_BAR;
        PG8_STAGE(PG8_SB(1, 0), cB + kstep, voffB); PG8_STAGE(PG8_SA(1, 0), cA + kstep, voffA); PG8_STAGE(PG8_SB(1, 1), cB + hstep + kstep, voffB);
        PG8_WAIT_V(6); PG8_BAR;
    } else {
        PG8_STAGE(PG8_SB(0, 0), cB, voffB); PG8_STAGE(PG8_SA(0, 0), cA, voffA); PG8_STAGE(PG8_SB(0, 1), cB + hstep, voffB); PG8_STAGE(PG8_SA(0, 1), cA + hstep, voffA);
        if (wr == 1) PG8_BAR;
        PG8_WAIT_V(4); PG8_BAR;
        PG8_STAGE(PG8_SB(1, 0), cB + kstep, voffB); PG8_STAGE(PG8_SA(1, 0), cA + kstep, voffA); PG8_STAGE(PG8_SB(1, 1), cB + hstep + kstep, voffB);
        PG8_WAIT_V(6); PG8_BAR;
    }
    for (;;) {
        const bool has_next = S.next(ui + 1, nxt);
        const char* nA = has_next ? (const char*)g.A + (size_t)(nxt.pn / g.a_tiles) * g.a_stride + (size_t)nxt.pm * tstep + (size_t)nxt.roff * K * 2 : cA; const char* nB = has_next ? (const char*)g.Bt + (size_t)nxt.pn * tstep : cB;
        const bool full = (cur.nai == 2);
        for (int t = 0; t < nt; t += 2) {
            const bool last = (t == nt - 2);
            const char* a1 = cA + (size_t)(t + 1) * kstep;
            const char* a2 = last ? nA : cA + (size_t)(t + 2) * kstep; const char* b2 = last ? nB : cB + (size_t)(t + 2) * kstep;
            const char* a3 = a2 + kstep; const char* b3 = b2 + kstep;
            if (last && has_next) S.a_ready(nxt);
            if constexpr (SP2) {
            PG8_LDB(B0, 0, 0); PG8_LDB(B1, 0, 1); PG8_SCHED; PG8_LDA(At, 0, 0); PG8_STAGE(PG8_SA(1, 1), a1 + hstep, voffA);
            PG8_WAIT_V(8); PG8_WAIT_L(0); PG8_BAR; PG8_MMA(0, 0, At, B0); PG8_MMA(0, 1, At, B1); PG8_BAR; PG8_SCHED;
            if (full) PG8_LDA(At, 0, 1); PG8_STAGE(PG8_SB(0, 0), b2, voffB); PG8_STAGE(PG8_SB(0, 1), b2 + hstep, voffB); PG8_STAGE(PG8_SA(0, 0), a2, voffA);
            PG8_WAIT_V(8); PG8_WAIT_L(0); PG8_BAR; if (full) { PG8_MMA(1, 0, At, B0); PG8_MMA(1, 1, At, B1); } PG8_BAR; PG8_SCHED;
            PG8_LDB(B0, 1, 0); PG8_LDB(B1, 1, 1); PG8_SCHED; PG8_LDA(At, 1, 0); PG8_STAGE(PG8_SA(0, 1), a2 + hstep, voffA);
            PG8_WAIT_V(8); PG8_WAIT_L(0); PG8_BAR; PG8_MMA(0, 0, At, B0); PG8_MMA(0, 1, At, B1); PG8_BAR; PG8_SCHED;
            if (full) PG8_LDA(At, 1, 1); PG8_STAGE(PG8_SB(1, 0), b3, voffB); PG8_STAGE(PG8_SB(1, 1), b3 + hstep, voffB); PG8_STAGE(PG8_SA(1, 0), a3, voffA);
            PG8_WAIT_V(8); PG8_WAIT_L(0); PG8_BAR; if (full) { PG8_MMA(1, 0, At, B0); PG8_MMA(1, 1, At, B1); } PG8_BAR; PG8_SCHED;
            } else {
            PG8_LDB(B0, 0, 0); PG8_SCHED; PG8_LDA(At, 0, 0); PG8_STAGE(PG8_SA(1, 1), a1 + hstep, voffA);
            PG8_WAIT_L(8); PG8_BAR; PG8_WAIT_L(0); PG8_MMA(0, 0, At, B0); PG8_BAR; PG8_SCHED;
            PG8_LDB(B1, 0, 1); PG8_STAGE(PG8_SB(0, 0), b2, voffB);
            PG8_BAR; PG8_WAIT_L(0); PG8_MMA(0, 1, At, B1); PG8_BAR;
            PG8_LDA(At, 0, 1); PG8_STAGE(PG8_SA(0, 0), a2, voffA);
            PG8_BAR; PG8_WAIT_L(0); PG8_MMA(1, 0, At, B0); PG8_BAR; PG8_SCHED;
            PG8_STAGE(PG8_SB(0, 1), b2 + hstep, voffB);
            PG8_WAIT_V(6); PG8_BAR; PG8_MMA(1, 1, At, B1); PG8_BAR;
            PG8_LDB(B0, 1, 0); PG8_SCHED; PG8_LDA(At, 1, 0); PG8_STAGE(PG8_SA(0, 1), a2 + hstep, voffA);
            PG8_WAIT_L(8); PG8_BAR; PG8_WAIT_L(0); PG8_MMA(0, 0, At, B0); PG8_BAR; PG8_SCHED;
            PG8_LDB(B1, 1, 1); PG8_STAGE(PG8_SB(1, 0), b3, voffB);
            PG8_BAR; PG8_WAIT_L(0); PG8_MMA(0, 1, At, B1); PG8_BAR;
            PG8_LDA(At, 1, 1); PG8_STAGE(PG8_SA(1, 0), a3, voffA);
            PG8_BAR; PG8_WAIT_L(0); PG8_MMA(1, 0, At, B0); PG8_BAR; PG8_SCHED;
            PG8_STAGE(PG8_SB(1, 1), b3 + hstep, voffB);
            PG8_WAIT_V(6); PG8_BAR; PG8_MMA(1, 1, At, B1); PG8_BAR;
            }
        }
        if constexpr (ALIGN_EPI) { if (wr == 0) PG8_BAR; }
        if constexpr (!Epi::AFTER_DRAIN) { E(acc, cur, wr, wc, fr, fq); S.done(cur); }
        if (!has_next) break;
        if (!Sched::KEEP || (nxt.pn >> 2) == 0) {
#pragma unroll
        for (int a = 0; a < 2; ++a)
#pragma unroll
            for (int b = 0; b < 2; ++b)
#pragma unroll
                for (int m = 0; m < 4; ++m)
#pragma unroll
                    for (int n = 0; n < 2; ++n) acc[a][b][m][n] = (f32x4){0.f, 0.f, 0.f, 0.f};
        }
        cur = nxt; cA = nA; cB = nB; ++ui;
        if constexpr (ALIGN_EPI) { if (wr == 1) PG8_BAR; }
    }
    PG8_WAIT_V(0);
    if constexpr (!ALIGN_EPI) { if (wr == 0) PG8_BAR; }
    PG8_BAR;
    if constexpr (Epi::AFTER_DRAIN) { E.fused(acc, cur, wr, wc, fr, fq, lds, wid, lane); S.done(cur); }
#undef PG8_SA
#undef PG8_SB
#undef PG8_STAGE
#undef PG8_LDA
#undef PG8_LDB
#undef PG8_MMA
#undef PG8_WAIT_V
#undef PG8_WAIT_L
#undef PG8_BAR
#undef PG8_SCHED
}
}

#include <hip/hip_bf16.h>
#include <cmath>
namespace attn_body {
using bf16=__hip_bfloat16;
using bf16x8=__attribute__((ext_vector_type(8)))short;
using s16x4=__attribute__((ext_vector_type(4)))short;
using f32x16=__attribute__((ext_vector_type(16)))float;
using u32x4=__attribute__((ext_vector_type(4)))unsigned;
constexpr int BATCH=2,NHEAD=8,SEQ=8192,D=64,DM=NHEAD*D;
constexpr int NW=8,QBLK=32,QB=QBLK*NW,KVBLK=64,NQB=SEQ/QB;
constexpr int ATTN_PITCH=DM, ATTN_UNIT_ROWS=QB;
__device__ __forceinline__ int crow(int r,int hi){return (r&3)+8*(r>>2)+4*hi;}
#define SBAR() __builtin_amdgcn_sched_barrier(0)
__device__ __forceinline__ void cmask(f32x16&p0,f32x16&p1,int jb,int qrel,int hi){
  const float NEG=-INFINITY; int kb=64*jb+4*hi;
  #pragma unroll
  for(int r=0;r<16;++r){int kv=kb+(r&3)+8*(r>>2); if(kv>qrel)p0[r]=NEG; if(kv+32>qrel)p1[r]=NEG;}
}

constexpr int NSLOT=3, SLOTB=8192;
constexpr int LDS_K=0, LDS_V=NSLOT*SLOTB, LDS_WS=2*NSLOT*SLOTB, LDS_OST=LDS_WS+NW*64*4, LDS_BYTES=LDS_OST+NW*4096;
constexpr float C2=0.125f*1.4426950408889634f; constexpr float LOG2E=1.4426950408889634f; constexpr int TAB_OFF=86016, LDS_BYTES_ALL=TAB_OFF+32768+512; constexpr float NEGBIG=-30000.f;

typedef __attribute__((address_space(3))) float* lds_fptr;
typedef float f32x4a __attribute__((ext_vector_type(4)));
template<int MODE> __device__ __forceinline__ void hook(f32x16&p0,f32x16&p1,int t,int NT,int qrel,int hi,lds_fptr tab,int dbase,int ibase){
  if(MODE==0){
    const lds_fptr tb=tab+64*t+4*hi;
    #pragma unroll
    for(int g=0;g<4;++g){ const f32x4a a=*(const __attribute__((address_space(3))) f32x4a*)(tb+8*g); const f32x4a c=*(const __attribute__((address_space(3))) f32x4a*)(tb+32+8*g);
      p0[4*g+0]+=a.x;p0[4*g+1]+=a.y;p0[4*g+2]+=a.z;p0[4*g+3]+=a.w; p1[4*g+0]+=c.x;p1[4*g+1]+=c.y;p1[4*g+2]+=c.z;p1[4*g+3]+=c.w; }
    const int jb=t-(NT-4); if(jb>=0)cmask(p0,p1,jb,qrel,hi);
  } else {
    const int delta=dbase-t;
    if(delta<0||delta>8){
      #pragma unroll
      for(int r=0;r<16;++r){p0[r]=NEGBIG;p1[r]=NEGBIG;}
    } else if(delta>=3){ const float cf=tab[256];
      #pragma unroll
      for(int r=0;r<16;++r){p0[r]+=cf;p1[r]+=cf;}
    } else { const int ib=64*delta+ibase-4*hi;
      #pragma unroll
      for(int r=0;r<16;++r){ const int kc=(r&3)+8*(r>>2); int i0=ib-kc, i1=ib-32-kc; i0=i0>256?256:i0; i1=i1>256?256:i1; p0[r]+=tab[i0]; p1[r]+=tab[i1]; }
    }
  }
}
__device__ __forceinline__ void glds16(const void*gsrc,unsigned lds_dst){unsigned keep;
  asm volatile("s_mov_b32 %0, m0\n\ts_mov_b32 m0, %2\n\ts_nop 0\n\tglobal_load_lds_dwordx4 %1, off\n\ts_mov_b32 m0, %0":"=&s"(keep):"v"(gsrc),"s"(lds_dst):"memory");}
__device__ __forceinline__ float max3f(float a,float b,float c){float r;asm("v_max3_f32 %0, %1, %2, %3":"=v"(r):"v"(a),"v"(b),"v"(c));return r;}
__device__ __forceinline__ float max2f(float a,float b){float r;asm("v_max_f32_e32 %0, %1, %2":"=v"(r):"v"(a),"v"(b));return r;}
__device__ __forceinline__ float fadd_s(float a,float b){float r;asm("v_add_f32_e32 %0, %1, %2":"=v"(r):"v"(a),"v"(b));return r;}
__device__ __forceinline__ float fsub_s(float a,float b){float r;asm("v_sub_f32_e32 %0, %1, %2":"=v"(r):"v"(a),"v"(b));return r;}
typedef float f32x2_t __attribute__((ext_vector_type(2))); typedef __bf16 bf16x2_t __attribute__((ext_vector_type(2)));
__device__ __forceinline__ unsigned cvtpk_s(float lo,float hi){f32x2_t v={lo,hi};bf16x2_t b=__builtin_convertvector(v,bf16x2_t);return __builtin_bit_cast(unsigned,b);}
#define WAIT_BAR(N) asm volatile("s_waitcnt vmcnt(" #N ") lgkmcnt(0)\n\ts_barrier":::"memory")

__device__ __forceinline__ void qkt(f32x16&p0,f32x16&p1,const char*Kslot,const bf16x8*qr,const f32x16&negm,int r32,int hi){
  const char*kb=Kslot+hi*1024+r32*16;
  #pragma unroll
  for(int d0=0;d0<4;++d0){
    const bf16x8 b0=*reinterpret_cast<const bf16x8*>(kb+d0*2048);
    const bf16x8 b1=*reinterpret_cast<const bf16x8*>(kb+d0*2048+512);
    if(d0==0){p0=__builtin_amdgcn_mfma_f32_32x32x16_bf16(b0,qr[0],negm,0,0,0);p1=__builtin_amdgcn_mfma_f32_32x32x16_bf16(b1,qr[0],negm,0,0,0);}
    else{p0=__builtin_amdgcn_mfma_f32_32x32x16_bf16(b0,qr[d0],p0,0,0,0);p1=__builtin_amdgcn_mfma_f32_32x32x16_bf16(b1,qr[d0],p1,0,0,0);}}
}
typedef __attribute__((address_space(3))) const char* lds_cptr;
typedef short v4i16_t __attribute__((ext_vector_type(4)));
__device__ __forceinline__ void kload8(bf16x8*kf,lds_cptr kp){
  kf[0]=*(const __attribute__((address_space(3))) bf16x8*)(kp);      kf[1]=*(const __attribute__((address_space(3))) bf16x8*)(kp+512);
  kf[2]=*(const __attribute__((address_space(3))) bf16x8*)(kp+2048); kf[3]=*(const __attribute__((address_space(3))) bf16x8*)(kp+2560);
  kf[4]=*(const __attribute__((address_space(3))) bf16x8*)(kp+4096); kf[5]=*(const __attribute__((address_space(3))) bf16x8*)(kp+4608);
  kf[6]=*(const __attribute__((address_space(3))) bf16x8*)(kp+6144); kf[7]=*(const __attribute__((address_space(3))) bf16x8*)(kp+6656);
}
__device__ __forceinline__ void kload2(bf16x8*kf,lds_cptr kp,int j){ kf[2*j]=*(const __attribute__((address_space(3))) bf16x8*)(kp+j*2048); kf[2*j+1]=*(const __attribute__((address_space(3))) bf16x8*)(kp+j*2048+512); }
__device__ __forceinline__ s16x4 vtr(lds_cptr p){ return __builtin_bit_cast(s16x4,__builtin_amdgcn_ds_read_tr16_b64_v4i16((__attribute__((address_space(3))) v4i16_t*)p)); }
__device__ __forceinline__ float rowmax(const f32x16&p0,const f32x16&p1){
  float a=max3f(p0[0],p0[1],p1[0]),b=max3f(p0[2],p0[3],p1[1]);a=max3f(a,p1[2],p1[3]);
  #pragma unroll
  for(int r=4;r<16;r+=4){a=max3f(a,p0[r],p0[r+1]);b=max3f(b,p0[r+2],p0[r+3]);a=max3f(a,p1[r],p1[r+1]);b=max3f(b,p1[r+2],p1[r+3]);}
  const float m=max2f(a,b);
  auto rr=__builtin_amdgcn_permlane32_swap(__float_as_uint(m),__float_as_uint(m),false,false);
  return max2f(__uint_as_float(rr[0]),__uint_as_float(rr[1]));
}
__device__ __forceinline__ void pv(f32x16*o,int vb,bf16x8 pa0,bf16x8 pa1,bf16x8 pa2,bf16x8 pa3){
  #pragma unroll
  for(int d0=0;d0<2;++d0){s16x4 lo[4],hi[4];
    #pragma unroll
    for(int ks=0;ks<4;++ks){
      asm volatile("ds_read_b64_tr_b16 %0,%1 offset:%c2":"=&v"(lo[ks]):"v"(vb),"i"(d0*4096+ks*1024):"memory");
      asm volatile("ds_read_b64_tr_b16 %0,%1 offset:%c2":"=&v"(hi[ks]):"v"(vb),"i"(d0*4096+ks*1024+512):"memory");}
    asm volatile("s_waitcnt lgkmcnt(0)":::"memory");SBAR();
    #define PK(k) (bf16x8){lo[k][0],lo[k][1],lo[k][2],lo[k][3],hi[k][0],hi[k][1],hi[k][2],hi[k][3]}
    o[d0]=__builtin_amdgcn_mfma_f32_32x32x16_bf16(pa0,PK(0),o[d0],0,0,0);
    o[d0]=__builtin_amdgcn_mfma_f32_32x32x16_bf16(pa1,PK(1),o[d0],0,0,0);
    o[d0]=__builtin_amdgcn_mfma_f32_32x32x16_bf16(pa2,PK(2),o[d0],0,0,0);
    o[d0]=__builtin_amdgcn_mfma_f32_32x32x16_bf16(pa3,PK(3),o[d0],0,0,0);
    #undef PK
  }
}

#ifndef ATTN_STORE16
#define ATTN_STORE16(p,v) (*(u32x4*)(p)=(v))
#endif
template<int MODE,int THRL> __device__ __forceinline__ void attn_unit(int b,int h,int qb,const bf16*Q,const bf16*__restrict__ K,const bf16*__restrict__ V,bf16*O,char*shm,const float*aux0,const float*aux1,const float*aux2){
  int tid_l=threadIdx.x; asm volatile("":"+v"(tid_l)); const int tid=tid_l,lane=tid&63,r32=lane&31,hi=lane>>5; const int wid=__builtin_amdgcn_readfirstlane(tid>>6);
  const long rowbase=(long)b*SEQ; const int q0=qb*QB;
  const bf16*Qw=Q+(rowbase+q0+wid*QBLK)*DM+h*D;
  int T0;
  if(MODE==1){ T0=(4*qb-8)>0?(4*qb-8):0; }
  else {
    const lds_fptr bp0=(lds_fptr)((lds_cptr)shm+TAB_OFF)+8192;
    if(wid==0){ const float a=aux1[(b*128+lane)*32+h], c=aux1[(b*128+64+lane)*32+h]; float sa=a, sc=c;
      #pragma unroll
      for(int o=1;o<64;o<<=1){ const float ta=__shfl_up(sa,o), tc=__shfl_up(sc,o); if(lane>=o){sa+=ta;sc+=tc;} }
      const float tot=__shfl(sa,63); bp0[lane]=sa-a; bp0[64+lane]=tot+sc-c; }
    asm volatile("s_waitcnt vmcnt(0) lgkmcnt(0)\n\ts_barrier":::"memory");
    const float*cum0=aux0+(long)(b*NHEAD+h)*SEQ; const int ntp=q0/KVBLK;
    float gq=fabsf(aux2[128+lane]), gk=fabsf(aux2[192+lane]);
    #pragma unroll
    for(int o=1;o<64;o<<=1){ gq=fmaxf(gq,__shfl_xor(gq,o)); gk=fmaxf(gk,__shfl_xor(gk,o)); }
    const float thr=-(cum0[q0]+bp0[q0>>6])*LOG2E-(2.02f*8.f*LOG2E*gq*gk+38.f);
    bool c0=false,c1=false;
    if(lane<ntp) c0=(-(cum0[64*lane+63]+bp0[lane])*LOG2E<thr);
    if(lane+64<ntp) c1=(-(cum0[64*(lane+64)+63]+bp0[lane+64])*LOG2E<thr);
    const int cnt=__popcll(__ballot(c0))+__popcll(__ballot(c1));
    T0=__builtin_amdgcn_readfirstlane(cnt&~1);
  }
  const bf16*Kh=K+(rowbase+(long)T0*KVBLK)*DM+h*D,*Vh=V+(rowbase+(long)T0*KVBLK)*DM+h*D;
  const unsigned lds0=(unsigned)(uintptr_t)shm;
  float*wsf=(float*)(shm+LDS_WS)+wid*64;
  const bf16*ksrc=Kh+(long)lane*DM+wid*8;
  const bf16*vsrc=Vh+(long)(16*(wid&3)+(lane>>2))*DM+(wid>>2)*32+(lane&3)*8;
  const unsigned kdst=lds0+LDS_K+wid*1024, vdst=lds0+LDS_V+wid*1024;
  #define DMA_K(t,slot) glds16(ksrc+(long)(t)*KVBLK*DM,(unsigned)__builtin_amdgcn_readfirstlane(kdst+(slot)))
  #define DMA_V(t,slot) glds16(vsrc+(long)(t)*KVBLK*DM,(unsigned)__builtin_amdgcn_readfirstlane(vdst+(slot)))
  const int vb0=(int)(lds0+LDS_V)+((lane>>4)&1)*32+(lane&3)*8+(4*hi+((lane&15)>>2))*64;
  const char*Kbase=shm+LDS_K; bf16x8 kf[8];
  const lds_cptr shm3=(lds_cptr)shm; const lds_cptr kp0=shm3+LDS_K+hi*1024+r32*16; const lds_cptr vp0=shm3+LDS_V+((lane>>4)&1)*32+(lane&3)*8+(4*hi+((lane&15)>>2))*64;
  const int NT=(q0+QB)/KVBLK-T0;
  const lds_fptr tab=(lds_fptr)(shm3+TAB_OFF);
  const int dbase=4*qb+(wid>>1)-T0, ibase=32*(wid&1)+r32+128; const lds_fptr tabh=(MODE==0)?tab+64*T0:tab;
  if(MODE==0){
    const lds_fptr bp=tab+8192;
    const int nkeys=q0+QB; const float*cum=aux0+(long)(b*NHEAD+h)*SEQ;
    for(int j0=64*T0+tid;j0<nkeys;j0+=2048){ float cv[4];
      #pragma unroll
      for(int u4=0;u4<4;++u4){const int jj=j0+512*u4; cv[u4]=(jj<nkeys)?cum[jj]:0.f;}
      #pragma unroll
      for(int u4=0;u4<4;++u4){const int jj=j0+512*u4; if(jj<nkeys) tab[jj]=-(cv[u4]+bp[jj>>6])*LOG2E;} }
  } else {
    if(tid<257) tab[tid]=aux0[tid]*LOG2E;
  }
  DMA_K(0,0);DMA_V(0,0);DMA_K(1,SLOTB);
  bf16x8 qr[4];
  #pragma unroll
  for(int d0=0;d0<4;++d0)qr[d0]=*reinterpret_cast<const bf16x8*>(&Qw[(long)r32*DM+d0*16+hi*8]);
  float mhat=0.f,l_reg=0.f;f32x16 o[2];o[0]=f32x16{};o[1]=f32x16{};f32x16 negm=f32x16{};asm volatile("":"+v"(negm));
  const int qrel=wid*QBLK+r32;
  #define CMASK(P0,P1,t) hook<MODE>(P0,P1,(t),NT,qrel,hi,tabh,dbase,ibase)
  bool resc=false;
  #define START(P0,P1) do{ const float rm=rowmax(P0,P1); resc=false; \
    { const float dl=rm; mhat=fadd_s(mhat,dl); \
      _Pragma("unroll") for(int r=0;r<16;++r){P0[r]=fsub_s(P0[r],dl);P1[r]=fsub_s(P1[r],dl);} \
      _Pragma("unroll") for(int r=0;r<16;++r)negm[r]=-mhat; asm volatile("":"+v"(negm)); } \
    _Pragma("unroll") for(int r=0;r<16;++r)P0[r]=__builtin_amdgcn_exp2f(P0[r]); }while(0)
  #define RESC() do{ if(resc){ asm volatile("s_waitcnt lgkmcnt(0)":::"memory"); \
      _Pragma("unroll") for(int d_=0;d_<2;++d_) _Pragma("unroll") for(int r=0;r<16;++r)o[d_][r]*=wsf[crow(r,hi)]; } }while(0)
  f32x16 pA0,pA1,pB0,pB1;
  int sl_prev=0,sl_cur=0,sl_next=SLOTB;
  #define ROT() do{sl_prev=sl_cur;sl_cur=sl_next;sl_next=(sl_next==(NSLOT-1)*SLOTB)?0:sl_next+SLOTB;}while(0)
  DMA_K(2,2*SLOTB);
  WAIT_BAR(3);
  qkt(pA0,pA1,Kbase,qr,negm,r32,hi);asm volatile("s_nop 15\n\ts_nop 7":"+v"(pA0),"+v"(pA1));CMASK(pA0,pA1,0);
  START(pA0,pA1);
  _Pragma("unroll") for(int r=0;r<16;++r)pA1[r]=__builtin_amdgcn_exp2f(pA1[r]);
  WAIT_BAR(0);
  DMA_K(3,0);DMA_V(1,SLOTB);
  ROT();
  kload8(kf,kp0+sl_cur);
  WAIT_BAR(2);
  s16x4 vlo[8],vhi[8]; u32x4 pw0,pw1,pw2,pw3;
  #define PKW(P,B) cvtpk_s(P[B],P[B+1])
  #define PAF(k) __builtin_bit_cast(bf16x8,pw##k)
  #define VFR(i) (bf16x8){vlo[i][0],vlo[i][1],vlo[i][2],vlo[i][3],vhi[i][0],vhi[i][1],vhi[i][2],vhi[i][3]}
  #define PIN(x) asm volatile("":"+v"(x))
  #define MX3(a,b,c) __builtin_fmaxf(__builtin_fmaxf((a),(b)),(c))
  #define GAPA(MF,A0,A1,A2,A3,W0,W1,PW) do{ MF; sacc+=A0; sacc+=A1; sacc+=A2; sacc+=A3; PIN(sacc); W0; W1; PIN(PW); SBAR(); }while(0)
  #define EX(v) __builtin_amdgcn_exp2f(v)
  #define GAPB(MF,X,B) do{ MF; X[B]=EX(X[B]); X[B+1]=EX(X[B+1]); X[B+2]=EX(X[B+2]); X[B+3]=EX(X[B+3]); PIN(X); SBAR(); }while(0)
  #define VRD(i) do{ vlo[i]=vtr(vp_+(((i)>>2)*4096+((i)&3)*1024)); vhi[i]=vtr(vp_+(((i)>>2)*4096+((i)&3)*1024+512)); }while(0)
  #define KRD(G,j) do{ if(G){ kload2(kf,kp0+sl_next,j); SBAR(); } }while(0)
  #define STEP(C0,C1,P0,P1,t,GK,GV,GL) do{ SBAR(); \
    const lds_cptr vp_=vp0+sl_prev; \
    VRD(0); SBAR(); float sacc=(P0[0]+P0[1]); \
    GAPA(C0=__builtin_amdgcn_mfma_f32_32x32x16_bf16(kf[0],qr[0],negm,0,0,0), P0[2],P0[3],P0[4],P0[5],     pw0[0]=PKW(P0,0), pw0[1]=PKW(P0,2), pw0); \
    VRD(4); SBAR(); GAPA(C1=__builtin_amdgcn_mfma_f32_32x32x16_bf16(kf[1],qr[0],negm,0,0,0), P0[6],P0[7],P0[8],P0[9],     pw0[2]=PKW(P0,4), pw0[3]=PKW(P0,6), pw0); \
    VRD(1); SBAR(); GAPA(C0=__builtin_amdgcn_mfma_f32_32x32x16_bf16(kf[2],qr[1],C0,0,0,0),   P0[10],P0[11],P0[12],P0[13], pw1[0]=PKW(P0,8), pw1[1]=PKW(P0,10), pw1); \
    VRD(5); SBAR(); GAPA(C1=__builtin_amdgcn_mfma_f32_32x32x16_bf16(kf[3],qr[1],C1,0,0,0),   P0[14],P0[15],P1[0],P1[1],   pw1[2]=PKW(P0,12),pw1[3]=PKW(P0,14), pw1); \
    VRD(2); SBAR(); GAPA(C0=__builtin_amdgcn_mfma_f32_32x32x16_bf16(kf[4],qr[2],C0,0,0,0),   P1[2],P1[3],P1[4],P1[5],     pw2[0]=PKW(P1,0), pw2[1]=PKW(P1,2), pw2); \
    VRD(6); SBAR(); GAPA(C1=__builtin_amdgcn_mfma_f32_32x32x16_bf16(kf[5],qr[2],C1,0,0,0),   P1[6],P1[7],P1[8],P1[9],     pw2[2]=PKW(P1,4), pw2[3]=PKW(P1,6), pw2); \
    VRD(3); SBAR(); GAPA(C0=__builtin_amdgcn_mfma_f32_32x32x16_bf16(kf[6],qr[3],C0,0,0,0),   P1[10],P1[11],P1[12],P1[13], pw3[0]=PKW(P1,8), pw3[1]=PKW(P1,10), pw3); \
    VRD(7); SBAR(); GAPA(C1=__builtin_amdgcn_mfma_f32_32x32x16_bf16(kf[7],qr[3],C1,0,0,0),   P1[14],P1[15],0.f,0.f,       pw3[2]=PKW(P1,12),pw3[3]=PKW(P1,14), pw3); \
    l_reg+=sacc; \
    if(GK){DMA_K((t)+3,sl_cur);} if(GV){DMA_V((t)+1,sl_next);} \
    CMASK(C0,C1,t); \
    { float a=MX3(C0[0],C0[1],C1[0]),b=MX3(C0[2],C0[3],C1[1]); a=MX3(a,C1[2],C1[3]); \
      _Pragma("unroll") for(int r=4;r<16;r+=4){a=MX3(a,C0[r],C0[r+1]);b=MX3(b,C0[r+2],C0[r+3]);a=MX3(a,C1[r],C1[r+1]);b=MX3(b,C1[r+2],C1[r+3]);} \
      float rm=__builtin_fmaxf(a,b); { auto rr=__builtin_amdgcn_permlane32_swap(__float_as_uint(rm),__float_as_uint(rm),false,false); rm=__builtin_fmaxf(__uint_as_float(rr[0]),__uint_as_float(rr[1])); } \
      resc=false; \
      if(__builtin_expect(__any(rm>(float)THRL),0)){ const float dl=__builtin_fmaxf(rm,0.f); mhat+=dl; \
        _Pragma("unroll") for(int r=0;r<16;++r){C0[r]-=dl;C1[r]-=dl;} \
        _Pragma("unroll") for(int r=0;r<16;++r)negm[r]=-mhat; asm volatile("":"+v"(negm)); \
        const float f=__builtin_amdgcn_exp2f(-dl); l_reg*=f; if(hi==0)wsf[r32]=f; resc=true; } } \
    SBAR(); \
    GAPB(o[0]=__builtin_amdgcn_mfma_f32_32x32x16_bf16(PAF(0),VFR(0),o[0],0,0,0), C0,0); \
    GAPB(o[1]=__builtin_amdgcn_mfma_f32_32x32x16_bf16(PAF(0),VFR(4),o[1],0,0,0), C0,4); \
    KRD(GL,0); GAPB(o[0]=__builtin_amdgcn_mfma_f32_32x32x16_bf16(PAF(1),VFR(1),o[0],0,0,0), C0,8); \
    KRD(GL,1); GAPB(o[1]=__builtin_amdgcn_mfma_f32_32x32x16_bf16(PAF(1),VFR(5),o[1],0,0,0), C0,12); \
    KRD(GL,2); GAPB(o[0]=__builtin_amdgcn_mfma_f32_32x32x16_bf16(PAF(2),VFR(2),o[0],0,0,0), C1,0); \
    KRD(GL,3); GAPB(o[1]=__builtin_amdgcn_mfma_f32_32x32x16_bf16(PAF(2),VFR(6),o[1],0,0,0), C1,4); \
    GAPB(o[0]=__builtin_amdgcn_mfma_f32_32x32x16_bf16(PAF(3),VFR(3),o[0],0,0,0), C1,8); \
    GAPB(o[1]=__builtin_amdgcn_mfma_f32_32x32x16_bf16(PAF(3),VFR(7),o[1],0,0,0), C1,12); \
    }while(0)
  int t=1;
  for(;t+5<NT;t+=2){
    STEP(pB0,pB1,pA0,pA1,t,true,true,true);     WAIT_BAR(2); RESC(); ROT();
    STEP(pA0,pA1,pB0,pB1,t+1,true,true,true);   WAIT_BAR(2); RESC(); ROT();
  }
  #define ENDW(tt) do{ if((tt)+3<NT){WAIT_BAR(2);} else if((tt)+2<NT){WAIT_BAR(1);} else {WAIT_BAR(0);} }while(0)
  for(;t+1<NT;t+=2){
    STEP(pB0,pB1,pA0,pA1,t,(t+3<NT),(t+1<NT),(t+1<NT));       ENDW(t);   RESC(); ROT();
    STEP(pA0,pA1,pB0,pB1,t+1,(t+4<NT),(t+2<NT),(t+2<NT));     ENDW(t+1); RESC(); ROT();
  }
  STEP(pB0,pB1,pA0,pA1,NT-1,false,false,false); RESC();
  { float sacc=pB0[0]+pB0[1]; _Pragma("unroll") for(int r=2;r<16;++r)sacc+=pB0[r]; _Pragma("unroll") for(int r=0;r<16;++r)sacc+=pB1[r]; l_reg+=sacc;
    pw0=(u32x4){PKW(pB0,0),PKW(pB0,2),PKW(pB0,4),PKW(pB0,6)};pw1=(u32x4){PKW(pB0,8),PKW(pB0,10),PKW(pB0,12),PKW(pB0,14)};pw2=(u32x4){PKW(pB1,0),PKW(pB1,2),PKW(pB1,4),PKW(pB1,6)};pw3=(u32x4){PKW(pB1,8),PKW(pB1,10),PKW(pB1,12),PKW(pB1,14)};
    SBAR(); pv(o,vb0+sl_cur,PAF(0),PAF(1),PAF(2),PAF(3)); }
  #undef PKW
  #undef PAF
  #undef VFR
  #undef PIN
  #undef MX3
  #undef GAPA
  #undef GAPB
  #undef EX
  #undef VRD
  #undef KRD
  #undef STEP
  #undef ENDW
  {auto rr=__builtin_amdgcn_permlane32_swap(__float_as_uint(l_reg),__float_as_uint(l_reg),false,false);l_reg=__uint_as_float(rr[0])+__uint_as_float(rr[1]);}
  if(hi==0)wsf[32+r32]=l_reg;asm volatile("s_waitcnt lgkmcnt(0)":::"memory");
  float rli[16];
  #pragma unroll
  for(int r=0;r<16;++r)rli[r]=__builtin_amdgcn_rcpf(wsf[32+crow(r,hi)]);
  bf16*Ow=O+(rowbase+q0+wid*QBLK)*DM+h*D;
  { bf16*stg=(bf16*)(shm+LDS_OST)+wid*2048;
    #pragma unroll
    for(int r=0;r<16;++r){const int orow=crow(r,hi);
      #pragma unroll
      for(int d0=0;d0<2;++d0)stg[orow*64+d0*32+r32]=__float2bfloat16(o[d0][r]*rli[r]);}
    asm volatile("s_waitcnt lgkmcnt(0)":::"memory");
    #pragma unroll
    for(int i=0;i<4;++i){const int row=i*8+(lane>>3),ch=lane&7; const u32x4 v=*(const u32x4*)(stg+row*64+ch*8); ATTN_STORE16(Ow+(long)row*DM+ch*8,v);} }
  asm volatile("s_waitcnt lgkmcnt(0)\n\ts_barrier":::"memory");
  #undef DMA_K
  #undef DMA_V
  #undef CMASK
  #undef START
  #undef RESC
  #undef ROT
}
constexpr int ATTN_LDS_BYTES=LDS_BYTES_ALL;
#undef SBAR
#undef WAIT_BAR
}

constexpr int NWAVES = 8;
constexpr int M = 16384, D = 1024, FF = 2816, NGU = 5632, NIN = 6656, DIN = 6664, SEQ = 8192;
constexpr size_t MiB = 1u << 20;
constexpr size_t WS_MOD = 0;
constexpr size_t WS_WF = 256 * 1024;
constexpr size_t WS_BT = 320 * 1024;
constexpr size_t WS_CTL = 1536 * 1024, CTL_ZERO_BYTES = 131072;
constexpr size_t WS_XBUF = WS_CTL + 131072;
constexpr size_t WS_CUM = 1 * MiB;
constexpr size_t WS_WGU = 2 * MiB;
constexpr size_t WS_WD = WS_WGU + 22 * MiB;
constexpr size_t WS_WIN = WS_WD + 11 * MiB;
constexpr size_t WS_WBR = WS_WIN + 13 * MiB;
constexpr size_t WS_WO = WS_WBR + 3 * MiB;
constexpr size_t WS_XN = 54 * MiB;
constexpr size_t WS_BIG = 86 * MiB;
constexpr size_t SLOT = 16 * MiB;
constexpr size_t WS_G = WS_BIG + 8 * SLOT;
constexpr size_t WS_MG = WS_BIG + 3 * SLOT;
constexpr size_t WS_END = WS_G + 96 * MiB;
static_assert(WS_WO + 2 * MiB <= WS_XN, "weights fit");
constexpr int LDS_BYTES = 147456;

#define LAS __attribute__((address_space(3)))
typedef unsigned short bf16;
typedef unsigned v4u __attribute__((ext_vector_type(4)));
typedef float f32x4 __attribute__((ext_vector_type(4)));
#define LDS_WAIT() asm volatile("s_waitcnt lgkmcnt(0)" ::: "memory")
__device__ __forceinline__ unsigned f2bf(float f) { unsigned u = __builtin_bit_cast(unsigned, f); return (u + 0x7fffu + ((u >> 16) & 1u)) >> 16; }
__device__ __forceinline__ unsigned pk2(float lo, float hi) { return f2bf(lo) | (f2bf(hi) << 16); }
__device__ __forceinline__ float wave_sum(float v) {
#pragma unroll
    for (int o = 1; o < 64; o <<= 1) v += __shfl_xor(v, o);
    return v;
}
__device__ __forceinline__ float silu_f(float x) { return x / (1.0f + __expf(-x)); }

__device__ __forceinline__ void transpose_item(const float* __restrict__ W, int ldw, int k0, int c0, bf16* WT, int K, int drow0, LAS float* scr, int lane) {
    { const int kr = lane >> 3, n4 = lane & 7;
      f32x4 v[8];
#pragma unroll
      for (int i = 0; i < 8; ++i) v[i] = *(const f32x4*)(W + (size_t)(k0 + 8 * i + kr) * ldw + c0 + 4 * n4);
#pragma unroll
      for (int i = 0; i < 8; ++i) { LAS float* p = scr + (8 * i + kr) * 33 + 4 * n4; p[0] = v[i].x; p[1] = v[i].y; p[2] = v[i].z; p[3] = v[i].w; } }
    LDS_WAIT(); asm volatile("" ::: "memory");
    const int c = lane & 7;
#pragma unroll
    for (int j = 0; j < 4; ++j) { const int n = (lane >> 3) + 8 * j; const LAS float* s = scr + (8 * c) * 33 + n;
        v4u o; o.x = pk2(s[0 * 33], s[1 * 33]); o.y = pk2(s[2 * 33], s[3 * 33]); o.z = pk2(s[4 * 33], s[5 * 33]); o.w = pk2(s[6 * 33], s[7 * 33]);
        *(v4u*)(WT + (size_t)(drow0 + n) * K + k0 + 8 * c) = o; }
    LDS_WAIT(); asm volatile("" ::: "memory");
}

#define XB_TMO      128
#define XB_XCNT(j)  (256  + 64 * (j))
#define XB_XSUB(j)  (1280 + 64 * (j))
#define XB_XGEN(j)  (2304 + 64 * (j))
#define XB_TOP      3328
#define XB_TOPGEN   3392
#define XCD_BAR_WORDS 3456
#define XB_SPIN_CAP (1u << 18)

__device__ __forceinline__ unsigned xb_ld(unsigned* p)              { return __hip_atomic_load(p, __ATOMIC_RELAXED, __HIP_MEMORY_SCOPE_AGENT); }
__device__ __forceinline__ unsigned xb_add(unsigned* p, unsigned v) { return __hip_atomic_fetch_add(p, v, __ATOMIC_RELAXED, __HIP_MEMORY_SCOPE_AGENT); }
__device__ __forceinline__ unsigned xb_xcc_id() { return (unsigned)__builtin_amdgcn_s_getreg((3 << 11) | 20) & 0xFu; }
#define XB_SPIN(cond, bar) do { unsigned _sp = 0; while (cond) { __builtin_amdgcn_s_sleep(1); \
    if ((++_sp & 255u) == 0u) { if (xb_ld(&(bar)[XB_TMO])) break; if (_sp > XB_SPIN_CAP) { atomicAdd(&(bar)[XB_TMO], 1u); break; } } } } while (0)

struct XcdBarrier {
    unsigned* bar; unsigned x;
    volatile LAS unsigned* st;
};

__device__ __forceinline__ XcdBarrier xcd_barrier_post(unsigned* bar, volatile LAS unsigned* st) {
    XcdBarrier b; b.bar = bar; b.x = xb_xcc_id(); b.st = st;
    if (threadIdx.x == 0) (void)xb_add(&bar[XB_XCNT(b.x)], 1u);
    return b;
}
__device__ __forceinline__ void xcd_barrier_complete(unsigned* bar, unsigned x, unsigned& nloc, unsigned& nx) {
    const unsigned G = gridDim.x * gridDim.y * gridDim.z;
    unsigned sum, cnt, mine, sp = 0u;
    for (;;) {
        sum = 0u; cnt = 0u; mine = 0u;
#pragma unroll
        for (unsigned j = 0; j < 16; ++j) { const unsigned c = xb_ld(&bar[XB_XCNT(j)]); sum += c; cnt += (c > 0u) ? 1u : 0u; mine = (j == x) ? c : mine; }
        if (sum == G) break;
        __builtin_amdgcn_s_sleep(1);
        if ((++sp & 255u) == 0u) { if (xb_ld(&bar[XB_TMO])) break; if (sp > XB_SPIN_CAP) { atomicAdd(&bar[XB_TMO], 1u); break; } }
    }
    nloc = mine > 0u ? mine : 1u; nx = cnt > 0u ? cnt : 1u;
}

__device__ __forceinline__ void xcd_barrier(const XcdBarrier& b) {
    asm volatile("s_waitcnt vmcnt(0)" ::: "memory");
    __syncthreads();
    if (threadIdx.x == 0) {
        unsigned* bar = b.bar;
        __builtin_amdgcn_s_waitcnt(0);
        unsigned nloc = b.st[0], nx = b.st[1];
        if (nloc == 0u) { xcd_barrier_complete(bar, b.x, nloc, nx); b.st[0] = nloc; b.st[1] = nx; }
        const unsigned old = xb_add(&bar[XB_XSUB(b.x)], 1u);
        const unsigned gen = old / nloc;
        if (old + 1u == (gen + 1u) * nloc) {
            __builtin_amdgcn_fence(__ATOMIC_RELEASE, "agent");
            asm volatile("s_waitcnt vmcnt(0)" ::: "memory");
            const unsigned og = xb_add(&bar[XB_TOP], 1u);
            const unsigned tg = og / nx;
            if (og + 1u == (tg + 1u) * nx) xb_add(&bar[XB_TOPGEN], 1u);
            else XB_SPIN(xb_ld(&bar[XB_TOPGEN]) == tg, bar);
            __builtin_amdgcn_fence(__ATOMIC_ACQUIRE, "agent");
            xb_add(&bar[XB_XGEN(b.x)], 1u);
            asm volatile("s_waitcnt vmcnt(0)" ::: "memory");
        } else {
            XB_SPIN(xb_ld(&bar[XB_XGEN(b.x)]) == gen, bar);
            __builtin_amdgcn_fence(__ATOMIC_ACQUIRE, "agent");
            asm volatile("s_waitcnt vmcnt(0)" ::: "memory");
        }
    }
    __syncthreads();
}

struct Args { const float* in[16]; float* out; unsigned char* ws; int cg_seam, pad; };
__device__ __forceinline__ const float* argp(int i) { auto ka = __builtin_amdgcn_kernarg_segment_ptr(); const __attribute__((address_space(1))) float* r; asm volatile("s_load_dwordx2 %0, %1, %2\n\ts_waitcnt lgkmcnt(0)" : "=s"(r) : "s"(ka), "i"(i * 8) : "memory"); return (const float*)r; }
#define ARG_IN(i) argp(i)
#define ARG_OUT ((float*)argp(16))
#define ARG_WS ((unsigned char*)argp(17))
__device__ __forceinline__ int arg_cg_seam() { auto ka = __builtin_amdgcn_kernarg_segment_ptr(); int r; asm volatile("s_load_dword %0, %1, 144\n\ts_waitcnt lgkmcnt(0)" : "=s"(r) : "s"(ka) : "memory"); return r; }

__device__ __forceinline__ void mod_phase(int j0, int j1, LAS unsigned char* lds, int vcu, int G, int tid, int wave, int lane) {
    unsigned char* ws_ = ARG_WS; float* MOD = (float*)(ws_ + WS_MOD); const float* c = ARG_IN(1); const float* w_ada = ARG_IN(2); const float* b_ada = ARG_IN(3);
    LAS float* part = (LAS float*)lds;
    for (int job = j0 + vcu; job < j1; job += G) {
        const int lm = job / 144, colbase = (job % 144) * 64, kk = lane >> 4, c4 = lane & 15;
        f32x4 acc0 = {0.f, 0.f, 0.f, 0.f}, acc1 = {0.f, 0.f, 0.f, 0.f};
        const float* wp = w_ada + ((size_t)lm * 1024 + wave * 128 + kk) * 9216 + colbase + 4 * c4;
#pragma unroll 8
        for (int i = 0; i < 32; ++i) { const int k = wave * 128 + 4 * i + kk; const f32x4 wv = *(const f32x4*)(wp + (size_t)i * 4 * 9216); const float a0 = silu_f(c[k]), a1 = silu_f(c[1024 + k]); acc0 += a0 * wv; acc1 += a1 * wv; }
#pragma unroll
        for (int e = 0; e < 4; ++e) { acc0[e] += __shfl_xor(acc0[e], 16); acc0[e] += __shfl_xor(acc0[e], 32); acc1[e] += __shfl_xor(acc1[e], 16); acc1[e] += __shfl_xor(acc1[e], 32); }
        if (kk == 0) { *(LAS f32x4*)(part + (wave * 2 + 0) * 64 + 4 * c4) = acc0; *(LAS f32x4*)(part + (wave * 2 + 1) * 64 + 4 * c4) = acc1; }
        __syncthreads();
        if (tid < 128) { const int b = tid >> 6, col = tid & 63; float s = b_ada[lm * 9216 + colbase + col];
#pragma unroll
          for (int w = 0; w < 8; ++w) s += part[(w * 2 + b) * 64 + col];
          MOD[(size_t)(lm * 2 + b) * 9216 + colbase + col] = s; }
        __syncthreads();
    }
}

__device__ __forceinline__ void weights_phase(int l, LAS unsigned char* lds, int vcu, int G, int wave, int lane) {
    LAS float* scr = (LAS float*)(lds + wave * 16384); unsigned char* ws_ = ARG_WS;
    bf16* WGU = (bf16*)(ws_ + WS_WGU); bf16* WD = (bf16*)(ws_ + WS_WD); bf16* WIN = (bf16*)(ws_ + WS_WIN); bf16* WBR = (bf16*)(ws_ + WS_WBR); bf16* WO = (bf16*)(ws_ + WS_WO);
    constexpr int IT_EFF = 1024, IT_GU = 2 * 2 * 16 * 88, IT_DN = 2 * 44 * 32, IT_IN = 16 * 208, IT_BR = 2 * 8 * 32, IT_WO = 16 * 32, IT_WF = 128, NITEMS = IT_EFF + IT_GU + IT_DN + IT_IN + IT_BR + IT_WO + IT_WF;
    const int gw = vcu * NWAVES + wave, NGW = G * NWAVES;
    for (int it = gw; it < NITEMS; it += NGW) {
        int r = it;
        if (r < IT_EFF) {
            const int cblk = r & 127, kh = (r >> 7) & 1, g = r >> 8, ci = kh * 64 + lane;
            const float* wp = ARG_IN(12) + ((size_t)(l * 4 + g) * 128 + ci) * 128; const float* ps = ARG_IN(13) + l * 512 + g * 128;
            const float* wb = ARG_IN(14) + ((size_t)(l * 3 + 1) * 512 + g * 128) * 1024 + cblk * 8;
            f32x4 a0 = {0.f, 0.f, 0.f, 0.f}, a1 = {0.f, 0.f, 0.f, 0.f};
#pragma unroll 16
            for (int e = 0; e < 128; ++e) { const float cf = wp[e] * ps[e]; a0 += cf * *(const f32x4*)(wb + (size_t)e * 1024); a1 += cf * *(const f32x4*)(wb + (size_t)e * 1024 + 4); }
            bf16* dst = WBR + (size_t)(1024 + cblk * 8) * 512 + g * 128 + ci;
            dst[0 * 512] = (bf16)f2bf(a0.x); dst[1 * 512] = (bf16)f2bf(a0.y); dst[2 * 512] = (bf16)f2bf(a0.z); dst[3 * 512] = (bf16)f2bf(a0.w);
            dst[4 * 512] = (bf16)f2bf(a1.x); dst[5 * 512] = (bf16)f2bf(a1.y); dst[6 * 512] = (bf16)f2bf(a1.z); dst[7 * 512] = (bf16)f2bf(a1.w);
        } else if ((r -= IT_EFF) < IT_GU) { const int j = r / 2816; r %= 2816; const int isup = r / 1408; r %= 1408; const int kb = r / 88, nb = r % 88, f0 = 32 * nb;
            const float* src = (isup ? ARG_IN(6) : ARG_IN(5)) + (size_t)(l * 2 + j) * 1024 * 2816;
            transpose_item(src, 2816, 64 * kb, f0, WGU + (size_t)j * NGU * 1024, 1024, 256 * (f0 >> 7) + 128 * isup + (f0 & 127), scr, lane);
        } else if ((r -= IT_GU) < IT_DN) { const int j = r / 1408; r %= 1408; const int kb = r / 32, nb = r % 32;
            transpose_item(ARG_IN(7) + (size_t)(l * 2 + j) * 2816 * 1024, 1024, 64 * kb, 32 * nb, WD + (size_t)j * 1024 * 2816, 2816, 32 * nb, scr, lane);
        } else if ((r -= IT_DN) < IT_IN) { const int kb = r / 208, nb = r % 208, L0 = 32 * nb, c0 = L0 < 3584 ? L0 : L0 + 8, pn = L0 >> 8, w = L0 & 255, hh = w >> 6, dh = (w >> 5) & 1;
            transpose_item(ARG_IN(8) + (size_t)l * 1024 * DIN, DIN, 64 * kb, c0, WIN, 1024, 256 * pn + 128 * dh + 32 * hh, scr, lane);
        } else if ((r -= IT_IN) < IT_BR) { const int n = (r / 256) * 2; r %= 256; const int kb = r / 32, nb = r % 32;
            transpose_item(ARG_IN(14) + (size_t)(l * 3 + n) * 512 * 1024, 1024, 64 * kb, 32 * nb, WBR, 512, n * 1024 + 32 * nb, scr, lane);
        } else if ((r -= IT_BR) < IT_WO) { const int kb = r / 32, nb = r % 32; transpose_item(ARG_IN(15) + (size_t)l * 1024 * 1024, 1024, 64 * kb, 32 * nb, WO, 1024, 32 * nb, scr, lane);
        } else { r -= IT_WO; float* WF = (float*)(ws_ + WS_WF); const int i = r * 64 + lane, hh = i >> 10, k = i & 1023; WF[i] = (ARG_IN(8) + (size_t)l * 1024 * DIN)[(size_t)k * DIN + 3584 + hh]; }
    }
}

__device__ __forceinline__ float log_sigmoid_f(float x) { return fminf(x, 0.f) - log1pf(__expf(-fabsf(x))); }

template <bool MIX>
__device__ __forceinline__ void norm_phase(const float* xin, int l, int sub, LAS unsigned char* lds, int vcu, int G, int tid, int wave, int lane) {
    unsigned char* ws_ = ARG_WS; const float* gain = ARG_IN(4) + (size_t)(l * 3 + sub) * 1024; const float* MOD = (const float*)(ws_ + WS_MOD);
    const float* shift = MOD + (size_t)(l * 2) * 9216 + (3 * sub) * 1024; const float* scale = shift + 1024;
    bf16* XN = (bf16*)(ws_ + WS_XN);
    LAS float* wfs = (LAS float*)lds; LAS float* lfs = (LAS float*)(lds + 32768);
    if (MIX) { const float* WF = (const float*)(ws_ + WS_WF); for (int i = tid; i < 8192; i += 512) wfs[i] = WF[i]; __syncthreads(); }
    for (int blk = vcu; blk < 256; blk += G) {
        const int b = blk >> 7;
#pragma unroll (MIX ? 2 : 4)
        for (int i = 0; i < 8; ++i) { const int rl = wave * 8 + i, row = blk * 64 + rl;
            const f32x4* xr = (const f32x4*)(xin + (size_t)row * 1024) + lane;
            f32x4 v[4]; float ss = 0.f;
#pragma unroll
            for (int j = 0; j < 4; ++j) { v[j] = xr[64 * j]; ss += (v[j].x * v[j].x + v[j].y * v[j].y) + (v[j].z * v[j].z + v[j].w * v[j].w); }
            const float rstd = 1.0f / sqrtf(wave_sum(ss) * (1.0f / 1024.0f) + 1e-6f);
            unsigned long long* o8 = (unsigned long long*)(XN + (size_t)row * 1024) + lane;
#pragma unroll
            for (int j = 0; j < 4; ++j) { const f32x4 g = ((const f32x4*)gain)[64 * j + lane], sc = ((const f32x4*)(scale + b * 9216))[64 * j + lane], sh = ((const f32x4*)(shift + b * 9216))[64 * j + lane];
                v[j] = (v[j] * rstd * g) * (1.0f + sc) + sh;
                o8[64 * j] = (unsigned long long)pk2(v[j].x, v[j].y) | ((unsigned long long)pk2(v[j].z, v[j].w) << 32); }
            if (MIX) { float keep = 0.f;
#pragma unroll
                for (int hh = 0; hh < 8; ++hh) { float p = 0.f;
#pragma unroll
                    for (int j = 0; j < 4; ++j) { const f32x4 w = *(const LAS f32x4*)(wfs + hh * 1024 + 4 * (64 * j + lane)); p += (v[j].x * w.x + v[j].y * w.y) + (v[j].z * w.z + v[j].w * w.w); }
                    p = wave_sum(p); keep = (lane == hh) ? p : keep; }
                if (lane < 8) lfs[rl * 8 + lane] = log_sigmoid_f(keep + ARG_IN(11)[l * 8 + lane]); }
        }
        if (MIX) { __syncthreads();
            float* CUM = (float*)(ws_ + WS_CUM); float* BT = (float*)(ws_ + WS_BT);
            float s = lfs[lane * 8 + wave];
#pragma unroll
            for (int o = 1; o < 64; o <<= 1) { const float t = __shfl_up(s, o); if (lane >= o) s += t; }
            CUM[(size_t)(b * 8 + wave) * SEQ + (blk & 127) * 64 + lane] = s; if (lane == 63) BT[blk * 32 + wave] = s;
            __syncthreads(); }
    }
}

__device__ __forceinline__ void f_phase(int l, LAS unsigned char* lds, int vcu, int G, int tid, int wave, int lane) {
    unsigned char* ws_ = ARG_WS; const bf16* XN = (const bf16*)(ws_ + WS_XN); const float* fb = ARG_IN(11) + l * 8;
    LAS float* wfs = (LAS float*)lds; LAS float* lfs = (LAS float*)(lds + 32768);
    { const float* WF = (const float*)(ws_ + WS_WF); for (int i = tid; i < 8192; i += 512) wfs[i] = WF[i]; __syncthreads(); }
    for (int blk = vcu; blk < 256; blk += G) {
        const int b = blk >> 7;
#pragma unroll 2
        for (int i = 0; i < 8; ++i) { const int rl = wave * 8 + i, row = blk * 64 + rl;
            const v4u* xr = (const v4u*)(XN + (size_t)row * 1024) + lane;
            const v4u a = xr[0], c = xr[64];
            const f32x4 h0 = {__uint_as_float(a.x << 16), __uint_as_float(a.x & 0xffff0000u), __uint_as_float(a.y << 16), __uint_as_float(a.y & 0xffff0000u)};
            const f32x4 h1 = {__uint_as_float(a.z << 16), __uint_as_float(a.z & 0xffff0000u), __uint_as_float(a.w << 16), __uint_as_float(a.w & 0xffff0000u)};
            const f32x4 h2 = {__uint_as_float(c.x << 16), __uint_as_float(c.x & 0xffff0000u), __uint_as_float(c.y << 16), __uint_as_float(c.y & 0xffff0000u)};
            const f32x4 h3 = {__uint_as_float(c.z << 16), __uint_as_float(c.z & 0xffff0000u), __uint_as_float(c.w << 16), __uint_as_float(c.w & 0xffff0000u)};
            float keep = 0.f;
#pragma unroll
            for (int hh = 0; hh < 8; ++hh) { const LAS f32x4* w = (const LAS f32x4*)(wfs + hh * 1024 + 8 * lane);
                const f32x4 w0 = w[0], w1 = w[1], w2 = w[128], w3 = w[129];
                float p = ((h0.x * w0.x + h0.y * w0.y) + (h0.z * w0.z + h0.w * w0.w)) + ((h1.x * w1.x + h1.y * w1.y) + (h1.z * w1.z + h1.w * w1.w))
                        + ((h2.x * w2.x + h2.y * w2.y) + (h2.z * w2.z + h2.w * w2.w)) + ((h3.x * w3.x + h3.y * w3.y) + (h3.z * w3.z + h3.w * w3.w));
                p = wave_sum(p); keep = (lane == hh) ? p : keep; }
            if (lane < 8) lfs[rl * 8 + lane] = log_sigmoid_f(keep + fb[lane]); }
        __syncthreads();
        { float* CUM = (float*)(ws_ + WS_CUM); float* BT = (float*)(ws_ + WS_BT);
          float s = lfs[lane * 8 + wave];
#pragma unroll
          for (int o = 1; o < 64; o <<= 1) { const float t = __shfl_up(s, o); if (lane >= o) s += t; }
          CUM[(size_t)(b * 8 + wave) * SEQ + (blk & 127) * 64 + lane] = s; if (lane == 63) BT[blk * 32 + wave] = s; }
        __syncthreads();
    }
}

__device__ __forceinline__ void pool_un8(const v4u u, float (&f)[8]) {
    f[0] = __uint_as_float(u.x << 16); f[1] = __uint_as_float(u.x & 0xffff0000u); f[2] = __uint_as_float(u.y << 16); f[3] = __uint_as_float(u.y & 0xffff0000u);
    f[4] = __uint_as_float(u.z << 16); f[5] = __uint_as_float(u.z & 0xffff0000u); f[6] = __uint_as_float(u.w << 16); f[7] = __uint_as_float(u.w & 0xffff0000u);
}
__device__ __forceinline__ void pool_phase(const bf16* UB, bf16* DD, int vcu, int G, int tid) {
    for (int blk = vcu; blk < 256; blk += G) {
        const int ch = (tid & 63) * 8, lg = ch >> 7, w = 2 << lg, wv = tid >> 6, tr0 = (blk & 127) * 64 + wv * 8; const size_t row0 = (size_t)blk * 64 + wv * 8;
        v4u u[23];
#pragma unroll
        for (int k = 0; k < 23; ++k) { const int d = k - 15; const bool need = (d >= 1 - w) && (tr0 + d >= 0);
            u[k] = (v4u){0u, 0u, 0u, 0u}; if (need) u[k] = *(const v4u*)(UB + (row0 + d) * 512 + ch); }
        float s[8];
#pragma unroll
        for (int e = 0; e < 8; ++e) s[e] = 0.f;
#pragma unroll
        for (int k = 0; k < 16; ++k) { float f[8]; pool_un8(u[k], f);
#pragma unroll
            for (int e = 0; e < 8; ++e) s[e] += f[e]; }
#pragma unroll
        for (int i = 0; i < 8; ++i) { float cur[8]; pool_un8(u[15 + i], cur);
            if (i > 0) {
                const v4u uo = (lg == 0) ? u[13 + i] : (lg == 1) ? u[11 + i] : (lg == 2) ? u[7 + i] : u[i - 1]; float old[8]; pool_un8(uo, old);
#pragma unroll
                for (int e = 0; e < 8; ++e) s[e] += cur[e] - old[e]; }
            const int t = tr0 + i, cnt = (t + 1 < w) ? t + 1 : w; const float inv = 1.0f / (float)cnt; v4u o;
            o.x = pk2(s[0] * inv - cur[0], s[1] * inv - cur[1]); o.y = pk2(s[2] * inv - cur[2], s[3] * inv - cur[3]); o.z = pk2(s[4] * inv - cur[4], s[5] * inv - cur[5]); o.w = pk2(s[6] * inv - cur[6], s[7] * inv - cur[7]);
            *(v4u*)(DD + (row0 + i) * 512 + ch) = o; }
    }
}

__global__ void __launch_bounds__(NWAVES * 64, 2) mk_fwd(Args) {
    extern __shared__ __attribute__((aligned(16))) unsigned char lds_raw[];
    cg::grid_group grid = cg::this_grid();
    LAS unsigned char* lds = (LAS unsigned char*)lds_raw;
    const int tid = threadIdx.x, lane = tid & 63, wave = __builtin_amdgcn_readfirstlane(tid >> 6);
    const int G = gridDim.x, bx = blockIdx.x, vcu = (G % 8 == 0) ? (bx % 8) * (G / 8) + bx / 8 : bx;
    constexpr size_t SLOT_E = (size_t)M * 512;
    constexpr int NOSPLIT = 1 << 30;
    typedef pg8::bf16_t pbf;
#define CG_SYNC() do { asm volatile("s_waitcnt vmcnt(0) lgkmcnt(0)" ::: "memory"); __syncthreads(); grid.sync(); __builtin_amdgcn_fence(__ATOMIC_ACQUIRE, "agent"); asm volatile("s_waitcnt vmcnt(0)" ::: "memory"); __syncthreads(); } while (0)
#define GRID_SYNC() do { asm volatile("s_waitcnt lgkmcnt(0)" ::: "memory"); XcdBarrier b_; b_.bar = (unsigned*)(ARG_WS + WS_CTL); b_.x = xb_xcc_id(); b_.st = (volatile LAS unsigned*)(lds + 131072 + 256); xcd_barrier(b_); } while (0)
#define FRESH() int G_ = G, bx_ = bx, vcu_ = vcu, tid_ = tid; asm volatile("" : "+s"(G_), "+s"(bx_), "+s"(vcu_), "+v"(tid_)); const int lane_ = tid_ & 63; (void)lane_; (void)bx_
    volatile LAS unsigned* bst = (volatile LAS unsigned*)(lds + 131072 + 256);
    if (tid < 2) bst[tid] = 0u;
    __syncthreads();
    (void)xcd_barrier_post((unsigned*)(ARG_WS + WS_CTL), bst);
    if (arg_cg_seam()) CG_SYNC();
    { FRESH(); mod_phase(0, 32, lds, vcu_, G_, tid_, wave, lane_); }
    GRID_SYNC();
    { FRESH(); norm_phase<false>(ARG_IN(0), 0, 0, lds, vcu_, G_, tid_, wave, lane_); }
    { FRESH(); mod_phase(32, 288, lds, vcu_, G_, tid_, wave, lane_); }
    { FRESH(); weights_phase(0, lds, vcu_, G_, wave, lane_); }
    GRID_SYNC();
    for (int l = 0; l < 2; ++l) {
        if (l == 1) { FRESH(); weights_phase(1, lds, vcu_, G_, wave, lane_); GRID_SYNC(); }
        for (int f = 0; f < 2; ++f) {
#ifndef NO_N
#endif
            {
                FRESH(); unsigned char* ws = ARG_WS;
                pg8::Gemm g{(const pbf*)(ws + WS_XN), (const pbf*)(ws + WS_WGU) + (size_t)f * NGU * 1024, M, NGU, D, NOSPLIT, 0}; pg8::StaticOrder S; S.init(M, NGU, G_, bx_); S.tail = 1;
                pg8::EpiSwiglu E{(pbf*)(ws + WS_BIG), FF};
#ifndef NO_GU
                pg8::gemm_phase<pg8::EpiSwiglu, pg8::StaticOrder, true, true>(lds, g, S, E);
#endif
            }
            GRID_SYNC();
            {
                FRESH(); unsigned char* ws = ARG_WS; float* outp = ARG_OUT;
                pg8::Gemm g{(const pbf*)(ws + WS_BIG), (const pbf*)(ws + WS_WD) + (size_t)f * 1024 * FF, M, D, FF, NOSPLIT, 0}; pg8::StaticOrder S; S.init(M, D, G_, bx_);
                const int nl = (f == 0) ? l : 1, nsub = (f == 0) ? 1 : 0, bank = (f == 0) ? 3 + l : 2, donorm = (f == 0 || l == 0) ? 1 : 0;
                const float* ng_ = ARG_IN(4) + (size_t)(nl * 3 + nsub) * 1024; const float* xin_ = ARG_IN(0);
                const float* nm_ = (const float*)(ws + WS_MOD) + (size_t)(nl * 2) * 9216 + (size_t)(3 * nsub) * 1024;
                pg8::EpiResid E{(f == 0 && l == 0) ? xin_ : (const float*)outp, outp, (const float*)(ws + WS_MOD) + (size_t)(l * 2) * 9216 + (f == 0 ? 2 : 8) * 1024,
                                (pbf*)(ws + WS_XN), ng_, nm_, nm_ + 1024, (float*)(ws + WS_XBUF), (unsigned*)(ws + WS_CTL) + 4096 + bank * 4096, 0.5f, donorm};
#ifndef NO_RES
                pg8::gemm_phase<pg8::EpiResid, pg8::StaticOrder, false, true>(lds, g, S, E);
#endif
            }
            GRID_SYNC();
            if (f == 0) {
                {
                    FRESH(); f_phase(l, lds, vcu_, G_, tid_, wave, lane_); unsigned char* ws = ARG_WS;
                    pg8::Gemm g{(const pbf*)(ws + WS_XN), (const pbf*)(ws + WS_WIN), M, NIN, D, NOSPLIT, 0}; pg8::StaticOrder S; S.init(M, NIN, G_, bx_); S.tail = 1;
                    LAS float* gl = (LAS float*)(lds + 131072 + 1024); if (tid_ < 256) gl[tid_] = (ARG_IN(9) + l * 256)[tid_]; __syncthreads();
                    pg8::EpiInproj E{(pbf*)(ws + WS_BIG), (pbf*)(ws + WS_G), (const LAS float*)gl};
#ifndef NO_IN
                    pg8::gemm_phase<pg8::EpiInproj, pg8::StaticOrder, true, true>(lds, g, S, E);
#endif
                }
                GRID_SYNC();
                {
                    FRESH(); unsigned char* ws = ARG_WS; pbf* SL = (pbf*)(ws + WS_BIG);
#ifndef NO_POOL
                    pool_phase((const bf16*)(SL + 5 * SLOT_E), (bf16*)(SL + 1 * SLOT_E), vcu_, G_, tid_);
#endif
                    using abf = attn_body::bf16;
                    volatile LAS int* hmap = (volatile LAS int*)(lds + 131072 + 288);
                    if (tid_ < 8) { const float* fbp = ARG_IN(11) + l * 8; const float fh = fbp[tid_]; int rank = 0;
#pragma unroll
                        for (int jj = 0; jj < 8; ++jj) { const float fj = fbp[jj]; rank += (fj > fh || (fj == fh && jj < tid_)) ? 1 : 0; }
                        hmap[rank] = tid_; }
                    __syncthreads();
                    for (int uu = vcu_; uu < 256; uu += G_) { const int bh = uu >> 4, s = uu & 15, b = bh >> 3, r = bh & 7;
#ifndef NO_ATTN0
                        for (int i = 0; i < 2; ++i) { const int h = __builtin_amdgcn_readfirstlane(hmap[i ? 7 - r : r]);
                            attn_body::attn_unit<0, 24>(b, h, i ? s : 31 - s, (const abf*)(SL + 2 * SLOT_E), (const abf*)(SL + 6 * SLOT_E), (const abf*)(SL + 7 * SLOT_E), (abf*)(SL + 2 * SLOT_E), (char*)lds_raw, (const float*)(ws + WS_CUM), (const float*)(ws + WS_BT), ARG_IN(9) + l * 256); }
#endif
#ifndef NO_ATTN1
                        for (int i = 0; i < 2; ++i)
                            attn_body::attn_unit<1, 8>(b, r, i ? s : 31 - s, (const abf*)(SL + 0 * SLOT_E), (const abf*)(SL + 3 * SLOT_E), (const abf*)(SL + 4 * SLOT_E), (abf*)(SL + 0 * SLOT_E), (char*)lds_raw, ARG_IN(10) + (size_t)(l * 8 + r) * 257, nullptr, nullptr);
#endif
                    }
                }
                GRID_SYNC();
                {
                    FRESH(); unsigned char* ws = ARG_WS;
                    pg8::Gemm g{(const pbf*)(ws + WS_BIG), (const pbf*)(ws + WS_WBR), M, 3072, 512, 4, SLOT}; pg8::BranchOrder S; S.S0.init(M, D, G_, bx_);
                    pg8::EpiBranch E{(pbf*)(ws + WS_MG), (const pbf*)(ws + WS_G)};
#ifndef NO_BR
                    pg8::gemm_phase<pg8::EpiBranch, pg8::BranchOrder, true, true>(lds, g, S, E);
#endif
                }
                GRID_SYNC();
                {
                    FRESH(); unsigned char* ws = ARG_WS; float* outp = ARG_OUT;
                    pg8::Gemm g{(const pbf*)(ws + WS_MG), (const pbf*)(ws + WS_WO), M, D, D, NOSPLIT, 0}; pg8::StaticOrder S; S.init(M, D, G_, bx_);
                    const float* ng_ = ARG_IN(4) + (size_t)(l * 3 + 2) * 1024;
                    pg8::EpiResid E{outp, outp, (const float*)(ws + WS_MOD) + (size_t)(l * 2) * 9216 + 5 * 1024,
                                    (pbf*)(ws + WS_XN), ng_, (const float*)(ws + WS_MOD) + (size_t)(l * 2) * 9216 + 6 * 1024, (const float*)(ws + WS_MOD) + (size_t)(l * 2) * 9216 + 7 * 1024, (float*)(ws + WS_XBUF), (unsigned*)(ws + WS_CTL) + 4096 + l * 4096, 1.0f, 1};
#ifndef NO_RES
                    pg8::gemm_phase<pg8::EpiResid, pg8::StaticOrder, false, true>(lds, g, S, E);
#endif
                }
                GRID_SYNC();
            }
        }
    }
}

extern "C" void kernel_launch(void* const* d_in, const int* in_sizes, int n_in, void* d_out, int out_size, void* d_ws, size_t ws_size, hipStream_t stream) {
    static int grid = 0;
    if (grid == 0) {
        if (n_in != 16 || out_size != M * D || ws_size < WS_END) { fprintf(stderr, "kernel_launch: unexpected shapes (n_in %d out %d ws %zu need %zu)\n", n_in, out_size, ws_size, (size_t)WS_END); grid = -1; return; }
        int dev = 0, cus = 0, per_cu = 0;
        if (hipGetDevice(&dev) != hipSuccess || hipDeviceGetAttribute(&cus, hipDeviceAttributeMultiprocessorCount, dev) != hipSuccess) { grid = -1; return; }
        if (hipFuncSetAttribute((const void*)mk_fwd, hipFuncAttributeMaxDynamicSharedMemorySize, LDS_BYTES) != hipSuccess) { fprintf(stderr, "kernel_launch: hipFuncSetAttribute failed\n"); grid = -1; return; }
        if (hipOccupancyMaxActiveBlocksPerMultiprocessor(&per_cu, (const void*)mk_fwd, NWAVES * 64, LDS_BYTES) != hipSuccess || per_cu < 1) { fprintf(stderr, "kernel_launch: occupancy query says %d\n", per_cu); per_cu = 1; }
        (void)hipGetLastError();
        grid = cus;
    }
    if (grid < 0) return;
    Args a{};
    for (int i = 0; i < 16; ++i) a.in[i] = (const float*)d_in[i];
    a.out = (float*)d_out; a.ws = (unsigned char*)d_ws; a.cg_seam = 0; a.pad = 0;
    if (hipMemsetAsync((char*)d_ws + WS_CTL, 0, CTL_ZERO_BYTES, stream) != hipSuccess) { fprintf(stderr, "kernel_launch: hipMemsetAsync failed\n"); return; }
    void* params[] = {&a};
    const hipError_t e = hipLaunchCooperativeKernel((const void*)mk_fwd, dim3(grid), dim3(NWAVES * 64), params, LDS_BYTES, stream);
    if (e != hipSuccess) fprintf(stderr, "kernel_launch: cooperative launch failed: %s (grid %d)\n", hipGetErrorString(e), grid);
}
```

```cpp
#include <hip/hip_runtime.h>
#include <hip/hip_cooperative_groups.h>
#include <hip/hip_bf16.h>
#include <cstdio>
#include <cstdint>
#include <cmath>
namespace cg = cooperative_groups;

namespace pg8 {
#define PG8_LAS __attribute__((address_space(3)))
typedef unsigned short bf16_t;
typedef short bf16x8 __attribute__((ext_vector_type(8)));
typedef float f32x4 __attribute__((ext_vector_type(4)));
typedef unsigned u32x4 __attribute__((ext_vector_type(4)));
constexpr int BM = 256, BK = 64, HALF = 128, HTB = HALF * BK * 2  , STAGE_BYTES = 8 * HTB, NXCD = 8, WGM = 8;

__host__ __device__ __forceinline__ int lds_byte(int r, int c) { const int st = (r >> 4) * 2 + (c >> 5), rr = r & 15, cc = c & 31, ob = rr * 64 + cc * 2; return st * 1024 + (ob ^ (((ob >> 9) & 1) << 5)); }
__host__ __device__ __forceinline__ void stage_rc(int b, int& R, int& C) { const int st = b / 1024, sb = b % 1024, swz = sb ^ (((sb >> 9) & 1) << 5); R = (st >> 1) * 16 + swz / 64; C = (st & 1) * 32 + (swz % 64) / 2; }
__host__ __device__ __forceinline__ int perm32(int rho) { const int n = rho >> 4, i = rho & 15; return 8 * (i >> 2) + 4 * n + (i & 3); }

struct Unit { int pm, pn, roff, nai; };
struct Gemm { const bf16_t* A; const bf16_t* Bt; int M, N, K; int a_tiles; size_t a_stride; };

struct StaticOrder {
    static constexpr bool KEEP = false;
    int nM, nN, nwg, G, c;
    __host__ __device__ void init(int M, int N, int G_, int c_) { nM = M / BM; nN = N / BM; nwg = nM * nN; G = G_; c = c_; tail = 0; }
    int tail;
    __host__ __device__ bool next(int i, Unit& u) const {
        long L = (long)i * G + c; u.roff = 0; u.nai = 2;
        const int full = nwg / G;
        if (tail && (nwg - full * G) * 2 == G && i >= full) { if (i > full) return false; L = (long)full * G + (c >> 1); u.roff = 128 * (c & 1); u.nai = 1; }
        if (L >= nwg) return false;
        int wgid = (int)L; { const int q = nwg / NXCD, r = nwg % NXCD, xcd = wgid % NXCD, off = wgid / NXCD; wgid = (xcd < r ? xcd * (q + 1) : r * (q + 1) + (xcd - r) * q) + off; }
        const int nig = WGM * nN, gid = wgid / nig, fm = gid * WGM, gsz = (nM - fm) < WGM ? (nM - fm) : WGM;
        u.pm = fm + ((wgid % nig) % gsz); u.pn = (wgid % nig) / gsz; return true;
    }
    __device__ __forceinline__ void a_ready(const Unit&) const {}
    __device__ __forceinline__ void done(const Unit&) const {}
};

typedef float f32x2c __attribute__((ext_vector_type(2))); typedef __bf16 bf16x2c __attribute__((ext_vector_type(2)));
__device__ __forceinline__ unsigned cvt_pk_bf16(float lo, float hi) { f32x2c v = {lo, hi}; bf16x2c b = __builtin_convertvector(v, bf16x2c); return __builtin_bit_cast(unsigned, b); }

typedef float f32x2 __attribute__((ext_vector_type(2)));
constexpr float EPI_LOG2E = 1.4426950408889634f;
constexpr float EPI_C2 = 0.125f * 1.4426950408889634f;
__device__ __forceinline__ float sigm(float x) { return __builtin_amdgcn_rcpf(1.0f + __builtin_amdgcn_exp2f(-x * EPI_LOG2E)); }
__device__ __forceinline__ f32x4 sigm4(f32x4 v) { return (f32x4){sigm(v[0]), sigm(v[1]), sigm(v[2]), sigm(v[3])}; }
__device__ __forceinline__ u32x4 pack8(f32x4 v0, f32x4 v1) { u32x4 w; w.x = cvt_pk_bf16(v0[0], v0[1]); w.y = cvt_pk_bf16(v0[2], v0[3]); w.z = cvt_pk_bf16(v1[0], v1[1]); w.w = cvt_pk_bf16(v1[2], v1[3]); return w; }
__device__ __forceinline__ f32x4 bf_lo4(unsigned a, unsigned b) { return (f32x4){__uint_as_float(a << 16), __uint_as_float(a & 0xffff0000u), __uint_as_float(b << 16), __uint_as_float(b & 0xffff0000u)}; }

__device__ __forceinline__ unsigned q4u8(f32x4 g) { f32x4 t = g * 255.0f + 0.5f; t[0] = fmaxf(t[0], 1.0f); t[1] = fmaxf(t[1], 1.0f); t[2] = fmaxf(t[2], 1.0f); t[3] = fmaxf(t[3], 1.0f);     return (unsigned)t[0] | ((unsigned)t[1] << 8) | ((unsigned)t[2] << 16) | ((unsigned)t[3] << 24); }
__device__ __forceinline__ f32x4 dq4u8(unsigned w) { return (f32x4){(float)(w & 0xffu), (float)((w >> 8) & 0xffu), (float)((w >> 16) & 0xffu), (float)(w >> 24)}; }
struct EpiSwiglu {
    static constexpr bool PERM = true, AFTER_DRAIN = false;
    bf16_t* H; int ldh;
    __device__ __forceinline__ void operator()(const f32x4 (&acc)[2][2][4][2], const Unit& u, int wr, int wc, int fr, int fq) const {
        const int row0 = u.pm * BM + u.roff + wr * 64 + fr, col0 = u.pn * 128 + wc * 32 + 8 * fq;
#pragma unroll
        for (int ai = 0; ai < 2; ++ai) if (ai < u.nai)
#pragma unroll
            for (int m = 0; m < 4; ++m) { bf16_t* rowp = H + (size_t)(row0 + ai * HALF + m * 16) * ldh + col0;
                const f32x4 g0 = acc[ai][0][m][0], g1 = acc[ai][0][m][1], u0 = acc[ai][1][m][0], u1 = acc[ai][1][m][1];
                const f32x4 h0 = g0 * sigm4(g0) * u0, h1 = g1 * sigm4(g1) * u1;
                *(u32x4*)rowp = pack8(h0, h1); }
    }
};
struct EpiResid {
    static constexpr bool PERM = false, AFTER_DRAIN = true;
    const float* base; float* out; const float* gate;
    bf16_t* xn; const float* ngain; const float* nshift; const float* nscale; float* xbuf; unsigned* cnt; float coef; int donorm;
    __device__ __forceinline__ void fused(f32x4 (&acc)[2][2][4][2], const Unit& u, int wr, int wc, int fr, int fq, PG8_LAS unsigned char* lds, int wid, int lane) const {
        const int row0 = u.pm * BM + wr * 64 + fr, col0 = u.pn * BM + wc * 32 + 4 * fq; const int bo = (u.pm >= 32 ? 9216 : 0); const float* gp = gate + bo + col0;
        f32x4 gv[2][2];
#pragma unroll
        for (int bj = 0; bj < 2; ++bj)
#pragma unroll
            for (int n = 0; n < 2; ++n) gv[bj][n] = *(const f32x4*)(gp + bj * HALF + n * 16) * coef;
#pragma unroll
        for (int ai = 0; ai < 2; ++ai)
#pragma unroll
            for (int m = 0; m < 4; ++m) { const size_t off = (size_t)(row0 + ai * HALF + m * 16) * 1024 + col0;
#pragma unroll
                for (int bj = 0; bj < 2; ++bj)
#pragma unroll
                    for (int n = 0; n < 2; ++n) { const f32x4 bs = *(const f32x4*)(base + off + bj * HALF + n * 16); acc[ai][bj][m][n] = bs + gv[bj][n] * acc[ai][bj][m][n]; *(f32x4*)(out + off + bj * HALF + n * 16) = acc[ai][bj][m][n]; }
                if (m & 1) asm volatile("" ::: "memory"); }
        if (donorm == 0) return;
        PG8_LAS float* P = (PG8_LAS float*)lds;
        PG8_LAS float* S = (PG8_LAS float*)(lds + 4096);
#pragma unroll
        for (int ai = 0; ai < 2; ++ai)
#pragma unroll
            for (int m = 0; m < 4; ++m) { float q = 0.f;
#pragma unroll
                for (int bj = 0; bj < 2; ++bj)
#pragma unroll
                    for (int n = 0; n < 2; ++n) { const f32x4 x = acc[ai][bj][m][n]; q += (x[0] * x[0] + x[1] * x[1]) + (x[2] * x[2] + x[3] * x[3]); }
                q += __shfl_xor(q, 16); q += __shfl_xor(q, 32);
                if (fq == 0) P[(ai * HALF + wr * 64 + m * 16 + fr) * 4 + wc] = q; }
        asm volatile("s_waitcnt lgkmcnt(0)" ::: "memory"); __builtin_amdgcn_s_barrier(); asm volatile("" ::: "memory");
        const int row = wid * 32 + (lane & 31); float* slot = xbuf + ((size_t)(u.pm * BM + row)) * 4;
        if (lane < 32) { const float t = (P[row * 4 + 0] + P[row * 4 + 1]) + (P[row * 4 + 2] + P[row * 4 + 3]); __hip_atomic_store((unsigned*)slot + u.pn, __float_as_uint(t), __ATOMIC_RELAXED, __HIP_MEMORY_SCOPE_AGENT); }
        asm volatile("s_waitcnt vmcnt(0)" ::: "memory");
        if (lane == 0) __hip_atomic_fetch_add(cnt + 64 * u.pm, 1u, __ATOMIC_RELAXED, __HIP_MEMORY_SCOPE_AGENT);
        if (wid == 0) { for (unsigned sp = 0; sp < (1u << 22); ++sp) { if ((unsigned)__builtin_amdgcn_readfirstlane(__hip_atomic_load(cnt + 64 * u.pm, __ATOMIC_RELAXED, __HIP_MEMORY_SCOPE_AGENT)) >= 32u) break; __builtin_amdgcn_s_sleep(2); }
            __builtin_amdgcn_fence(__ATOMIC_ACQUIRE, "agent"); }
        asm volatile("s_waitcnt vmcnt(0) lgkmcnt(0)" ::: "memory"); __builtin_amdgcn_s_barrier(); asm volatile("" ::: "memory");
        if (lane < 32) { float t = 0.f;
#pragma unroll
            for (int k = 0; k < 4; ++k) t += __uint_as_float(__hip_atomic_load((unsigned*)slot + k, __ATOMIC_RELAXED, __HIP_MEMORY_SCOPE_AGENT));
            S[row] = 1.0f / sqrtf(t * (1.0f / 1024.0f) + 1e-6f); }
        asm volatile("s_waitcnt lgkmcnt(0)" ::: "memory"); __builtin_amdgcn_s_barrier(); asm volatile("" ::: "memory");
        typedef unsigned u32x2v __attribute__((ext_vector_type(2)));
        const float* g2 = ngain + col0; const float* sh2 = nshift + bo + col0; const float* sc2 = nscale + bo + col0;
#pragma unroll
        for (int bj = 0; bj < 2; ++bj)
#pragma unroll
            for (int n = 0; n < 2; ++n) { const f32x4 g = *(const f32x4*)(g2 + bj * HALF + n * 16), sc = *(const f32x4*)(sc2 + bj * HALF + n * 16), sh = *(const f32x4*)(sh2 + bj * HALF + n * 16); const f32x4 gm = g * (1.0f + sc);
#pragma unroll
                for (int ai = 0; ai < 2; ++ai)
#pragma unroll
                    for (int m = 0; m < 4; ++m) { const int r = ai * HALF + wr * 64 + m * 16 + fr; const float rs = S[r]; const f32x4 v = (acc[ai][bj][m][n] * rs) * gm + sh;
                        u32x2v w; w.x = cvt_pk_bf16(v[0], v[1]); w.y = cvt_pk_bf16(v[2], v[3]);
                        *(u32x2v*)(xn + (size_t)(u.pm * BM + r) * 1024 + col0 + bj * HALF + n * 16) = w; } }
    }
};
struct EpiInproj {
    static constexpr bool PERM = true, AFTER_DRAIN = false;
    bf16_t* base; bf16_t* G; const PG8_LAS float* gain;
    __device__ __forceinline__ void operator()(const f32x4 (&acc)[2][2][4][2], const Unit& u, int wr, int wc, int fr, int fq) const {
        const int row0 = u.pm * BM + u.roff + wr * 64 + fr;
        if (u.pn >= 14) {
            const int col0 = (u.pn - 14) * 256 + 64 * wc + 8 * fq;
#pragma unroll
            for (int ai = 0; ai < 2; ++ai) if (ai < u.nai)
#pragma unroll
                for (int m = 0; m < 4; ++m) { unsigned char* rowp = (unsigned char*)G + (size_t)(row0 + ai * HALF + m * 16) * 3072 + col0;
#pragma unroll
                    for (int bj = 0; bj < 2; ++bj) { typedef unsigned u32x2q __attribute__((ext_vector_type(2))); u32x2q w; w.x = q4u8(sigm4(acc[ai][bj][m][0])); w.y = q4u8(sigm4(acc[ai][bj][m][1])); *(u32x2q*)(rowp + 32 * bj) = w; } }
        } else {
            const int t = u.pn >> 1; const int slot = (t == 0) ? 0 : (t == 4) ? 2 : (t < 4) ? t + 2 : t + 1; bf16_t* O = base + (size_t)slot * ((size_t)16384 * 512);     const int col0 = (u.pn & 1) * 256 + 64 * wc + 8 * fq;
            if (t == 0 || t == 1 || t == 4 || t == 5) {
                const int gi = (t == 0) ? 0 : (t == 1) ? 1 : (t == 4) ? 2 : 3; const float qs = (t == 0 || t == 4) ? EPI_C2 : 1.f;
                f32x4 gv[2][2];
#pragma unroll
                for (int bj = 0; bj < 2; ++bj)
#pragma unroll
                    for (int n = 0; n < 2; ++n) gv[bj][n] = *(const PG8_LAS f32x4*)(gain + gi * 64 + 32 * bj + 8 * fq + 4 * n) * qs;
#pragma unroll
                for (int ai = 0; ai < 2; ++ai) if (ai < u.nai)
#pragma unroll
                    for (int m = 0; m < 4; ++m) { bf16_t* rowp = O + (size_t)(row0 + ai * HALF + m * 16) * 512 + col0;
                        float ss = 0.f;
#pragma unroll
                        for (int bj = 0; bj < 2; ++bj)
#pragma unroll
                            for (int n = 0; n < 2; ++n) { const f32x4 x = acc[ai][bj][m][n]; ss += (x[0] * x[0] + x[1] * x[1]) + (x[2] * x[2] + x[3] * x[3]); }
                        ss += __shfl_xor(ss, 16); ss += __shfl_xor(ss, 32);
                        const float rstd = __builtin_amdgcn_rsqf(ss * (1.0f / 64.0f) + 1e-6f);
#pragma unroll
                        for (int bj = 0; bj < 2; ++bj) *(u32x4*)(rowp + 32 * bj) = pack8(acc[ai][bj][m][0] * rstd * gv[bj][0], acc[ai][bj][m][1] * rstd * gv[bj][1]); }
            } else {
#pragma unroll
                for (int ai = 0; ai < 2; ++ai) if (ai < u.nai)
#pragma unroll
                    for (int m = 0; m < 4; ++m) { bf16_t* rowp = O + (size_t)(row0 + ai * HALF + m * 16) * 512 + col0;
#pragma unroll
                        for (int bj = 0; bj < 2; ++bj) *(u32x4*)(rowp + 32 * bj) = pack8(acc[ai][bj][m][0], acc[ai][bj][m][1]); }
            }
        }
    }
};
struct EpiBranch {
    static constexpr bool PERM = true, AFTER_DRAIN = false;
    bf16_t* MG; const bf16_t* G;
    __device__ __forceinline__ void operator()(f32x4 (&acc)[2][2][4][2], const Unit& u, int wr, int wc, int fr, int fq) const {
        typedef unsigned u32x2q __attribute__((ext_vector_type(2)));
        const int n = u.pn >> 2, pc = u.pn & 3; const int row0 = u.pm * BM + wr * 64 + fr, col0 = pc * 256 + wc * 32 + 8 * fq;
        const int nn = (n < 2) ? n + 1 : n;
#pragma unroll
        for (int ai = 0; ai < 2; ++ai)
#pragma unroll
          for (int mp2 = 0; mp2 < 2; ++mp2) {
            u32x2q ga[2][2], gb[2][2];
#pragma unroll
            for (int q = 0; q < 2; ++q) { const int m = 2 * mp2 + q; const size_t row = (size_t)(row0 + ai * HALF + m * 16); const unsigned char* gp = (const unsigned char*)G + row * 3072 + col0;
#pragma unroll
                for (int bj = 0; bj < 2; ++bj) { ga[q][bj] = *(const u32x2q*)(gp + n * 1024 + bj * HALF); gb[q][bj] = *(const u32x2q*)(gp + nn * 1024 + bj * HALF); } }
            asm volatile("" : "+v"(ga[0][0]), "+v"(ga[0][1]), "+v"(ga[1][0]), "+v"(ga[1][1]), "+v"(gb[0][0]), "+v"(gb[0][1]), "+v"(gb[1][0]), "+v"(gb[1][1]));
#pragma unroll
            for (int q = 0; q < 2; ++q) { const int m = 2 * mp2 + q; const size_t row = (size_t)(row0 + ai * HALF + m * 16);
                if (n < 2) {
#pragma unroll
                    for (int bj = 0; bj < 2; ++bj) { const f32x4 d0 = dq4u8(gb[q][bj].x), d1 = dq4u8(gb[q][bj].y);
                        const f32x4 r0 = dq4u8(ga[q][bj].x) * (f32x4){__builtin_amdgcn_rcpf(d0[0]), __builtin_amdgcn_rcpf(d0[1]), __builtin_amdgcn_rcpf(d0[2]), __builtin_amdgcn_rcpf(d0[3])};
                        const f32x4 r1 = dq4u8(ga[q][bj].y) * (f32x4){__builtin_amdgcn_rcpf(d1[0]), __builtin_amdgcn_rcpf(d1[1]), __builtin_amdgcn_rcpf(d1[2]), __builtin_amdgcn_rcpf(d1[3])};
                        acc[ai][bj][m][0] *= r0; acc[ai][bj][m][1] *= r1; }
                } else { bf16_t* mp = MG + row * 1024 + col0;
#pragma unroll
                    for (int bj = 0; bj < 2; ++bj) *(u32x4*)(mp + bj * HALF) = pack8(dq4u8(ga[q][bj].x) * (acc[ai][bj][m][0] * (1.0f / 255.0f)), dq4u8(ga[q][bj].y) * (acc[ai][bj][m][1] * (1.0f / 255.0f))); } }
          }
    }
};
struct BranchOrder {
    static constexpr bool KEEP = true;
    StaticOrder S0;
    __device__ __forceinline__ bool next(int i, Unit& u) const { Unit t; if (!S0.next(i / 3, t)) return false; u.pm = t.pm; u.pn = 4 * (i % 3) + t.pn; u.roff = 0; u.nai = 2; return true; }
    __device__ __forceinline__ void a_ready(const Unit&) const {}
    __device__ __forceinline__ void done(const Unit&) const {}
};

template <class Epi, class Sched, bool ALIGN_EPI = false, bool SP2 = false>
__device__ __forceinline__ void gemm_phase(PG8_LAS unsigned char* lds, const Gemm g, const Sched& S, const Epi& E) {
    int tid_l = threadIdx.x; asm volatile("" : "+v"(tid_l));
    const int tid = tid_l, wid = __builtin_amdgcn_readfirstlane(tid >> 6), lane = tid & 63, wr = wid >> 2, wc = wid & 3, fr = lane & 15, fq = lane >> 4;
    const int K = g.K, nt = K / BK;
    unsigned voffA[2], voffB[2];
#pragma unroll
    for (int i = 0; i < 2; ++i) { int R, C; stage_rc(tid * 16 + i * 8192, R, C); const int Rb = Epi::PERM ? ((R & ~31) + perm32(R & 31)) : R;
        voffA[i] = (unsigned)(R * K + C) * 2u; voffB[i] = (unsigned)(Rb * K + C) * 2u; }
    const size_t kstep = (size_t)(BK * 2);
    const size_t hstep = (size_t)HALF * K * 2;
    const size_t tstep = 2 * hstep;
    const unsigned ldsw = (unsigned)wid * 1024u;
    const int aoff = lds_byte(wr * 64 + fr, fq * 8), boff = lds_byte(wc * 32 + fr, fq * 8);
#define PG8_SA(b, h) (((b) * 2 + (h)) * HTB)
#define PG8_SB(b, h) ((4 + (b) * 2 + (h)) * HTB)
#define PG8_STAGE(bufoff, gbase, voff) do { _Pragma("unroll") for (int _i = 0; _i < 2; ++_i) \
        __builtin_amdgcn_global_load_lds((const unsigned*)((const char*)(gbase) + (voff)[_i]), (PG8_LAS unsigned*)(lds + (bufoff) + ldsw + _i * 8192), 16, 0, 0); } while (0)
#define PG8_LDA(dst, b, h) do { _Pragma("unroll") for (int m = 0; m < 4; ++m) _Pragma("unroll") for (int k = 0; k < 2; ++k) dst[m][k] = *(const PG8_LAS bf16x8*)(lds + PG8_SA(b, h) + aoff + m * 2048 + k * 1024); } while (0)
#define PG8_LDB(dst, b, h) do { _Pragma("unroll") for (int n = 0; n < 2; ++n) _Pragma("unroll") for (int k = 0; k < 2; ++k) dst[n][k] = *(const PG8_LAS bf16x8*)(lds + PG8_SB(b, h) + boff + n * 2048 + k * 1024); } while (0)
#define PG8_MMA(ai, bj, At, Bt) do { __builtin_amdgcn_s_setprio(1); _Pragma("unroll") for (int m = 0; m < 4; ++m) _Pragma("unroll") for (int n = 0; n < 2; ++n) _Pragma("unroll") for (int k = 0; k < 2; ++k) \
        acc[ai][bj][m][n] = __builtin_amdgcn_mfma_f32_16x16x32_bf16(Bt[n][k], At[m][k], acc[ai][bj][m][n], 0, 0, 0); __builtin_amdgcn_s_setprio(0); } while (0)
#define PG8_WAIT_V(n) asm volatile("s_waitcnt vmcnt(" #n ")" ::: "memory")
#define PG8_WAIT_L(n) asm volatile("s_waitcnt lgkmcnt(" #n ")" ::: "memory")
#define PG8_BAR __builtin_amdgcn_s_barrier()
#define PG8_SCHED __builtin_amdgcn_sched_barrier(0)
    Unit cur, nxt; int ui = 0;
    if (!S.next(0, cur)) return;
    f32x4 acc[2][2][4][2];
#pragma unroll
    for (int a = 0; a < 2; ++a)
#pragma unroll
        for (int b = 0; b < 2; ++b)
#pragma unroll
            for (int m = 0; m < 4; ++m)
#pragma unroll
                for (int n = 0; n < 2; ++n) acc[a][b][m][n] = (f32x4){0.f, 0.f, 0.f, 0.f};
    bf16x8 At[4][2], B0[2][2], B1[2][2];
    const char* cA = (const char*)g.A + (size_t)(cur.pn / g.a_tiles) * g.a_stride + (size_t)cur.pm * tstep + (size_t)cur.roff * K * 2; const char* cB = (const char*)g.Bt + (size_t)cur.pn * tstep;
    S.a_ready(cur);
    if constexpr (SP2) {
        PG8_STAGE(PG8_SB(0, 0), cB, voffB); PG8_STAGE(PG8_SB(0, 1), cB + hstep, voffB); PG8_STAGE(PG8_SA(0, 0), cA, voffA); PG8_STAGE(PG8_SA(0, 1), cA + hstep, voffA);
        if (wr == 1) PG8_BAR;
        PG8_WAIT_V(2); PG8_BAR;
        PG8_STAGE(PG8_SB(1, 0), cB + kstep, voffB); PG8_STAGE(PG8_SA(1, 0), cA + kstep, voffA); PG8_STAGE(PG8_SB(1, 1), cB + hstep + kstep, voffB);
        PG8_WAIT_V(6); PG8_BAR;
    } else {
        PG8_STAGE(PG8_SB(0, 0), cB, voffB); PG8_STAGE(PG8_SA(0, 0), cA, voffA); PG8_STAGE(PG8_SB(0, 1), cB + hstep, voffB); PG8_STAGE(PG8_SA(0, 1), cA + hstep, voffA);
        if (wr == 1) PG8_BAR;
        PG8_WAIT_V(4); PG8_BAR;
        PG8_STAGE(PG8_SB(1, 0), cB + kstep, voffB); PG8_STAGE(PG8_SA(1, 0), cA + kstep, voffA); PG8_STAGE(PG8_SB(1, 1), cB + hstep + kstep, voffB);
        PG8_WAIT_V(6); PG8_BAR;
    }
    for (;;) {
        const bool has_next = S.next(ui + 1, nxt);
        const char* nA = has_next ? (const char*)g.A + (size_t)(nxt.pn / g.a_tiles) * g.a_stride + (size_t)nxt.pm * tstep + (size_t)nxt.roff * K * 2 : cA; const char* nB = has_next ? (const char*)g.Bt + (size_t)nxt.pn * tstep : cB;
        const bool full = (cur.nai == 2);
        for (int t = 0; t < nt; t += 2) {
            const bool last = (t == nt - 2);
            const char* a1 = cA + (size_t)(t + 1) * kstep;
            const char* a2 = last ? nA : cA + (size_t)(t + 2) * kstep; const char* b2 = last ? nB : cB + (size_t)(t + 2) * kstep;
            const char* a3 = a2 + kstep; const char* b3 = b2 + kstep;
            if (last && has_next) S.a_ready(nxt);
            if constexpr (SP2) {
            PG8_LDB(B0, 0, 0); PG8_LDB(B1, 0, 1); PG8_SCHED; PG8_LDA(At, 0, 0); PG8_STAGE(PG8_SA(1, 1), a1 + hstep, voffA);
            PG8_WAIT_V(8); PG8_WAIT_L(0); PG8_BAR; PG8_MMA(0, 0, At, B0); PG8_MMA(0, 1, At, B1); PG8_BAR; PG8_SCHED;
            if (full) PG8_LDA(At, 0, 1); PG8_STAGE(PG8_SB(0, 0), b2, voffB); PG8_STAGE(PG8_SB(0, 1), b2 + hstep, voffB); PG8_STAGE(PG8_SA(0, 0), a2, voffA);
            PG8_WAIT_V(8); PG8_WAIT_L(0); PG8_BAR; if (full) { PG8_MMA(1, 0, At, B0); PG8_MMA(1, 1, At, B1); } PG8_BAR; PG8_SCHED;
            PG8_LDB(B0, 1, 0); PG8_LDB(B1, 1, 1); PG8_SCHED; PG8_LDA(At, 1, 0); PG8_STAGE(PG8_SA(0, 1), a2 + hstep, voffA);
            PG8_WAIT_V(8); PG8_WAIT_L(0); PG8_BAR; PG8_MMA(0, 0, At, B0); PG8_MMA(0, 1, At, B1); PG8_BAR; PG8_SCHED;
            if (full) PG8_LDA(At, 1, 1); PG8_STAGE(PG8_SB(1, 0), b3, voffB); PG8_STAGE(PG8_SB(1, 1), b3 + hstep, voffB); PG8_STAGE(PG8_SA(1, 0), a3, voffA);
            PG8_WAIT_V(8); PG8_WAIT_L(0); PG8_BAR; if (full) { PG8_MMA(1, 0, At, B0); PG8_MMA(1, 1, At, B1); } PG8_BAR; PG8_SCHED;
            } else {
            PG8_LDB(B0, 0, 0); PG8_SCHED; PG8_LDA(At, 0, 0); PG8_STAGE(PG8_SA(1, 1), a1 + hstep, voffA);
            PG8_WAIT_L(8); PG8_BAR; PG8_WAIT_L(0); PG8_MMA(0, 0, At, B0); PG8_BAR; PG8_SCHED;
            PG8_LDB(B1, 0, 1); PG8_STAGE(PG8_SB(0, 0), b2, voffB);
            PG8_BAR; PG8_WAIT_L(0); PG8_MMA(0, 1, At, B1); PG8_BAR;
            PG8_LDA(At, 0, 1); PG8_STAGE(PG8_SA(0, 0), a2, voffA);
            PG8_BAR; PG8_WAIT_L(0); PG8_MMA(1, 0, At, B0); PG8_BAR; PG8_SCHED;
            PG8_STAGE(PG8_SB(0, 1), b2 + hstep, voffB);
            PG8_WAIT_V(6); PG8_BAR; PG8_MMA(1, 1, At, B1); PG8_BAR;
            PG8_LDB(B0, 1, 0); PG8_SCHED; PG8_LDA(At, 1, 0); PG8_STAGE(PG8_SA(0, 1), a2 + hstep, voffA);
            PG8_WAIT_L(8); PG8_BAR; PG8_WAIT_L(0); PG8_MMA(0, 0, At, B0); PG8_BAR; PG8_SCHED;
            PG8_LDB(B1, 1, 1); PG8_STAGE(PG8_SB(1, 0), b3, voffB);
            PG8_BAR; PG8_WAIT_L(0); PG8_MMA(0, 1, At, B1); PG8_BAR;
            PG8_LDA(At, 1, 1); PG8_STAGE(PG8_SA(1, 0), a3, voffA);
            PG8_BAR; PG8_WAIT_L(0); PG8_MMA(1, 0, At, B0); PG8_BAR; PG8_SCHED;
            PG8_STAGE(PG8_SB(1, 1), b3 + hstep, voffB);
            PG8_WAIT_V(6); PG8_BAR; PG8_MMA(1, 1, At, B1); PG8_BAR;
            }
        }
        if constexpr (ALIGN_EPI) { if (wr == 0) PG8_BAR; }
        if constexpr (!Epi::AFTER_DRAIN) { E(acc, cur, wr, wc, fr, fq); S.done(cur); }
        if (!has_next) break;
        if (!Sched::KEEP || (nxt.pn >> 2) == 0) {
#pragma unroll
        for (int a = 0; a < 2; ++a)
#pragma unroll
            for (int b = 0; b < 2; ++b)
#pragma unroll
                for (int m = 0; m < 4; ++m)
#pragma unroll
                    for (int n = 0; n < 2; ++n) acc[a][b][m][n] = (f32x4){0.f, 0.f, 0.f, 0.f};
        }
        cur = nxt; cA = nA; cB = nB; ++ui;
        if constexpr (ALIGN_EPI) { if (wr == 1) PG8_BAR; }
    }
    PG8_WAIT_V(0);
    if constexpr (!ALIGN_EPI) { if (wr == 0) PG8_BAR; }
    PG8_BAR;
    if constexpr (Epi::AFTER_DRAIN) { E.fused(acc, cur, wr, wc, fr, fq, lds, wid, lane); S.done(cur); }
#undef PG8_SA
#undef PG8_SB
#undef PG8_STAGE
#undef PG8_LDA
#undef PG8_LDB
#undef PG8_MMA
#undef PG8_WAIT_V
#undef PG8_WAIT_L
#undef PG8_BAR
#undef PG8_SCHED
}
}

#include <hip/hip_bf16.h>
#include <cmath>
namespace attn_body {
using bf16=__hip_bfloat16;
using bf16x8=__attribute__((ext_vector_type(8)))short;
using s16x4=__attribute__((ext_vector_type(4)))short;
using f32x16=__attribute__((ext_vector_type(16)))float;
using u32x4=__attribute__((ext_vector_type(4)))unsigned;
constexpr int BATCH=2,NHEAD=8,SEQ=8192,D=64,DM=NHEAD*D;
constexpr int NW=8,QBLK=32,QB=QBLK*NW,KVBLK=64,NQB=SEQ/QB;
constexpr int ATTN_PITCH=DM, ATTN_UNIT_ROWS=QB;
__device__ __forceinline__ int crow(int r,int hi){return (r&3)+8*(r>>2)+4*hi;}
#define SBAR() __builtin_amdgcn_sched_barrier(0)
__device__ __forceinline__ void cmask(f32x16&p0,f32x16&p1,int jb,int qrel,int hi){
  const float NEG=-INFINITY; int kb=64*jb+4*hi;
  #pragma unroll
  for(int r=0;r<16;++r){int kv=kb+(r&3)+8*(r>>2); if(kv>qrel)p0[r]=NEG; if(kv+32>qrel)p1[r]=NEG;}
}

constexpr int NSLOT=3, SLOTB=8192;
constexpr int LDS_K=0, LDS_V=NSLOT*SLOTB, LDS_WS=2*NSLOT*SLOTB, LDS_OST=LDS_WS+NW*64*4, LDS_BYTES=LDS_OST+NW*4096;
constexpr float C2=0.125f*1.4426950408889634f; constexpr float LOG2E=1.4426950408889634f; constexpr int TAB_OFF=86016, LDS_BYTES_ALL=TAB_OFF+32768+512; constexpr float NEGBIG=-30000.f;

typedef __attribute__((address_space(3))) float* lds_fptr;
typedef float f32x4a __attribute__((ext_vector_type(4)));
template<int MODE> __device__ __forceinline__ void hook(f32x16&p0,f32x16&p1,int t,int NT,int qrel,int hi,lds_fptr tab,int dbase,int ibase){
  if(MODE==0){
    const lds_fptr tb=tab+64*t+4*hi;
    #pragma unroll
    for(int g=0;g<4;++g){ const f32x4a a=*(const __attribute__((address_space(3))) f32x4a*)(tb+8*g); const f32x4a c=*(const __attribute__((address_space(3))) f32x4a*)(tb+32+8*g);
      p0[4*g+0]+=a.x;p0[4*g+1]+=a.y;p0[4*g+2]+=a.z;p0[4*g+3]+=a.w; p1[4*g+0]+=c.x;p1[4*g+1]+=c.y;p1[4*g+2]+=c.z;p1[4*g+3]+=c.w; }
    const int jb=t-(NT-4); if(jb>=0)cmask(p0,p1,jb,qrel,hi);
  } else {
    const int delta=dbase-t;
    if(delta<0||delta>8){
      #pragma unroll
      for(int r=0;r<16;++r){p0[r]=NEGBIG;p1[r]=NEGBIG;}
    } else if(delta>=3){ const float cf=tab[256];
      #pragma unroll
      for(int r=0;r<16;++r){p0[r]+=cf;p1[r]+=cf;}
    } else { const int ib=64*delta+ibase-4*hi;
      #pragma unroll
      for(int r=0;r<16;++r){ const int kc=(r&3)+8*(r>>2); int i0=ib-kc, i1=ib-32-kc; i0=i0>256?256:i0; i1=i1>256?256:i1; p0[r]+=tab[i0]; p1[r]+=tab[i1]; }
    }
  }
}
__device__ __forceinline__ void glds16(const void*gsrc,unsigned lds_dst){unsigned keep;
  asm volatile("s_mov_b32 %0, m0\n\ts_mov_b32 m0, %2\n\ts_nop 0\n\tglobal_load_lds_dwordx4 %1, off\n\ts_mov_b32 m0, %0":"=&s"(keep):"v"(gsrc),"s"(lds_dst):"memory");}
__device__ __forceinline__ float max3f(float a,float b,float c){float r;asm("v_max3_f32 %0, %1, %2, %3":"=v"(r):"v"(a),"v"(b),"v"(c));return r;}
__device__ __forceinline__ float max2f(float a,float b){float r;asm("v_max_f32_e32 %0, %1, %2":"=v"(r):"v"(a),"v"(b));return r;}
__device__ __forceinline__ float fadd_s(float a,float b){float r;asm("v_add_f32_e32 %0, %1, %2":"=v"(r):"v"(a),"v"(b));return r;}
__device__ __forceinline__ float fsub_s(float a,float b){float r;asm("v_sub_f32_e32 %0, %1, %2":"=v"(r):"v"(a),"v"(b));return r;}
typedef float f32x2_t __attribute__((ext_vector_type(2))); typedef __bf16 bf16x2_t __attribute__((ext_vector_type(2)));
__device__ __forceinline__ unsigned cvtpk_s(float lo,float hi){f32x2_t v={lo,hi};bf16x2_t b=__builtin_convertvector(v,bf16x2_t);return __builtin_bit_cast(unsigned,b);}
#define WAIT_BAR(N) asm volatile("s_waitcnt vmcnt(" #N ") lgkmcnt(0)\n\ts_barrier":::"memory")

__device__ __forceinline__ void qkt(f32x16&p0,f32x16&p1,const char*Kslot,const bf16x8*qr,const f32x16&negm,int r32,int hi){
  const char*kb=Kslot+hi*1024+r32*16;
  #pragma unroll
  for(int d0=0;d0<4;++d0){
    const bf16x8 b0=*reinterpret_cast<const bf16x8*>(kb+d0*2048);
    const bf16x8 b1=*reinterpret_cast<const bf16x8*>(kb+d0*2048+512);
    if(d0==0){p0=__builtin_amdgcn_mfma_f32_32x32x16_bf16(b0,qr[0],negm,0,0,0);p1=__builtin_amdgcn_mfma_f32_32x32x16_bf16(b1,qr[0],negm,0,0,0);}
    else{p0=__builtin_amdgcn_mfma_f32_32x32x16_bf16(b0,qr[d0],p0,0,0,0);p1=__builtin_amdgcn_mfma_f32_32x32x16_bf16(b1,qr[d0],p1,0,0,0);}}
}
typedef __attribute__((address_space(3))) const char* lds_cptr;
typedef short v4i16_t __attribute__((ext_vector_type(4)));
__device__ __forceinline__ void kload8(bf16x8*kf,lds_cptr kp){
  kf[0]=*(const __attribute__((address_space(3))) bf16x8*)(kp);      kf[1]=*(const __attribute__((address_space(3))) bf16x8*)(kp+512);
  kf[2]=*(const __attribute__((address_space(3))) bf16x8*)(kp+2048); kf[3]=*(const __attribute__((address_space(3))) bf16x8*)(kp+2560);
  kf[4]=*(const __attribute__((address_space(3))) bf16x8*)(kp+4096); kf[5]=*(const __attribute__((address_space(3))) bf16x8*)(kp+4608);
  kf[6]=*(const __attribute__((address_space(3))) bf16x8*)(kp+6144); kf[7]=*(const __attribute__((address_space(3))) bf16x8*)(kp+6656);
}
__device__ __forceinline__ void kload2(bf16x8*kf,lds_cptr kp,int j){ kf[2*j]=*(const __attribute__((address_space(3))) bf16x8*)(kp+j*2048); kf[2*j+1]=*(const __attribute__((address_space(3))) bf16x8*)(kp+j*2048+512); }
__device__ __forceinline__ s16x4 vtr(lds_cptr p){ return __builtin_bit_cast(s16x4,__builtin_amdgcn_ds_read_tr16_b64_v4i16((__attribute__((address_space(3))) v4i16_t*)p)); }
__device__ __forceinline__ float rowmax(const f32x16&p0,const f32x16&p1){
  float a=max3f(p0[0],p0[1],p1[0]),b=max3f(p0[2],p0[3],p1[1]);a=max3f(a,p1[2],p1[3]);
  #pragma unroll
  for(int r=4;r<16;r+=4){a=max3f(a,p0[r],p0[r+1]);b=max3f(b,p0[r+2],p0[r+3]);a=max3f(a,p1[r],p1[r+1]);b=max3f(b,p1[r+2],p1[r+3]);}
  const float m=max2f(a,b);
  auto rr=__builtin_amdgcn_permlane32_swap(__float_as_uint(m),__float_as_uint(m),false,false);
  return max2f(__uint_as_float(rr[0]),__uint_as_float(rr[1]));
}
__device__ __forceinline__ void pv(f32x16*o,int vb,bf16x8 pa0,bf16x8 pa1,bf16x8 pa2,bf16x8 pa3){
  #pragma unroll
  for(int d0=0;d0<2;++d0){s16x4 lo[4],hi[4];
    #pragma unroll
    for(int ks=0;ks<4;++ks){
      asm volatile("ds_read_b64_tr_b16 %0,%1 offset:%c2":"=&v"(lo[ks]):"v"(vb),"i"(d0*4096+ks*1024):"memory");
      asm volatile("ds_read_b64_tr_b16 %0,%1 offset:%c2":"=&v"(hi[ks]):"v"(vb),"i"(d0*4096+ks*1024+512):"memory");}
    asm volatile("s_waitcnt lgkmcnt(0)":::"memory");SBAR();
    #define PK(k) (bf16x8){lo[k][0],lo[k][1],lo[k][2],lo[k][3],hi[k][0],hi[k][1],hi[k][2],hi[k][3]}
    o[d0]=__builtin_amdgcn_mfma_f32_32x32x16_bf16(pa0,PK(0),o[d0],0,0,0);
    o[d0]=__builtin_amdgcn_mfma_f32_32x32x16_bf16(pa1,PK(1),o[d0],0,0,0);
    o[d0]=__builtin_amdgcn_mfma_f32_32x32x16_bf16(pa2,PK(2),o[d0],0,0,0);
    o[d0]=__builtin_amdgcn_mfma_f32_32x32x16_bf16(pa3,PK(3),o[d0],0,0,0);
    #undef PK
  }
}

#ifndef ATTN_STORE16
#define ATTN_STORE16(p,v) (*(u32x4*)(p)=(v))
#endif
template<int MODE,int THRL> __device__ __forceinline__ void attn_unit(int b,int h,int qb,const bf16*Q,const bf16*__restrict__ K,const bf16*__restrict__ V,bf16*O,char*shm,const float*aux0,const float*aux1,const float*aux2){
  int tid_l=threadIdx.x; asm volatile("":"+v"(tid_l)); const int tid=tid_l,lane=tid&63,r32=lane&31,hi=lane>>5; const int wid=__builtin_amdgcn_readfirstlane(tid>>6);
  const long rowbase=(long)b*SEQ; const int q0=qb*QB;
  const bf16*Qw=Q+(rowbase+q0+wid*QBLK)*DM+h*D;
  int T0;
  if(MODE==1){ T0=(4*qb-8)>0?(4*qb-8):0; }
  else {
    const lds_fptr bp0=(lds_fptr)((lds_cptr)shm+TAB_OFF)+8192;
    if(wid==0){ const float a=aux1[(b*128+lane)*32+h], c=aux1[(b*128+64+lane)*32+h]; float sa=a, sc=c;
      #pragma unroll
      for(int o=1;o<64;o<<=1){ const float ta=__shfl_up(sa,o), tc=__shfl_up(sc,o); if(lane>=o){sa+=ta;sc+=tc;} }
      const float tot=__shfl(sa,63); bp0[lane]=sa-a; bp0[64+lane]=tot+sc-c; }
    asm volatile("s_waitcnt vmcnt(0) lgkmcnt(0)\n\ts_barrier":::"memory");
    const float*cum0=aux0+(long)(b*NHEAD+h)*SEQ; const int ntp=q0/KVBLK;
    float gq=fabsf(aux2[128+lane]), gk=fabsf(aux2[192+lane]);
    #pragma unroll
    for(int o=1;o<64;o<<=1){ gq=fmaxf(gq,__shfl_xor(gq,o)); gk=fmaxf(gk,__shfl_xor(gk,o)); }
    const float thr=-(cum0[q0]+bp0[q0>>6])*LOG2E-(2.02f*8.f*LOG2E*gq*gk+38.f);
    bool c0=false,c1=false;
    if(lane<ntp) c0=(-(cum0[64*lane+63]+bp0[lane])*LOG2E<thr);
    if(lane+64<ntp) c1=(-(cum0[64*(lane+64)+63]+bp0[lane+64])*LOG2E<thr);
    const int cnt=__popcll(__ballot(c0))+__popcll(__ballot(c1));
    T0=__builtin_amdgcn_readfirstlane(cnt&~1);
  }
  const bf16*Kh=K+(rowbase+(long)T0*KVBLK)*DM+h*D,*Vh=V+(rowbase+(long)T0*KVBLK)*DM+h*D;
  const unsigned lds0=(unsigned)(uintptr_t)shm;
  float*wsf=(float*)(shm+LDS_WS)+wid*64;
  const bf16*ksrc=Kh+(long)lane*DM+wid*8;
  const bf16*vsrc=Vh+(long)(16*(wid&3)+(lane>>2))*DM+(wid>>2)*32+(lane&3)*8;
  const unsigned kdst=lds0+LDS_K+wid*1024, vdst=lds0+LDS_V+wid*1024;
  #define DMA_K(t,slot) glds16(ksrc+(long)(t)*KVBLK*DM,(unsigned)__builtin_amdgcn_readfirstlane(kdst+(slot)))
  #define DMA_V(t,slot) glds16(vsrc+(long)(t)*KVBLK*DM,(unsigned)__builtin_amdgcn_readfirstlane(vdst+(slot)))
  const int vb0=(int)(lds0+LDS_V)+((lane>>4)&1)*32+(lane&3)*8+(4*hi+((lane&15)>>2))*64;
  const char*Kbase=shm+LDS_K; bf16x8 kf[8];
  const lds_cptr shm3=(lds_cptr)shm; const lds_cptr kp0=shm3+LDS_K+hi*1024+r32*16; const lds_cptr vp0=shm3+LDS_V+((lane>>4)&1)*32+(lane&3)*8+(4*hi+((lane&15)>>2))*64;
  const int NT=(q0+QB)/KVBLK-T0;
  const lds_fptr tab=(lds_fptr)(shm3+TAB_OFF);
  const int dbase=4*qb+(wid>>1)-T0, ibase=32*(wid&1)+r32+128; const lds_fptr tabh=(MODE==0)?tab+64*T0:tab;
  if(MODE==0){
    const lds_fptr bp=tab+8192;
    const int nkeys=q0+QB; const float*cum=aux0+(long)(b*NHEAD+h)*SEQ;
    for(int j0=64*T0+tid;j0<nkeys;j0+=2048){ float cv[4];
      #pragma unroll
      for(int u4=0;u4<4;++u4){const int jj=j0+512*u4; cv[u4]=(jj<nkeys)?cum[jj]:0.f;}
      #pragma unroll
      for(int u4=0;u4<4;++u4){const int jj=j0+512*u4; if(jj<nkeys) tab[jj]=-(cv[u4]+bp[jj>>6])*LOG2E;} }
  } else {
    if(tid<257) tab[tid]=aux0[tid]*LOG2E;
  }
  DMA_K(0,0);DMA_V(0,0);DMA_K(1,SLOTB);
  bf16x8 qr[4];
  #pragma unroll
  for(int d0=0;d0<4;++d0)qr[d0]=*reinterpret_cast<const bf16x8*>(&Qw[(long)r32*DM+d0*16+hi*8]);
  float mhat=0.f,l_reg=0.f;f32x16 o[2];o[0]=f32x16{};o[1]=f32x16{};f32x16 negm=f32x16{};asm volatile("":"+v"(negm));
  const int qrel=wid*QBLK+r32;
  #define CMASK(P0,P1,t) hook<MODE>(P0,P1,(t),NT,qrel,hi,tabh,dbase,ibase)
  bool resc=false;
  #define START(P0,P1) do{ const float rm=rowmax(P0,P1); resc=false; \
    { const float dl=rm; mhat=fadd_s(mhat,dl); \
      _Pragma("unroll") for(int r=0;r<16;++r){P0[r]=fsub_s(P0[r],dl);P1[r]=fsub_s(P1[r],dl);} \
      _Pragma("unroll") for(int r=0;r<16;++r)negm[r]=-mhat; asm volatile("":"+v"(negm)); } \
    _Pragma("unroll") for(int r=0;r<16;++r)P0[r]=__builtin_amdgcn_exp2f(P0[r]); }while(0)
  #define RESC() do{ if(resc){ asm volatile("s_waitcnt lgkmcnt(0)":::"memory"); \
      _Pragma("unroll") for(int d_=0;d_<2;++d_) _Pragma("unroll") for(int r=0;r<16;++r)o[d_][r]*=wsf[crow(r,hi)]; } }while(0)
  f32x16 pA0,pA1,pB0,pB1;
  int sl_prev=0,sl_cur=0,sl_next=SLOTB;
  #define ROT() do{sl_prev=sl_cur;sl_cur=sl_next;sl_next=(sl_next==(NSLOT-1)*SLOTB)?0:sl_next+SLOTB;}while(0)
  DMA_K(2,2*SLOTB);
  WAIT_BAR(3);
  qkt(pA0,pA1,Kbase,qr,negm,r32,hi);asm volatile("s_nop 15\n\ts_nop 7":"+v"(pA0),"+v"(pA1));CMASK(pA0,pA1,0);
  START(pA0,pA1);
  _Pragma("unroll") for(int r=0;r<16;++r)pA1[r]=__builtin_amdgcn_exp2f(pA1[r]);
  WAIT_BAR(0);
  DMA_K(3,0);DMA_V(1,SLOTB);
  ROT();
  kload8(kf,kp0+sl_cur);
  WAIT_BAR(2);
  s16x4 vlo[8],vhi[8]; u32x4 pw0,pw1,pw2,pw3;
  #define PKW(P,B) cvtpk_s(P[B],P[B+1])
  #define PAF(k) __builtin_bit_cast(bf16x8,pw##k)
  #define VFR(i) (bf16x8){vlo[i][0],vlo[i][1],vlo[i][2],vlo[i][3],vhi[i][0],vhi[i][1],vhi[i][2],vhi[i][3]}
  #define PIN(x) asm volatile("":"+v"(x))
  #define MX3(a,b,c) __builtin_fmaxf(__builtin_fmaxf((a),(b)),(c))
  #define GAPA(MF,A0,A1,A2,A3,W0,W1,PW) do{ MF; sacc+=A0; sacc+=A1; sacc+=A2; sacc+=A3; PIN(sacc); W0; W1; PIN(PW); SBAR(); }while(0)
  #define EX(v) __builtin_amdgcn_exp2f(v)
  #define GAPB(MF,X,B) do{ MF; X[B]=EX(X[B]); X[B+1]=EX(X[B+1]); X[B+2]=EX(X[B+2]); X[B+3]=EX(X[B+3]); PIN(X); SBAR(); }while(0)
  #define VRD(i) do{ vlo[i]=vtr(vp_+(((i)>>2)*4096+((i)&3)*1024)); vhi[i]=vtr(vp_+(((i)>>2)*4096+((i)&3)*1024+512)); }while(0)
  #define KRD(G,j) do{ if(G){ kload2(kf,kp0+sl_next,j); SBAR(); } }while(0)
  #define STEP(C0,C1,P0,P1,t,GK,GV,GL) do{ SBAR(); \
    const lds_cptr vp_=vp0+sl_prev; \
    VRD(0); SBAR(); float sacc=(P0[0]+P0[1]); \
    GAPA(C0=__builtin_amdgcn_mfma_f32_32x32x16_bf16(kf[0],qr[0],negm,0,0,0), P0[2],P0[3],P0[4],P0[5],     pw0[0]=PKW(P0,0), pw0[1]=PKW(P0,2), pw0); \
    VRD(4); SBAR(); GAPA(C1=__builtin_amdgcn_mfma_f32_32x32x16_bf16(kf[1],qr[0],negm,0,0,0), P0[6],P0[7],P0[8],P0[9],     pw0[2]=PKW(P0,4), pw0[3]=PKW(P0,6), pw0); \
    VRD(1); SBAR(); GAPA(C0=__builtin_amdgcn_mfma_f32_32x32x16_bf16(kf[2],qr[1],C0,0,0,0),   P0[10],P0[11],P0[12],P0[13], pw1[0]=PKW(P0,8), pw1[1]=PKW(P0,10), pw1); \
    VRD(5); SBAR(); GAPA(C1=__builtin_amdgcn_mfma_f32_32x32x16_bf16(kf[3],qr[1],C1,0,0,0),   P0[14],P0[15],P1[0],P1[1],   pw1[2]=PKW(P0,12),pw1[3]=PKW(P0,14), pw1); \
    VRD(2); SBAR(); GAPA(C0=__builtin_amdgcn_mfma_f32_32x32x16_bf16(kf[4],qr[2],C0,0,0,0),   P1[2],P1[3],P1[4],P1[5],     pw2[0]=PKW(P1,0), pw2[1]=PKW(P1,2), pw2); \
    VRD(6); SBAR(); GAPA(C1=__builtin_amdgcn_mfma_f32_32x32x16_bf16(kf[5],qr[2],C1,0,0,0),   P1[6],P1[7],P1[8],P1[9],     pw2[2]=PKW(P1,4), pw2[3]=PKW(P1,6), pw2); \
    VRD(3); SBAR(); GAPA(C0=__builtin_amdgcn_mfma_f32_32x32x16_bf16(kf[6],qr[3],C0,0,0,0),   P1[10],P1[11],P1[12],P1[13], pw3[0]=PKW(P1,8), pw3[1]=PKW(P1,10), pw3); \
    VRD(7); SBAR(); GAPA(C1=__builtin_amdgcn_mfma_f32_32x32x16_bf16(kf[7],qr[3],C1,0,0,0),   P1[14],P1[15],0.f,0.f,       pw3[2]=PKW(P1,12),pw3[3]=PKW(P1,14), pw3); \
    l_reg+=sacc; \
    if(GK){DMA_K((t)+3,sl_cur);} if(GV){DMA_V((t)+1,sl_next);} \
    CMASK(C0,C1,t); \
    { float a=MX3(C0[0],C0[1],C1[0]),b=MX3(C0[2],C0[3],C1[1]); a=MX3(a,C1[2],C1[3]); \
      _Pragma("unroll") for(int r=4;r<16;r+=4){a=MX3(a,C0[r],C0[r+1]);b=MX3(b,C0[r+2],C0[r+3]);a=MX3(a,C1[r],C1[r+1]);b=MX3(b,C1[r+2],C1[r+3]);} \
      float rm=__builtin_fmaxf(a,b); { auto rr=__builtin_amdgcn_permlane32_swap(__float_as_uint(rm),__float_as_uint(rm),false,false); rm=__builtin_fmaxf(__uint_as_float(rr[0]),__uint_as_float(rr[1])); } \
      resc=false; \
      if(__builtin_expect(__any(rm>(float)THRL),0)){ const float dl=__builtin_fmaxf(rm,0.f); mhat+=dl; \
        _Pragma("unroll") for(int r=0;r<16;++r){C0[r]-=dl;C1[r]-=dl;} \
        _Pragma("unroll") for(int r=0;r<16;++r)negm[r]=-mhat; asm volatile("":"+v"(negm)); \
        const float f=__builtin_amdgcn_exp2f(-dl); l_reg*=f; if(hi==0)wsf[r32]=f; resc=true; } } \
    SBAR(); \
    GAPB(o[0]=__builtin_amdgcn_mfma_f32_32x32x16_bf16(PAF(0),VFR(0),o[0],0,0,0), C0,0); \
    GAPB(o[1]=__builtin_amdgcn_mfma_f32_32x32x16_bf16(PAF(0),VFR(4),o[1],0,0,0), C0,4); \
    KRD(GL,0); GAPB(o[0]=__builtin_amdgcn_mfma_f32_32x32x16_bf16(PAF(1),VFR(1),o[0],0,0,0), C0,8); \
    KRD(GL,1); GAPB(o[1]=__builtin_amdgcn_mfma_f32_32x32x16_bf16(PAF(1),VFR(5),o[1],0,0,0), C0,12); \
    KRD(GL,2); GAPB(o[0]=__builtin_amdgcn_mfma_f32_32x32x16_bf16(PAF(2),VFR(2),o[0],0,0,0), C1,0); \
    KRD(GL,3); GAPB(o[1]=__builtin_amdgcn_mfma_f32_32x32x16_bf16(PAF(2),VFR(6),o[1],0,0,0), C1,4); \
    GAPB(o[0]=__builtin_amdgcn_mfma_f32_32x32x16_bf16(PAF(3),VFR(3),o[0],0,0,0), C1,8); \
    GAPB(o[1]=__builtin_amdgcn_mfma_f32_32x32x16_bf16(PAF(3),VFR(7),o[1],0,0,0), C1,12); \
    }while(0)
  int t=1;
  for(;t+5<NT;t+=2){
    STEP(pB0,pB1,pA0,pA1,t,true,true,true);     WAIT_BAR(2); RESC(); ROT();
    STEP(pA0,pA1,pB0,pB1,t+1,true,true,true);   WAIT_BAR(2); RESC(); ROT();
  }
  #define ENDW(tt) do{ if((tt)+3<NT){WAIT_BAR(2);} else if((tt)+2<NT){WAIT_BAR(1);} else {WAIT_BAR(0);} }while(0)
  for(;t+1<NT;t+=2){
    STEP(pB0,pB1,pA0,pA1,t,(t+3<NT),(t+1<NT),(t+1<NT));       ENDW(t);   RESC(); ROT();
    STEP(pA0,pA1,pB0,pB1,t+1,(t+4<NT),(t+2<NT),(t+2<NT));     ENDW(t+1); RESC(); ROT();
  }
  STEP(pB0,pB1,pA0,pA1,NT-1,false,false,false); RESC();
  { float sacc=pB0[0]+pB0[1]; _Pragma("unroll") for(int r=2;r<16;++r)sacc+=pB0[r]; _Pragma("unroll") for(int r=0;r<16;++r)sacc+=pB1[r]; l_reg+=sacc;
    pw0=(u32x4){PKW(pB0,0),PKW(pB0,2),PKW(pB0,4),PKW(pB0,6)};pw1=(u32x4){PKW(pB0,8),PKW(pB0,10),PKW(pB0,12),PKW(pB0,14)};pw2=(u32x4){PKW(pB1,0),PKW(pB1,2),PKW(pB1,4),PKW(pB1,6)};pw3=(u32x4){PKW(pB1,8),PKW(pB1,10),PKW(pB1,12),PKW(pB1,14)};
    SBAR(); pv(o,vb0+sl_cur,PAF(0),PAF(1),PAF(2),PAF(3)); }
  #undef PKW
  #undef PAF
  #undef VFR
  #undef PIN
  #undef MX3
  #undef GAPA
  #undef GAPB
  #undef EX
  #undef VRD
  #undef KRD
  #undef STEP
  #undef ENDW
  {auto rr=__builtin_amdgcn_permlane32_swap(__float_as_uint(l_reg),__float_as_uint(l_reg),false,false);l_reg=__uint_as_float(rr[0])+__uint_as_float(rr[1]);}
  if(hi==0)wsf[32+r32]=l_reg;asm volatile("s_waitcnt lgkmcnt(0)":::"memory");
  float rli[16];
  #pragma unroll
  for(int r=0;r<16;++r)rli[r]=__builtin_amdgcn_rcpf(wsf[32+crow(r,hi)]);
  bf16*Ow=O+(rowbase+q0+wid*QBLK)*DM+h*D;
  { bf16*stg=(bf16*)(shm+LDS_OST)+wid*2048;
    #pragma unroll
    for(int r=0;r<16;++r){const int orow=crow(r,hi);
      #pragma unroll
      for(int d0=0;d0<2;++d0)stg[orow*64+d0*32+r32]=__float2bfloat16(o[d0][r]*rli[r]);}
    asm volatile("s_waitcnt lgkmcnt(0)":::"memory");
    #pragma unroll
    for(int i=0;i<4;++i){const int row=i*8+(lane>>3),ch=lane&7; const u32x4 v=*(const u32x4*)(stg+row*64+ch*8); ATTN_STORE16(Ow+(long)row*DM+ch*8,v);} }
  asm volatile("s_waitcnt lgkmcnt(0)\n\ts_barrier":::"memory");
  #undef DMA_K
  #undef DMA_V
  #undef CMASK
  #undef START
  #undef RESC
  #undef ROT
}
constexpr int ATTN_LDS_BYTES=LDS_BYTES_ALL;
#undef SBAR
#undef WAIT_BAR
}

constexpr int NWAVES = 8;
constexpr int M = 16384, D = 1024, FF = 2816, NGU = 5632, NIN = 6656, DIN = 6664, SEQ = 8192;
constexpr size_t MiB = 1u << 20;
constexpr size_t WS_MOD = 0;
constexpr size_t WS_WF = 256 * 1024;
constexpr size_t WS_BT = 320 * 1024;
constexpr size_t WS_CTL = 1536 * 1024, CTL_ZERO_BYTES = 131072;
constexpr size_t WS_XBUF = WS_CTL + 131072;
constexpr size_t WS_CUM = 1 * MiB;
constexpr size_t WS_WGU = 2 * MiB;
constexpr size_t WS_WD = WS_WGU + 22 * MiB;
constexpr size_t WS_WIN = WS_WD + 11 * MiB;
constexpr size_t WS_WBR = WS_WIN + 13 * MiB;
constexpr size_t WS_WO = WS_WBR + 3 * MiB;
constexpr size_t WS_XN = 54 * MiB;
constexpr size_t WS_BIG = 86 * MiB;
constexpr size_t SLOT = 16 * MiB;
constexpr size_t WS_G = WS_BIG + 8 * SLOT;
constexpr size_t WS_MG = WS_BIG + 3 * SLOT;
constexpr size_t WS_END = WS_G + 96 * MiB;
static_assert(WS_WO + 2 * MiB <= WS_XN, "weights fit");
constexpr int LDS_BYTES = 147456;

#define LAS __attribute__((address_space(3)))
typedef unsigned short bf16;
typedef unsigned v4u __attribute__((ext_vector_type(4)));
typedef float f32x4 __attribute__((ext_vector_type(4)));
#define LDS_WAIT() asm volatile("s_waitcnt lgkmcnt(0)" ::: "memory")
__device__ __forceinline__ unsigned f2bf(float f) { unsigned u = __builtin_bit_cast(unsigned, f); return (u + 0x7fffu + ((u >> 16) & 1u)) >> 16; }
__device__ __forceinline__ unsigned pk2(float lo, float hi) { return f2bf(lo) | (f2bf(hi) << 16); }
__device__ __forceinline__ float wave_sum(float v) {
#pragma unroll
    for (int o = 1; o < 64; o <<= 1) v += __shfl_xor(v, o);
    return v;
}
__device__ __forceinline__ float silu_f(float x) { return x / (1.0f + __expf(-x)); }

__device__ __forceinline__ void transpose_item(const float* __restrict__ W, int ldw, int k0, int c0, bf16* WT, int K, int drow0, LAS float* scr, int lane) {
    { const int kr = lane >> 3, n4 = lane & 7;
      f32x4 v[8];
#pragma unroll
      for (int i = 0; i < 8; ++i) v[i] = *(const f32x4*)(W + (size_t)(k0 + 8 * i + kr) * ldw + c0 + 4 * n4);
#pragma unroll
      for (int i = 0; i < 8; ++i) { LAS float* p = scr + (8 * i + kr) * 33 + 4 * n4; p[0] = v[i].x; p[1] = v[i].y; p[2] = v[i].z; p[3] = v[i].w; } }
    LDS_WAIT(); asm volatile("" ::: "memory");
    const int c = lane & 7;
#pragma unroll
    for (int j = 0; j < 4; ++j) { const int n = (lane >> 3) + 8 * j; const LAS float* s = scr + (8 * c) * 33 + n;
        v4u o; o.x = pk2(s[0 * 33], s[1 * 33]); o.y = pk2(s[2 * 33], s[3 * 33]); o.z = pk2(s[4 * 33], s[5 * 33]); o.w = pk2(s[6 * 33], s[7 * 33]);
        *(v4u*)(WT + (size_t)(drow0 + n) * K + k0 + 8 * c) = o; }
    LDS_WAIT(); asm volatile("" ::: "memory");
}

#define XB_TMO      128
#define XB_XCNT(j)  (256  + 64 * (j))
#define XB_XSUB(j)  (1280 + 64 * (j))
#define XB_XGEN(j)  (2304 + 64 * (j))
#define XB_TOP      3328
#define XB_TOPGEN   3392
#define XCD_BAR_WORDS 3456
#define XB_SPIN_CAP (1u << 18)

__device__ __forceinline__ unsigned xb_ld(unsigned* p)              { return __hip_atomic_load(p, __ATOMIC_RELAXED, __HIP_MEMORY_SCOPE_AGENT); }
__device__ __forceinline__ unsigned xb_add(unsigned* p, unsigned v) { return __hip_atomic_fetch_add(p, v, __ATOMIC_RELAXED, __HIP_MEMORY_SCOPE_AGENT); }
__device__ __forceinline__ unsigned xb_xcc_id() { return (unsigned)__builtin_amdgcn_s_getreg((3 << 11) | 20) & 0xFu; }
#define XB_SPIN(cond, bar) do { unsigned _sp = 0; while (cond) { __builtin_amdgcn_s_sleep(1); \
    if ((++_sp & 255u) == 0u) { if (xb_ld(&(bar)[XB_TMO])) break; if (_sp > XB_SPIN_CAP) { atomicAdd(&(bar)[XB_TMO], 1u); break; } } } } while (0)

struct XcdBarrier {
    unsigned* bar; unsigned x;
    volatile LAS unsigned* st;
};

__device__ __forceinline__ XcdBarrier xcd_barrier_post(unsigned* bar, volatile LAS unsigned* st) {
    XcdBarrier b; b.bar = bar; b.x = xb_xcc_id(); b.st = st;
    if (threadIdx.x == 0) (void)xb_add(&bar[XB_XCNT(b.x)], 1u);
    return b;
}
__device__ __forceinline__ void xcd_barrier_complete(unsigned* bar, unsigned x, unsigned& nloc, unsigned& nx) {
    const unsigned G = gridDim.x * gridDim.y * gridDim.z;
    unsigned sum, cnt, mine, sp = 0u;
    for (;;) {
        sum = 0u; cnt = 0u; mine = 0u;
#pragma unroll
        for (unsigned j = 0; j < 16; ++j) { const unsigned c = xb_ld(&bar[XB_XCNT(j)]); sum += c; cnt += (c > 0u) ? 1u : 0u; mine = (j == x) ? c : mine; }
        if (sum == G) break;
        __builtin_amdgcn_s_sleep(1);
        if ((++sp & 255u) == 0u) { if (xb_ld(&bar[XB_TMO])) break; if (sp > XB_SPIN_CAP) { atomicAdd(&bar[XB_TMO], 1u); break; } }
    }
    nloc = mine > 0u ? mine : 1u; nx = cnt > 0u ? cnt : 1u;
}

__device__ __forceinline__ void xcd_barrier(const XcdBarrier& b) {
    asm volatile("s_waitcnt vmcnt(0)" ::: "memory");
    __syncthreads();
    if (threadIdx.x == 0) {
        unsigned* bar = b.bar;
        __builtin_amdgcn_s_waitcnt(0);
        unsigned nloc = b.st[0], nx = b.st[1];
        if (nloc == 0u) { xcd_barrier_complete(bar, b.x, nloc, nx); b.st[0] = nloc; b.st[1] = nx; }
        const unsigned old = xb_add(&bar[XB_XSUB(b.x)], 1u);
        const unsigned gen = old / nloc;
        if (old + 1u == (gen + 1u) * nloc) {
            __builtin_amdgcn_fence(__ATOMIC_RELEASE, "agent");
            asm volatile("s_waitcnt vmcnt(0)" ::: "memory");
            const unsigned og = xb_add(&bar[XB_TOP], 1u);
            const unsigned tg = og / nx;
            if (og + 1u == (tg + 1u) * nx) xb_add(&bar[XB_TOPGEN], 1u);
            else XB_SPIN(xb_ld(&bar[XB_TOPGEN]) == tg, bar);
            __builtin_amdgcn_fence(__ATOMIC_ACQUIRE, "agent");
            xb_add(&bar[XB_XGEN(b.x)], 1u);
            asm volatile("s_waitcnt vmcnt(0)" ::: "memory");
        } else {
            XB_SPIN(xb_ld(&bar[XB_XGEN(b.x)]) == gen, bar);
            __builtin_amdgcn_fence(__ATOMIC_ACQUIRE, "agent");
            asm volatile("s_waitcnt vmcnt(0)" ::: "memory");
        }
    }
    __syncthreads();
}

struct Args { const float* in[16]; float* out; unsigned char* ws; int cg_seam, pad; };
__device__ __forceinline__ const float* argp(int i) { auto ka = __builtin_amdgcn_kernarg_segment_ptr(); const __attribute__((address_space(1))) float* r; asm volatile("s_load_dwordx2 %0, %1, %2\n\ts_waitcnt lgkmcnt(0)" : "=s"(r) : "s"(ka), "i"(i * 8) : "memory"); return (const float*)r; }
#define ARG_IN(i) argp(i)
#define ARG_OUT ((float*)argp(16))
#define ARG_WS ((unsigned char*)argp(17))
__device__ __forceinline__ int arg_cg_seam() { auto ka = __builtin_amdgcn_kernarg_segment_ptr(); int r; asm volatile("s_load_dword %0, %1, 144\n\ts_waitcnt lgkmcnt(0)" : "=s"(r) : "s"(ka) : "memory"); return r; }

__device__ __forceinline__ void mod_phase(int j0, int j1, LAS unsigned char* lds, int vcu, int G, int tid, int wave, int lane) {
    unsigned char* ws_ = ARG_WS; float* MOD = (float*)(ws_ + WS_MOD); const float* c = ARG_IN(1); const float* w_ada = ARG_IN(2); const float* b_ada = ARG_IN(3);
    LAS float* part = (LAS float*)lds;
    for (int job = j0 + vcu; job < j1; job += G) {
        const int lm = job / 144, colbase = (job % 144) * 64, kk = lane >> 4, c4 = lane & 15;
        f32x4 acc0 = {0.f, 0.f, 0.f, 0.f}, acc1 = {0.f, 0.f, 0.f, 0.f};
        const float* wp = w_ada + ((size_t)lm * 1024 + wave * 128 + kk) * 9216 + colbase + 4 * c4;
#pragma unroll 8
        for (int i = 0; i < 32; ++i) { const int k = wave * 128 + 4 * i + kk; const f32x4 wv = *(const f32x4*)(wp + (size_t)i * 4 * 9216); const float a0 = silu_f(c[k]), a1 = silu_f(c[1024 + k]); acc0 += a0 * wv; acc1 += a1 * wv; }
#pragma unroll
        for (int e = 0; e < 4; ++e) { acc0[e] += __shfl_xor(acc0[e], 16); acc0[e] += __shfl_xor(acc0[e], 32); acc1[e] += __shfl_xor(acc1[e], 16); acc1[e] += __shfl_xor(acc1[e], 32); }
        if (kk == 0) { *(LAS f32x4*)(part + (wave * 2 + 0) * 64 + 4 * c4) = acc0; *(LAS f32x4*)(part + (wave * 2 + 1) * 64 + 4 * c4) = acc1; }
        __syncthreads();
        if (tid < 128) { const int b = tid >> 6, col = tid & 63; float s = b_ada[lm * 9216 + colbase + col];
#pragma unroll
          for (int w = 0; w < 8; ++w) s += part[(w * 2 + b) * 64 + col];
          MOD[(size_t)(lm * 2 + b) * 9216 + colbase + col] = s; }
        __syncthreads();
    }
}

__device__ __forceinline__ void weights_phase(int l, LAS unsigned char* lds, int vcu, int G, int wave, int lane) {
    LAS float* scr = (LAS float*)(lds + wave * 16384); unsigned char* ws_ = ARG_WS;
    bf16* WGU = (bf16*)(ws_ + WS_WGU); bf16* WD = (bf16*)(ws_ + WS_WD); bf16* WIN = (bf16*)(ws_ + WS_WIN); bf16* WBR = (bf16*)(ws_ + WS_WBR); bf16* WO = (bf16*)(ws_ + WS_WO);
    constexpr int IT_EFF = 1024, IT_GU = 2 * 2 * 16 * 88, IT_DN = 2 * 44 * 32, IT_IN = 16 * 208, IT_BR = 2 * 8 * 32, IT_WO = 16 * 32, IT_WF = 128, NITEMS = IT_EFF + IT_GU + IT_DN + IT_IN + IT_BR + IT_WO + IT_WF;
    const int gw = vcu * NWAVES + wave, NGW = G * NWAVES;
    for (int it = gw; it < NITEMS; it += NGW) {
        int r = it;
        if (r < IT_EFF) {
            const int cblk = r & 127, kh = (r >> 7) & 1, g = r >> 8, ci = kh * 64 + lane;
            const float* wp = ARG_IN(12) + ((size_t)(l * 4 + g) * 128 + ci) * 128; const float* ps = ARG_IN(13) + l * 512 + g * 128;
            const float* wb = ARG_IN(14) + ((size_t)(l * 3 + 1) * 512 + g * 128) * 1024 + cblk * 8;
            f32x4 a0 = {0.f, 0.f, 0.f, 0.f}, a1 = {0.f, 0.f, 0.f, 0.f};
#pragma unroll 16
            for (int e = 0; e < 128; ++e) { const float cf = wp[e] * ps[e]; a0 += cf * *(const f32x4*)(wb + (size_t)e * 1024); a1 += cf * *(const f32x4*)(wb + (size_t)e * 1024 + 4); }
            bf16* dst = WBR + (size_t)(1024 + cblk * 8) * 512 + g * 128 + ci;
            dst[0 * 512] = (bf16)f2bf(a0.x); dst[1 * 512] = (bf16)f2bf(a0.y); dst[2 * 512] = (bf16)f2bf(a0.z); dst[3 * 512] = (bf16)f2bf(a0.w);
            dst[4 * 512] = (bf16)f2bf(a1.x); dst[5 * 512] = (bf16)f2bf(a1.y); dst[6 * 512] = (bf16)f2bf(a1.z); dst[7 * 512] = (bf16)f2bf(a1.w);
        } else if ((r -= IT_EFF) < IT_GU) { const int j = r / 2816; r %= 2816; const int isup = r / 1408; r %= 1408; const int kb = r / 88, nb = r % 88, f0 = 32 * nb;
            const float* src = (isup ? ARG_IN(6) : ARG_IN(5)) + (size_t)(l * 2 + j) * 1024 * 2816;
            transpose_item(src, 2816, 64 * kb, f0, WGU + (size_t)j * NGU * 1024, 1024, 256 * (f0 >> 7) + 128 * isup + (f0 & 127), scr, lane);
        } else if ((r -= IT_GU) < IT_DN) { const int j = r / 1408; r %= 1408; const int kb = r / 32, nb = r % 32;
            transpose_item(ARG_IN(7) + (size_t)(l * 2 + j) * 2816 * 1024, 1024, 64 * kb, 32 * nb, WD + (size_t)j * 1024 * 2816, 2816, 32 * nb, scr, lane);
        } else if ((r -= IT_DN) < IT_IN) { const int kb = r / 208, nb = r % 208, L0 = 32 * nb, c0 = L0 < 3584 ? L0 : L0 + 8, pn = L0 >> 8, w = L0 & 255, hh = w >> 6, dh = (w >> 5) & 1;
            transpose_item(ARG_IN(8) + (size_t)l * 1024 * DIN, DIN, 64 * kb, c0, WIN, 1024, 256 * pn + 128 * dh + 32 * hh, scr, lane);
        } else if ((r -= IT_IN) < IT_BR) { const int n = (r / 256) * 2; r %= 256; const int kb = r / 32, nb = r % 32;
            transpose_item(ARG_IN(14) + (size_t)(l * 3 + n) * 512 * 1024, 1024, 64 * kb, 32 * nb, WBR, 512, n * 1024 + 32 * nb, scr, lane);
        } else if ((r -= IT_BR) < IT_WO) { const int kb = r / 32, nb = r % 32; transpose_item(ARG_IN(15) + (size_t)l * 1024 * 1024, 1024, 64 * kb, 32 * nb, WO, 1024, 32 * nb, scr, lane);
        } else { r -= IT_WO; float* WF = (float*)(ws_ + WS_WF); const int i = r * 64 + lane, hh = i >> 10, k = i & 1023; WF[i] = (ARG_IN(8) + (size_t)l * 1024 * DIN)[(size_t)k * DIN + 3584 + hh]; }
    }
}

__device__ __forceinline__ float log_sigmoid_f(float x) { return fminf(x, 0.f) - log1pf(__expf(-fabsf(x))); }

template <bool MIX>
__device__ __forceinline__ void norm_phase(const float* xin, int l, int sub, LAS unsigned char* lds, int vcu, int G, int tid, int wave, int lane) {
    unsigned char* ws_ = ARG_WS; const float* gain = ARG_IN(4) + (size_t)(l * 3 + sub) * 1024; const float* MOD = (const float*)(ws_ + WS_MOD);
    const float* shift = MOD + (size_t)(l * 2) * 9216 + (3 * sub) * 1024; const float* scale = shift + 1024;
    bf16* XN = (bf16*)(ws_ + WS_XN);
    LAS float* wfs = (LAS float*)lds; LAS float* lfs = (LAS float*)(lds + 32768);
    if (MIX) { const float* WF = (const float*)(ws_ + WS_WF); for (int i = tid; i < 8192; i += 512) wfs[i] = WF[i]; __syncthreads(); }
    for (int blk = vcu; blk < 256; blk += G) {
        const int b = blk >> 7;
#pragma unroll (MIX ? 2 : 4)
        for (int i = 0; i < 8; ++i) { const int rl = wave * 8 + i, row = blk * 64 + rl;
            const f32x4* xr = (const f32x4*)(xin + (size_t)row * 1024) + lane;
            f32x4 v[4]; float ss = 0.f;
#pragma unroll
            for (int j = 0; j < 4; ++j) { v[j] = xr[64 * j]; ss += (v[j].x * v[j].x + v[j].y * v[j].y) + (v[j].z * v[j].z + v[j].w * v[j].w); }
            const float rstd = 1.0f / sqrtf(wave_sum(ss) * (1.0f / 1024.0f) + 1e-6f);
            unsigned long long* o8 = (unsigned long long*)(XN + (size_t)row * 1024) + lane;
#pragma unroll
            for (int j = 0; j < 4; ++j) { const f32x4 g = ((const f32x4*)gain)[64 * j + lane], sc = ((const f32x4*)(scale + b * 9216))[64 * j + lane], sh = ((const f32x4*)(shift + b * 9216))[64 * j + lane];
                v[j] = (v[j] * rstd * g) * (1.0f + sc) + sh;
                o8[64 * j] = (unsigned long long)pk2(v[j].x, v[j].y) | ((unsigned long long)pk2(v[j].z, v[j].w) << 32); }
            if (MIX) { float keep = 0.f;
#pragma unroll
                for (int hh = 0; hh < 8; ++hh) { float p = 0.f;
#pragma unroll
                    for (int j = 0; j < 4; ++j) { const f32x4 w = *(const LAS f32x4*)(wfs + hh * 1024 + 4 * (64 * j + lane)); p += (v[j].x * w.x + v[j].y * w.y) + (v[j].z * w.z + v[j].w * w.w); }
                    p = wave_sum(p); keep = (lane == hh) ? p : keep; }
                if (lane < 8) lfs[rl * 8 + lane] = log_sigmoid_f(keep + ARG_IN(11)[l * 8 + lane]); }
        }
        if (MIX) { __syncthreads();
            float* CUM = (float*)(ws_ + WS_CUM); float* BT = (float*)(ws_ + WS_BT);
            float s = lfs[lane * 8 + wave];
#pragma unroll
            for (int o = 1; o < 64; o <<= 1) { const float t = __shfl_up(s, o); if (lane >= o) s += t; }
            CUM[(size_t)(b * 8 + wave) * SEQ + (blk & 127) * 64 + lane] = s; if (lane == 63) BT[blk * 32 + wave] = s;
            __syncthreads(); }
    }
}

__device__ __forceinline__ void f_phase(int l, LAS unsigned char* lds, int vcu, int G, int tid, int wave, int lane) {
    unsigned char* ws_ = ARG_WS; const bf16* XN = (const bf16*)(ws_ + WS_XN); const float* fb = ARG_IN(11) + l * 8;
    LAS float* wfs = (LAS float*)lds; LAS float* lfs = (LAS float*)(lds + 32768);
    { const float* WF = (const float*)(ws_ + WS_WF); for (int i = tid; i < 8192; i += 512) wfs[i] = WF[i]; __syncthreads(); }
    for (int blk = vcu; blk < 256; blk += G) {
        const int b = blk >> 7;
#pragma unroll 2
        for (int i = 0; i < 8; ++i) { const int rl = wave * 8 + i, row = blk * 64 + rl;
            const v4u* xr = (const v4u*)(XN + (size_t)row * 1024) + lane;
            const v4u a = xr[0], c = xr[64];
            const f32x4 h0 = {__uint_as_float(a.x << 16), __uint_as_float(a.x & 0xffff0000u), __uint_as_float(a.y << 16), __uint_as_float(a.y & 0xffff0000u)};
            const f32x4 h1 = {__uint_as_float(a.z << 16), __uint_as_float(a.z & 0xffff0000u), __uint_as_float(a.w << 16), __uint_as_float(a.w & 0xffff0000u)};
            const f32x4 h2 = {__uint_as_float(c.x << 16), __uint_as_float(c.x & 0xffff0000u), __uint_as_float(c.y << 16), __uint_as_float(c.y & 0xffff0000u)};
            const f32x4 h3 = {__uint_as_float(c.z << 16), __uint_as_float(c.z & 0xffff0000u), __uint_as_float(c.w << 16), __uint_as_float(c.w & 0xffff0000u)};
            float p8[8];
#pragma unroll
            for (int hh = 0; hh < 8; ++hh) { const LAS f32x4* w = (const LAS f32x4*)(wfs + hh * 1024 + 8 * lane);
                const f32x4 w0 = w[0], w1 = w[1], w2 = w[128], w3 = w[129];
                float p = ((h0.x * w0.x + h0.y * w0.y) + (h0.z * w0.z + h0.w * w0.w)) + ((h1.x * w1.x + h1.y * w1.y) + (h1.z * w1.z + h1.w * w1.w))
                        + ((h2.x * w2.x + h2.y * w2.y) + (h2.z * w2.z + h2.w * w2.w)) + ((h3.x * w3.x + h3.y * w3.y) + (h3.z * w3.z + h3.w * w3.w));
                p8[hh] = p; }
            { const bool b32 = (lane & 32) != 0, b16 = (lane & 16) != 0, b8 = (lane & 8) != 0; float q4[4], q2[2], q1;
#pragma unroll
              for (int k = 0; k < 4; ++k) { const float mine = b32 ? p8[4 + k] : p8[k], send = b32 ? p8[k] : p8[4 + k]; q4[k] = mine + __shfl_xor(send, 32); }
#pragma unroll
              for (int k = 0; k < 2; ++k) { const float mine = b16 ? q4[2 + k] : q4[k], send = b16 ? q4[k] : q4[2 + k]; q2[k] = mine + __shfl_xor(send, 16); }
              { const float mine = b8 ? q2[1] : q2[0], send = b8 ? q2[0] : q2[1]; q1 = mine + __shfl_xor(send, 8); }
              q1 += __shfl_xor(q1, 4); q1 += __shfl_xor(q1, 2); q1 += __shfl_xor(q1, 1);
              if ((lane & 7) == 0) lfs[rl * 8 + (lane >> 3)] = log_sigmoid_f(q1 + fb[lane >> 3]); } }
        __syncthreads();
        { float* CUM = (float*)(ws_ + WS_CUM); float* BT = (float*)(ws_ + WS_BT);
          float s = lfs[lane * 8 + wave];
#pragma unroll
          for (int o = 1; o < 64; o <<= 1) { const float t = __shfl_up(s, o); if (lane >= o) s += t; }
          CUM[(size_t)(b * 8 + wave) * SEQ + (blk & 127) * 64 + lane] = s; if (lane == 63) BT[blk * 32 + wave] = s; }
        __syncthreads();
    }
}

__device__ __forceinline__ void pool_un8(const v4u u, float (&f)[8]) {
    f[0] = __uint_as_float(u.x << 16); f[1] = __uint_as_float(u.x & 0xffff0000u); f[2] = __uint_as_float(u.y << 16); f[3] = __uint_as_float(u.y & 0xffff0000u);
    f[4] = __uint_as_float(u.z << 16); f[5] = __uint_as_float(u.z & 0xffff0000u); f[6] = __uint_as_float(u.w << 16); f[7] = __uint_as_float(u.w & 0xffff0000u);
}
__device__ __forceinline__ void pool_phase(const bf16* UB, bf16* DD, int vcu, int G, int tid) {
    for (int blk = vcu; blk < 256; blk += G) {
        const int ch = (tid & 63) * 8, lg = ch >> 7, w = 2 << lg, wv = tid >> 6, tr0 = (blk & 127) * 64 + wv * 8; const size_t row0 = (size_t)blk * 64 + wv * 8;
        v4u u[23];
#pragma unroll
        for (int k = 0; k < 23; ++k) { const int d = k - 15; const bool need = (d >= 1 - w) && (tr0 + d >= 0);
            u[k] = (v4u){0u, 0u, 0u, 0u}; if (need) u[k] = *(const v4u*)(UB + (row0 + d) * 512 + ch); }
        float s[8];
#pragma unroll
        for (int e = 0; e < 8; ++e) s[e] = 0.f;
#pragma unroll
        for (int k = 0; k < 16; ++k) { float f[8]; pool_un8(u[k], f);
#pragma unroll
            for (int e = 0; e < 8; ++e) s[e] += f[e]; }
#pragma unroll
        for (int i = 0; i < 8; ++i) { float cur[8]; pool_un8(u[15 + i], cur);
            if (i > 0) {
                const v4u uo = (lg == 0) ? u[13 + i] : (lg == 1) ? u[11 + i] : (lg == 2) ? u[7 + i] : u[i - 1]; float old[8]; pool_un8(uo, old);
#pragma unroll
                for (int e = 0; e < 8; ++e) s[e] += cur[e] - old[e]; }
            const int t = tr0 + i, cnt = (t + 1 < w) ? t + 1 : w; const float inv = 1.0f / (float)cnt; v4u o;
            o.x = pk2(s[0] * inv - cur[0], s[1] * inv - cur[1]); o.y = pk2(s[2] * inv - cur[2], s[3] * inv - cur[3]); o.z = pk2(s[4] * inv - cur[4], s[5] * inv - cur[5]); o.w = pk2(s[6] * inv - cur[6], s[7] * inv - cur[7]);
            *(v4u*)(DD + (row0 + i) * 512 + ch) = o; }
    }
}

__global__ void __launch_bounds__(NWAVES * 64, 2) mk_fwd(Args) {
    extern __shared__ __attribute__((aligned(16))) unsigned char lds_raw[];
    cg::grid_group grid = cg::this_grid();
    LAS unsigned char* lds = (LAS unsigned char*)lds_raw;
    const int tid = threadIdx.x, lane = tid & 63, wave = __builtin_amdgcn_readfirstlane(tid >> 6);
    const int G = gridDim.x, bx = blockIdx.x, vcu = (G % 8 == 0) ? (bx % 8) * (G / 8) + bx / 8 : bx;
    constexpr size_t SLOT_E = (size_t)M * 512;
    constexpr int NOSPLIT = 1 << 30;
    typedef pg8::bf16_t pbf;
#define CG_SYNC() do { asm volatile("s_waitcnt vmcnt(0) lgkmcnt(0)" ::: "memory"); __syncthreads(); grid.sync(); __builtin_amdgcn_fence(__ATOMIC_ACQUIRE, "agent"); asm volatile("s_waitcnt vmcnt(0)" ::: "memory"); __syncthreads(); } while (0)
#define GRID_SYNC() do { asm volatile("s_waitcnt lgkmcnt(0)" ::: "memory"); XcdBarrier b_; b_.bar = (unsigned*)(ARG_WS + WS_CTL); b_.x = xb_xcc_id(); b_.st = (volatile LAS unsigned*)(lds + 131072 + 256); xcd_barrier(b_); } while (0)
#define FRESH() int G_ = G, bx_ = bx, vcu_ = vcu, tid_ = tid; asm volatile("" : "+s"(G_), "+s"(bx_), "+s"(vcu_), "+v"(tid_)); const int lane_ = tid_ & 63; (void)lane_; (void)bx_
    volatile LAS unsigned* bst = (volatile LAS unsigned*)(lds + 131072 + 256);
    if (tid < 2) bst[tid] = 0u;
    __syncthreads();
    (void)xcd_barrier_post((unsigned*)(ARG_WS + WS_CTL), bst);
    if (arg_cg_seam()) CG_SYNC();
    { FRESH(); mod_phase(0, 32, lds, vcu_, G_, tid_, wave, lane_); }
    GRID_SYNC();
    { FRESH(); norm_phase<false>(ARG_IN(0), 0, 0, lds, vcu_, G_, tid_, wave, lane_); }
    { FRESH(); mod_phase(32, 288, lds, vcu_, G_, tid_, wave, lane_); }
    { FRESH(); weights_phase(0, lds, vcu_, G_, wave, lane_); }
    GRID_SYNC();
    for (int l = 0; l < 2; ++l) {
        if (l == 1) { FRESH(); weights_phase(1, lds, vcu_, G_, wave, lane_); GRID_SYNC(); }
        for (int f = 0; f < 2; ++f) {
#ifndef NO_N
#endif
            {
                FRESH(); unsigned char* ws = ARG_WS;
                pg8::Gemm g{(const pbf*)(ws + WS_XN), (const pbf*)(ws + WS_WGU) + (size_t)f * NGU * 1024, M, NGU, D, NOSPLIT, 0}; pg8::StaticOrder S; S.init(M, NGU, G_, bx_); S.tail = 1;
                pg8::EpiSwiglu E{(pbf*)(ws + WS_BIG), FF};
#ifndef NO_GU
                pg8::gemm_phase<pg8::EpiSwiglu, pg8::StaticOrder, true, true>(lds, g, S, E);
#endif
            }
            GRID_SYNC();
            {
                FRESH(); unsigned char* ws = ARG_WS; float* outp = ARG_OUT;
                pg8::Gemm g{(const pbf*)(ws + WS_BIG), (const pbf*)(ws + WS_WD) + (size_t)f * 1024 * FF, M, D, FF, NOSPLIT, 0}; pg8::StaticOrder S; S.init(M, D, G_, bx_);
                const int nl = (f == 0) ? l : 1, nsub = (f == 0) ? 1 : 0, bank = (f == 0) ? 3 + l : 2, donorm = (f == 0 || l == 0) ? 1 : 0;
                const float* ng_ = ARG_IN(4) + (size_t)(nl * 3 + nsub) * 1024; const float* xin_ = ARG_IN(0);
                const float* nm_ = (const float*)(ws + WS_MOD) + (size_t)(nl * 2) * 9216 + (size_t)(3 * nsub) * 1024;
                pg8::EpiResid E{(f == 0 && l == 0) ? xin_ : (const float*)outp, outp, (const float*)(ws + WS_MOD) + (size_t)(l * 2) * 9216 + (f == 0 ? 2 : 8) * 1024,
                                (pbf*)(ws + WS_XN), ng_, nm_, nm_ + 1024, (float*)(ws + WS_XBUF), (unsigned*)(ws + WS_CTL) + 4096 + bank * 4096, 0.5f, donorm};
#ifndef NO_RES
                pg8::gemm_phase<pg8::EpiResid, pg8::StaticOrder, false, true>(lds, g, S, E);
#endif
            }
            GRID_SYNC();
            if (f == 0) {
                {
                    FRESH(); f_phase(l, lds, vcu_, G_, tid_, wave, lane_); unsigned char* ws = ARG_WS;
                    pg8::Gemm g{(const pbf*)(ws + WS_XN), (const pbf*)(ws + WS_WIN), M, NIN, D, NOSPLIT, 0}; pg8::StaticOrder S; S.init(M, NIN, G_, bx_); S.tail = 1;
                    LAS float* gl = (LAS float*)(lds + 131072 + 1024); if (tid_ < 256) gl[tid_] = (ARG_IN(9) + l * 256)[tid_]; __syncthreads();
                    pg8::EpiInproj E{(pbf*)(ws + WS_BIG), (pbf*)(ws + WS_G), (const LAS float*)gl};
#ifndef NO_IN
                    pg8::gemm_phase<pg8::EpiInproj, pg8::StaticOrder, true, true>(lds, g, S, E);
#endif
                }
                GRID_SYNC();
                {
                    FRESH(); unsigned char* ws = ARG_WS; pbf* SL = (pbf*)(ws + WS_BIG);
#ifndef NO_POOL
                    pool_phase((const bf16*)(SL + 5 * SLOT_E), (bf16*)(SL + 1 * SLOT_E), vcu_, G_, tid_);
#endif
                    using abf = attn_body::bf16;
                    volatile LAS int* hmap = (volatile LAS int*)(lds + 131072 + 288);
                    if (tid_ < 8) { const float* fbp = ARG_IN(11) + l * 8; const float fh = fbp[tid_]; int rank = 0;
#pragma unroll
                        for (int jj = 0; jj < 8; ++jj) { const float fj = fbp[jj]; rank += (fj > fh || (fj == fh && jj < tid_)) ? 1 : 0; }
                        hmap[rank] = tid_; }
                    __syncthreads();
                    for (int uu = vcu_; uu < 256; uu += G_) { const int bh = uu >> 4, s = uu & 15, b = bh >> 3, r = bh & 7;
#ifndef NO_ATTN0
                        for (int i = 0; i < 2; ++i) { const int h = __builtin_amdgcn_readfirstlane(hmap[i ? 7 - r : r]);
                            attn_body::attn_unit<0, 24>(b, h, i ? s : 31 - s, (const abf*)(SL + 2 * SLOT_E), (const abf*)(SL + 6 * SLOT_E), (const abf*)(SL + 7 * SLOT_E), (abf*)(SL + 2 * SLOT_E), (char*)lds_raw, (const float*)(ws + WS_CUM), (const float*)(ws + WS_BT), ARG_IN(9) + l * 256); }
#endif
#ifndef NO_ATTN1
                        for (int i = 0; i < 2; ++i)
                            attn_body::attn_unit<1, 8>(b, r, i ? s : 31 - s, (const abf*)(SL + 0 * SLOT_E), (const abf*)(SL + 3 * SLOT_E), (const abf*)(SL + 4 * SLOT_E), (abf*)(SL + 0 * SLOT_E), (char*)lds_raw, ARG_IN(10) + (size_t)(l * 8 + r) * 257, nullptr, nullptr);
#endif
                    }
                }
                GRID_SYNC();
                {
                    FRESH(); unsigned char* ws = ARG_WS;
                    pg8::Gemm g{(const pbf*)(ws + WS_BIG), (const pbf*)(ws + WS_WBR), M, 3072, 512, 4, SLOT}; pg8::BranchOrder S; S.S0.init(M, D, G_, bx_);
                    pg8::EpiBranch E{(pbf*)(ws + WS_MG), (const pbf*)(ws + WS_G)};
#ifndef NO_BR
                    pg8::gemm_phase<pg8::EpiBranch, pg8::BranchOrder, true, true>(lds, g, S, E);
#endif
                }
                GRID_SYNC();
                {
                    FRESH(); unsigned char* ws = ARG_WS; float* outp = ARG_OUT;
                    pg8::Gemm g{(const pbf*)(ws + WS_MG), (const pbf*)(ws + WS_WO), M, D, D, NOSPLIT, 0}; pg8::StaticOrder S; S.init(M, D, G_, bx_);
                    const float* ng_ = ARG_IN(4) + (size_t)(l * 3 + 2) * 1024;
                    pg8::EpiResid E{outp, outp, (const float*)(ws + WS_MOD) + (size_t)(l * 2) * 9216 + 5 * 1024,
                                    (pbf*)(ws + WS_XN), ng_, (const float*)(ws + WS_MOD) + (size_t)(l * 2) * 9216 + 6 * 1024, (const float*)(ws + WS_MOD) + (size_t)(l * 2) * 9216 + 7 * 1024, (float*)(ws + WS_XBUF), (unsigned*)(ws + WS_CTL) + 4096 + l * 4096, 1.0f, 1};
#ifndef NO_RES
                    pg8::gemm_phase<pg8::EpiResid, pg8::StaticOrder, false, true>(lds, g, S, E);
#endif
                }
                GRID_SYNC();
            }
        }
    }
}

extern "C" void kernel_launch(void* const* d_in, const int* in_sizes, int n_in, void* d_out, int out_size, void* d_ws, size_t ws_size, hipStream_t stream) {
    static int grid = 0;
    if (grid == 0) {
        if (n_in != 16 || out_size != M * D || ws_size < WS_END) { fprintf(stderr, "kernel_launch: unexpected shapes (n_in %d out %d ws %zu need %zu)\n", n_in, out_size, ws_size, (size_t)WS_END); grid = -1; return; }
        int dev = 0, cus = 0, per_cu = 0;
        if (hipGetDevice(&dev) != hipSuccess || hipDeviceGetAttribute(&cus, hipDeviceAttributeMultiprocessorCount, dev) != hipSuccess) { grid = -1; return; }
        if (hipFuncSetAttribute((const void*)mk_fwd, hipFuncAttributeMaxDynamicSharedMemorySize, LDS_BYTES) != hipSuccess) { fprintf(stderr, "kernel_launch: hipFuncSetAttribute failed\n"); grid = -1; return; }
        if (hipOccupancyMaxActiveBlocksPerMultiprocessor(&per_cu, (const void*)mk_fwd, NWAVES * 64, LDS_BYTES) != hipSuccess || per_cu < 1) { fprintf(stderr, "kernel_launch: occupancy query says %d\n", per_cu); per_cu = 1; }
        (void)hipGetLastError();
        grid = cus;
    }
    if (grid < 0) return;
    Args a{};
    for (int i = 0; i < 16; ++i) a.in[i] = (const float*)d_in[i];
    a.out = (float*)d_out; a.ws = (unsigned char*)d_ws; a.cg_seam = 0; a.pad = 0;
    if (hipMemsetAsync((char*)d_ws + WS_CTL, 0, CTL_ZERO_BYTES, stream) != hipSuccess) { fprintf(stderr, "kernel_launch: hipMemsetAsync failed\n"); return; }
    void* params[] = {&a};
    const hipError_t e = hipLaunchCooperativeKernel((const void*)mk_fwd, dim3(grid), dim3(NWAVES * 64), params, LDS_BYTES, stream);
    if (e != hipSuccess) fprintf(stderr, "kernel_launch: cooperative launch failed: %s (grid %d)\n", hipGetErrorString(e), grid);
}
```

```cpp
#include <hip/hip_runtime.h>
#include <hip/hip_cooperative_groups.h>
#include <hip/hip_bf16.h>
#include <cstdio>
#include <cstdint>
#include <cmath>
namespace cg = cooperative_groups;

namespace pg8 {
#define PG8_LAS __attribute__((address_space(3)))
typedef unsigned short bf16_t;
typedef short bf16x8 __attribute__((ext_vector_type(8)));
typedef float f32x4 __attribute__((ext_vector_type(4)));
typedef unsigned u32x4 __attribute__((ext_vector_type(4)));
constexpr int BM = 256, BK = 64, HALF = 128, HTB = HALF * BK * 2  , STAGE_BYTES = 8 * HTB, NXCD = 8, WGM = 8;

__host__ __device__ __forceinline__ int lds_byte(int r, int c) { const int st = (r >> 4) * 2 + (c >> 5), rr = r & 15, cc = c & 31, ob = rr * 64 + cc * 2; return st * 1024 + (ob ^ (((ob >> 9) & 1) << 5)); }
__host__ __device__ __forceinline__ void stage_rc(int b, int& R, int& C) { const int st = b / 1024, sb = b % 1024, swz = sb ^ (((sb >> 9) & 1) << 5); R = (st >> 1) * 16 + swz / 64; C = (st & 1) * 32 + (swz % 64) / 2; }
__host__ __device__ __forceinline__ int perm32(int rho) { const int n = rho >> 4, i = rho & 15; return 8 * (i >> 2) + 4 * n + (i & 3); }

struct Unit { int pm, pn, roff, nai; };
struct Gemm { const bf16_t* A; const bf16_t* Bt; int M, N, K; int a_tiles; size_t a_stride; };

struct StaticOrder {
    static constexpr bool KEEP = false;
    int nM, nN, nwg, G, c;
    __host__ __device__ void init(int M, int N, int G_, int c_) { nM = M / BM; nN = N / BM; nwg = nM * nN; G = G_; c = c_; tail = 0; }
    int tail;
    __host__ __device__ bool next(int i, Unit& u) const {
        long L = (long)i * G + c; u.roff = 0; u.nai = 2;
        const int full = nwg / G;
        if (tail && (nwg - full * G) * 2 == G && i >= full) { if (i > full) return false; L = (long)full * G + (c >> 1); u.roff = 128 * (c & 1); u.nai = 1; }
        if (L >= nwg) return false;
        int wgid = (int)L; { const int q = nwg / NXCD, r = nwg % NXCD, xcd = wgid % NXCD, off = wgid / NXCD; wgid = (xcd < r ? xcd * (q + 1) : r * (q + 1) + (xcd - r) * q) + off; }
        const int nig = WGM * nN, gid = wgid / nig, fm = gid * WGM, gsz = (nM - fm) < WGM ? (nM - fm) : WGM;
        u.pm = fm + ((wgid % nig) % gsz); u.pn = (wgid % nig) / gsz; return true;
    }
    __device__ __forceinline__ void a_ready(const Unit&) const {}
    __device__ __forceinline__ void done(const Unit&) const {}
};

typedef float f32x2c __attribute__((ext_vector_type(2))); typedef __bf16 bf16x2c __attribute__((ext_vector_type(2)));
__device__ __forceinline__ unsigned cvt_pk_bf16(float lo, float hi) { f32x2c v = {lo, hi}; bf16x2c b = __builtin_convertvector(v, bf16x2c); return __builtin_bit_cast(unsigned, b); }

typedef float f32x2 __attribute__((ext_vector_type(2)));
constexpr float EPI_LOG2E = 1.4426950408889634f;
constexpr float EPI_C2 = 0.125f * 1.4426950408889634f;
__device__ __forceinline__ float sigm(float x) { return __builtin_amdgcn_rcpf(1.0f + __builtin_amdgcn_exp2f(-x * EPI_LOG2E)); }
__device__ __forceinline__ f32x4 sigm4(f32x4 v) { return (f32x4){sigm(v[0]), sigm(v[1]), sigm(v[2]), sigm(v[3])}; }
__device__ __forceinline__ u32x4 pack8(f32x4 v0, f32x4 v1) { u32x4 w; w.x = cvt_pk_bf16(v0[0], v0[1]); w.y = cvt_pk_bf16(v0[2], v0[3]); w.z = cvt_pk_bf16(v1[0], v1[1]); w.w = cvt_pk_bf16(v1[2], v1[3]); return w; }
__device__ __forceinline__ f32x4 bf_lo4(unsigned a, unsigned b) { return (f32x4){__uint_as_float(a << 16), __uint_as_float(a & 0xffff0000u), __uint_as_float(b << 16), __uint_as_float(b & 0xffff0000u)}; }

__device__ __forceinline__ unsigned q4u8(f32x4 g) { f32x4 t = g * 255.0f + 0.5f; t[0] = fmaxf(t[0], 1.0f); t[1] = fmaxf(t[1], 1.0f); t[2] = fmaxf(t[2], 1.0f); t[3] = fmaxf(t[3], 1.0f);     return (unsigned)t[0] | ((unsigned)t[1] << 8) | ((unsigned)t[2] << 16) | ((unsigned)t[3] << 24); }
__device__ __forceinline__ f32x4 dq4u8(unsigned w) { return (f32x4){(float)(w & 0xffu), (float)((w >> 8) & 0xffu), (float)((w >> 16) & 0xffu), (float)(w >> 24)}; }
struct EpiSwiglu {
    static constexpr bool PERM = true, AFTER_DRAIN = false;
    bf16_t* H; int ldh;
    __device__ __forceinline__ void operator()(const f32x4 (&acc)[2][2][4][2], const Unit& u, int wr, int wc, int fr, int fq) const {
        const int row0 = u.pm * BM + u.roff + wr * 64 + fr, col0 = u.pn * 128 + wc * 32 + 8 * fq;
#pragma unroll
        for (int ai = 0; ai < 2; ++ai) if (ai < u.nai)
#pragma unroll
            for (int m = 0; m < 4; ++m) { bf16_t* rowp = H + (size_t)(row0 + ai * HALF + m * 16) * ldh + col0;
                const f32x4 g0 = acc[ai][0][m][0], g1 = acc[ai][0][m][1], u0 = acc[ai][1][m][0], u1 = acc[ai][1][m][1];
                const f32x4 h0 = g0 * sigm4(g0) * u0, h1 = g1 * sigm4(g1) * u1;
                *(u32x4*)rowp = pack8(h0, h1); }
    }
};
struct EpiResid {
    static constexpr bool PERM = false, AFTER_DRAIN = true;
    const float* base; float* out; const float* gate;
    bf16_t* xn; const float* ngain; const float* nshift; const float* nscale; float* xbuf; unsigned* cnt; float coef; int donorm;
    __device__ __forceinline__ void fused(f32x4 (&acc)[2][2][4][2], const Unit& u, int wr, int wc, int fr, int fq, PG8_LAS unsigned char* lds, int wid, int lane) const {
        const int row0 = u.pm * BM + wr * 64 + fr, col0 = u.pn * BM + wc * 32 + 4 * fq; const int bo = (u.pm >= 32 ? 9216 : 0); const float* gp = gate + bo + col0;
        f32x4 gv[2][2];
#pragma unroll
        for (int bj = 0; bj < 2; ++bj)
#pragma unroll
            for (int n = 0; n < 2; ++n) gv[bj][n] = *(const f32x4*)(gp + bj * HALF + n * 16) * coef;
#pragma unroll
        for (int ai = 0; ai < 2; ++ai)
#pragma unroll
            for (int m = 0; m < 4; ++m) { const size_t off = (size_t)(row0 + ai * HALF + m * 16) * 1024 + col0;
#pragma unroll
                for (int bj = 0; bj < 2; ++bj)
#pragma unroll
                    for (int n = 0; n < 2; ++n) { const f32x4 bs = *(const f32x4*)(base + off + bj * HALF + n * 16); acc[ai][bj][m][n] = bs + gv[bj][n] * acc[ai][bj][m][n]; *(f32x4*)(out + off + bj * HALF + n * 16) = acc[ai][bj][m][n]; }
                if (m & 1) asm volatile("" ::: "memory"); }
        if (donorm == 0) return;
        PG8_LAS float* P = (PG8_LAS float*)lds;
        PG8_LAS float* S = (PG8_LAS float*)(lds + 4096);
#pragma unroll
        for (int ai = 0; ai < 2; ++ai)
#pragma unroll
            for (int m = 0; m < 4; ++m) { float q = 0.f;
#pragma unroll
                for (int bj = 0; bj < 2; ++bj)
#pragma unroll
                    for (int n = 0; n < 2; ++n) { const f32x4 x = acc[ai][bj][m][n]; q += (x[0] * x[0] + x[1] * x[1]) + (x[2] * x[2] + x[3] * x[3]); }
                q += __shfl_xor(q, 16); q += __shfl_xor(q, 32);
                if (fq == 0) P[(ai * HALF + wr * 64 + m * 16 + fr) * 4 + wc] = q; }
        asm volatile("s_waitcnt lgkmcnt(0)" ::: "memory"); __builtin_amdgcn_s_barrier(); asm volatile("" ::: "memory");
        const int row = wid * 32 + (lane & 31); float* slot = xbuf + ((size_t)(u.pm * BM + row)) * 4;
        if (lane < 32) { const float t = (P[row * 4 + 0] + P[row * 4 + 1]) + (P[row * 4 + 2] + P[row * 4 + 3]); __hip_atomic_store((unsigned*)slot + u.pn, __float_as_uint(t), __ATOMIC_RELAXED, __HIP_MEMORY_SCOPE_AGENT); }
        asm volatile("s_waitcnt vmcnt(0)" ::: "memory");
        if (lane == 0) __hip_atomic_fetch_add(cnt + 64 * u.pm, 1u, __ATOMIC_RELAXED, __HIP_MEMORY_SCOPE_AGENT);
        if (wid == 0) { for (unsigned sp = 0; sp < (1u << 22); ++sp) { if ((unsigned)__builtin_amdgcn_readfirstlane(__hip_atomic_load(cnt + 64 * u.pm, __ATOMIC_RELAXED, __HIP_MEMORY_SCOPE_AGENT)) >= 32u) break; __builtin_amdgcn_s_sleep(2); }
            __builtin_amdgcn_fence(__ATOMIC_ACQUIRE, "agent"); }
        asm volatile("s_waitcnt vmcnt(0) lgkmcnt(0)" ::: "memory"); __builtin_amdgcn_s_barrier(); asm volatile("" ::: "memory");
        if (lane < 32) { float t = 0.f;
#pragma unroll
            for (int k = 0; k < 4; ++k) t += __uint_as_float(__hip_atomic_load((unsigned*)slot + k, __ATOMIC_RELAXED, __HIP_MEMORY_SCOPE_AGENT));
            S[row] = 1.0f / sqrtf(t * (1.0f / 1024.0f) + 1e-6f); }
        asm volatile("s_waitcnt lgkmcnt(0)" ::: "memory"); __builtin_amdgcn_s_barrier(); asm volatile("" ::: "memory");
        typedef unsigned u32x2v __attribute__((ext_vector_type(2)));
        const float* g2 = ngain + col0; const float* sh2 = nshift + bo + col0; const float* sc2 = nscale + bo + col0;
#pragma unroll
        for (int bj = 0; bj < 2; ++bj)
#pragma unroll
            for (int n = 0; n < 2; ++n) { const f32x4 g = *(const f32x4*)(g2 + bj * HALF + n * 16), sc = *(const f32x4*)(sc2 + bj * HALF + n * 16), sh = *(const f32x4*)(sh2 + bj * HALF + n * 16); const f32x4 gm = g * (1.0f + sc);
#pragma unroll
                for (int ai = 0; ai < 2; ++ai)
#pragma unroll
                    for (int m = 0; m < 4; ++m) { const int r = ai * HALF + wr * 64 + m * 16 + fr; const float rs = S[r]; const f32x4 v = (acc[ai][bj][m][n] * rs) * gm + sh;
                        u32x2v w; w.x = cvt_pk_bf16(v[0], v[1]); w.y = cvt_pk_bf16(v[2], v[3]);
                        *(u32x2v*)(xn + (size_t)(u.pm * BM + r) * 1024 + col0 + bj * HALF + n * 16) = w; } }
    }
};
struct EpiInproj {
    static constexpr bool PERM = true, AFTER_DRAIN = false;
    bf16_t* base; bf16_t* G; const PG8_LAS float* gain;
    __device__ __forceinline__ void operator()(const f32x4 (&acc)[2][2][4][2], const Unit& u, int wr, int wc, int fr, int fq) const {
        const int row0 = u.pm * BM + u.roff + wr * 64 + fr;
        if (u.pn >= 14) {
            const int col0 = (u.pn - 14) * 256 + 64 * wc + 8 * fq;
#pragma unroll
            for (int ai = 0; ai < 2; ++ai) if (ai < u.nai)
#pragma unroll
                for (int m = 0; m < 4; ++m) { unsigned char* rowp = (unsigned char*)G + (size_t)(row0 + ai * HALF + m * 16) * 3072 + col0;
#pragma unroll
                    for (int bj = 0; bj < 2; ++bj) { typedef unsigned u32x2q __attribute__((ext_vector_type(2))); u32x2q w; w.x = q4u8(sigm4(acc[ai][bj][m][0])); w.y = q4u8(sigm4(acc[ai][bj][m][1])); *(u32x2q*)(rowp + 32 * bj) = w; } }
        } else {
            const int t = u.pn >> 1; const int slot = (t == 0) ? 0 : (t == 4) ? 2 : (t < 4) ? t + 2 : t + 1; bf16_t* O = base + (size_t)slot * ((size_t)16384 * 512);     const int col0 = (u.pn & 1) * 256 + 64 * wc + 8 * fq;
            if (t == 0 || t == 1 || t == 4 || t == 5) {
                const int gi = (t == 0) ? 0 : (t == 1) ? 1 : (t == 4) ? 2 : 3; const float qs = (t == 0 || t == 4) ? EPI_C2 : 1.f;
                f32x4 gv[2][2];
#pragma unroll
                for (int bj = 0; bj < 2; ++bj)
#pragma unroll
                    for (int n = 0; n < 2; ++n) gv[bj][n] = *(const PG8_LAS f32x4*)(gain + gi * 64 + 32 * bj + 8 * fq + 4 * n) * qs;
#pragma unroll
                for (int ai = 0; ai < 2; ++ai) if (ai < u.nai)
#pragma unroll
                    for (int m = 0; m < 4; ++m) { bf16_t* rowp = O + (size_t)(row0 + ai * HALF + m * 16) * 512 + col0;
                        float ss = 0.f;
#pragma unroll
                        for (int bj = 0; bj < 2; ++bj)
#pragma unroll
                            for (int n = 0; n < 2; ++n) { const f32x4 x = acc[ai][bj][m][n]; ss += (x[0] * x[0] + x[1] * x[1]) + (x[2] * x[2] + x[3] * x[3]); }
                        ss += __shfl_xor(ss, 16); ss += __shfl_xor(ss, 32);
                        const float rstd = __builtin_amdgcn_rsqf(ss * (1.0f / 64.0f) + 1e-6f);
#pragma unroll
                        for (int bj = 0; bj < 2; ++bj) *(u32x4*)(rowp + 32 * bj) = pack8(acc[ai][bj][m][0] * rstd * gv[bj][0], acc[ai][bj][m][1] * rstd * gv[bj][1]); }
            } else {
#pragma unroll
                for (int ai = 0; ai < 2; ++ai) if (ai < u.nai)
#pragma unroll
                    for (int m = 0; m < 4; ++m) { bf16_t* rowp = O + (size_t)(row0 + ai * HALF + m * 16) * 512 + col0;
#pragma unroll
                        for (int bj = 0; bj < 2; ++bj) *(u32x4*)(rowp + 32 * bj) = pack8(acc[ai][bj][m][0], acc[ai][bj][m][1]); }
            }
        }
    }
};
struct EpiBranch {
    static constexpr bool PERM = true, AFTER_DRAIN = false;
    bf16_t* MG; const bf16_t* G;
    __device__ __forceinline__ void operator()(f32x4 (&acc)[2][2][4][2], const Unit& u, int wr, int wc, int fr, int fq) const {
        typedef unsigned u32x2q __attribute__((ext_vector_type(2)));
        const int n = u.pn >> 2, pc = u.pn & 3; const int row0 = u.pm * BM + wr * 64 + fr, col0 = pc * 256 + wc * 32 + 8 * fq;
        const int nn = (n < 2) ? n + 1 : n;
#pragma unroll
        for (int ai = 0; ai < 2; ++ai)
#pragma unroll
          for (int mp2 = 0; mp2 < 2; ++mp2) {
            u32x2q ga[2][2], gb[2][2];
#pragma unroll
            for (int q = 0; q < 2; ++q) { const int m = 2 * mp2 + q; const size_t row = (size_t)(row0 + ai * HALF + m * 16); const unsigned char* gp = (const unsigned char*)G + row * 3072 + col0;
#pragma unroll
                for (int bj = 0; bj < 2; ++bj) { ga[q][bj] = *(const u32x2q*)(gp + n * 1024 + bj * HALF); gb[q][bj] = *(const u32x2q*)(gp + nn * 1024 + bj * HALF); } }
            asm volatile("" : "+v"(ga[0][0]), "+v"(ga[0][1]), "+v"(ga[1][0]), "+v"(ga[1][1]), "+v"(gb[0][0]), "+v"(gb[0][1]), "+v"(gb[1][0]), "+v"(gb[1][1]));
#pragma unroll
            for (int q = 0; q < 2; ++q) { const int m = 2 * mp2 + q; const size_t row = (size_t)(row0 + ai * HALF + m * 16);
                if (n < 2) {
#pragma unroll
                    for (int bj = 0; bj < 2; ++bj) { const f32x4 d0 = dq4u8(gb[q][bj].x), d1 = dq4u8(gb[q][bj].y);
                        const f32x4 r0 = dq4u8(ga[q][bj].x) * (f32x4){__builtin_amdgcn_rcpf(d0[0]), __builtin_amdgcn_rcpf(d0[1]), __builtin_amdgcn_rcpf(d0[2]), __builtin_amdgcn_rcpf(d0[3])};
                        const f32x4 r1 = dq4u8(ga[q][bj].y) * (f32x4){__builtin_amdgcn_rcpf(d1[0]), __builtin_amdgcn_rcpf(d1[1]), __builtin_amdgcn_rcpf(d1[2]), __builtin_amdgcn_rcpf(d1[3])};
                        acc[ai][bj][m][0] *= r0; acc[ai][bj][m][1] *= r1; }
                } else { bf16_t* mp = MG + row * 1024 + col0;
#pragma unroll
                    for (int bj = 0; bj < 2; ++bj) *(u32x4*)(mp + bj * HALF) = pack8(dq4u8(ga[q][bj].x) * (acc[ai][bj][m][0] * (1.0f / 255.0f)), dq4u8(ga[q][bj].y) * (acc[ai][bj][m][1] * (1.0f / 255.0f))); } }
          }
    }
};
struct BranchOrder {
    static constexpr bool KEEP = true;
    StaticOrder S0;
    __device__ __forceinline__ bool next(int i, Unit& u) const { Unit t; if (!S0.next(i / 3, t)) return false; u.pm = t.pm; u.pn = 4 * (i % 3) + t.pn; u.roff = 0; u.nai = 2; return true; }
    __device__ __forceinline__ void a_ready(const Unit&) const {}
    __device__ __forceinline__ void done(const Unit&) const {}
};

template <class Epi, class Sched, bool ALIGN_EPI = false, bool SP2 = false>
__device__ __forceinline__ void gemm_phase(PG8_LAS unsigned char* lds, const Gemm g, const Sched& S, const Epi& E) {
    int tid_l = threadIdx.x; asm volatile("" : "+v"(tid_l));
    const int tid = tid_l, wid = __builtin_amdgcn_readfirstlane(tid >> 6), lane = tid & 63, wr = wid >> 2, wc = wid & 3, fr = lane & 15, fq = lane >> 4;
    const int K = g.K, nt = K / BK;
    unsigned voffA[2], voffB[2];
#pragma unroll
    for (int i = 0; i < 2; ++i) { int R, C; stage_rc(tid * 16 + i * 8192, R, C); const int Rb = Epi::PERM ? ((R & ~31) + perm32(R & 31)) : R;
        voffA[i] = (unsigned)(R * K + C) * 2u; voffB[i] = (unsigned)(Rb * K + C) * 2u; }
    const size_t kstep = (size_t)(BK * 2);
    const size_t hstep = (size_t)HALF * K * 2;
    const size_t tstep = 2 * hstep;
    const unsigned ldsw = (unsigned)wid * 1024u;
    const int aoff = lds_byte(wr * 64 + fr, fq * 8), boff = lds_byte(wc * 32 + fr, fq * 8);
#define PG8_SA(b, h) (((b) * 2 + (h)) * HTB)
#define PG8_SB(b, h) ((4 + (b) * 2 + (h)) * HTB)
#define PG8_STAGE(bufoff, gbase, voff) do { _Pragma("unroll") for (int _i = 0; _i < 2; ++_i) \
        __builtin_amdgcn_global_load_lds((const unsigned*)((const char*)(gbase) + (voff)[_i]), (PG8_LAS unsigned*)(lds + (bufoff) + ldsw + _i * 8192), 16, 0, 0); } while (0)
#define PG8_LDA(dst, b, h) do { _Pragma("unroll") for (int m = 0; m < 4; ++m) _Pragma("unroll") for (int k = 0; k < 2; ++k) dst[m][k] = *(const PG8_LAS bf16x8*)(lds + PG8_SA(b, h) + aoff + m * 2048 + k * 1024); } while (0)
#define PG8_LDB(dst, b, h) do { _Pragma("unroll") for (int n = 0; n < 2; ++n) _Pragma("unroll") for (int k = 0; k < 2; ++k) dst[n][k] = *(const PG8_LAS bf16x8*)(lds + PG8_SB(b, h) + boff + n * 2048 + k * 1024); } while (0)
#define PG8_MMA(ai, bj, At, Bt) do { __builtin_amdgcn_s_setprio(1); _Pragma("unroll") for (int m = 0; m < 4; ++m) _Pragma("unroll") for (int n = 0; n < 2; ++n) _Pragma("unroll") for (int k = 0; k < 2; ++k) \
        acc[ai][bj][m][n] = __builtin_amdgcn_mfma_f32_16x16x32_bf16(Bt[n][k], At[m][k], acc[ai][bj][m][n], 0, 0, 0); __builtin_amdgcn_s_setprio(0); } while (0)
#define PG8_WAIT_V(n) asm volatile("s_waitcnt vmcnt(" #n ")" ::: "memory")
#define PG8_WAIT_L(n) asm volatile("s_waitcnt lgkmcnt(" #n ")" ::: "memory")
#define PG8_BAR __builtin_amdgcn_s_barrier()
#define PG8_SCHED __builtin_amdgcn_sched_barrier(0)
    Unit cur, nxt; int ui = 0;
    if (!S.next(0, cur)) return;
    f32x4 acc[2][2][4][2];
#pragma unroll
    for (int a = 0; a < 2; ++a)
#pragma unroll
        for (int b = 0; b < 2; ++b)
#pragma unroll
            for (int m = 0; m < 4; ++m)
#pragma unroll
                for (int n = 0; n < 2; ++n) acc[a][b][m][n] = (f32x4){0.f, 0.f, 0.f, 0.f};
    bf16x8 At[4][2], B0[2][2], B1[2][2];
    const char* cA = (const char*)g.A + (size_t)(cur.pn / g.a_tiles) * g.a_stride + (size_t)cur.pm * tstep + (size_t)cur.roff * K * 2; const char* cB = (const char*)g.Bt + (size_t)cur.pn * tstep;
    S.a_ready(cur);
    if constexpr (SP2) {
        PG8_STAGE(PG8_SB(0, 0), cB, voffB); PG8_STAGE(PG8_SB(0, 1), cB + hstep, voffB); PG8_STAGE(PG8_SA(0, 0), cA, voffA); PG8_STAGE(PG8_SA(0, 1), cA + hstep, voffA);
        if (wr == 1) PG8_BAR;
        PG8_WAIT_V(2); PG8_BAR;
        PG8_STAGE(PG8_SB(1, 0), cB + kstep, voffB); PG8_STAGE(PG8_SA(1, 0), cA + kstep, voffA); PG8_STAGE(PG8_SB(1, 1), cB + hstep + kstep, voffB);
        PG8_WAIT_V(6); PG8_BAR;
    } else {
        PG8_STAGE(PG8_SB(0, 0), cB, voffB); PG8_STAGE(PG8_SA(0, 0), cA, voffA); PG8_STAGE(PG8_SB(0, 1), cB + hstep, voffB); PG8_STAGE(PG8_SA(0, 1), cA + hstep, voffA);
        if (wr == 1) PG8_BAR;
        PG8_WAIT_V(4); PG8_BAR;
        PG8_STAGE(PG8_SB(1, 0), cB + kstep, voffB); PG8_STAGE(PG8_SA(1, 0), cA + kstep, voffA); PG8_STAGE(PG8_SB(1, 1), cB + hstep + kstep, voffB);
        PG8_WAIT_V(6); PG8_BAR;
    }
    for (;;) {
        const bool has_next = S.next(ui + 1, nxt);
        const char* nA = has_next ? (const char*)g.A + (size_t)(nxt.pn / g.a_tiles) * g.a_stride + (size_t)nxt.pm * tstep + (size_t)nxt.roff * K * 2 : cA; const char* nB = has_next ? (const char*)g.Bt + (size_t)nxt.pn * tstep : cB;
        const bool full = (cur.nai == 2);
        for (int t = 0; t < nt; t += 2) {
            const bool last = (t == nt - 2);
            const char* a1 = cA + (size_t)(t + 1) * kstep;
            const char* a2 = last ? nA : cA + (size_t)(t + 2) * kstep; const char* b2 = last ? nB : cB + (size_t)(t + 2) * kstep;
            const char* a3 = a2 + kstep; const char* b3 = b2 + kstep;
            if (last && has_next) S.a_ready(nxt);
            if constexpr (SP2) {
            PG8_LDB(B0, 0, 0); PG8_LDB(B1, 0, 1); PG8_SCHED; PG8_LDA(At, 0, 0); PG8_STAGE(PG8_SA(1, 1), a1 + hstep, voffA);
            PG8_WAIT_V(8); PG8_WAIT_L(0); PG8_BAR; PG8_MMA(0, 0, At, B0); PG8_MMA(0, 1, At, B1); PG8_BAR; PG8_SCHED;
            if (full) PG8_LDA(At, 0, 1); PG8_STAGE(PG8_SB(0, 0), b2, voffB); PG8_STAGE(PG8_SB(0, 1), b2 + hstep, voffB); PG8_STAGE(PG8_SA(0, 0), a2, voffA);
            PG8_WAIT_V(8); PG8_WAIT_L(0); PG8_BAR; if (full) { PG8_MMA(1, 0, At, B0); PG8_MMA(1, 1, At, B1); } PG8_BAR; PG8_SCHED;
            PG8_LDB(B0, 1, 0); PG8_LDB(B1, 1, 1); PG8_SCHED; PG8_LDA(At, 1, 0); PG8_STAGE(PG8_SA(0, 1), a2 + hstep, voffA);
            PG8_WAIT_V(8); PG8_WAIT_L(0); PG8_BAR; PG8_MMA(0, 0, At, B0); PG8_MMA(0, 1, At, B1); PG8_BAR; PG8_SCHED;
            if (full) PG8_LDA(At, 1, 1); PG8_STAGE(PG8_SB(1, 0), b3, voffB); PG8_STAGE(PG8_SB(1, 1), b3 + hstep, voffB); PG8_STAGE(PG8_SA(1, 0), a3, voffA);
            PG8_WAIT_V(8); PG8_WAIT_L(0); PG8_BAR; if (full) { PG8_MMA(1, 0, At, B0); PG8_MMA(1, 1, At, B1); } PG8_BAR; PG8_SCHED;
            } else {
            PG8_LDB(B0, 0, 0); PG8_SCHED; PG8_LDA(At, 0, 0); PG8_STAGE(PG8_SA(1, 1), a1 + hstep, voffA);
            PG8_WAIT_L(8); PG8_BAR; PG8_WAIT_L(0); PG8_MMA(0, 0, At, B0); PG8_BAR; PG8_SCHED;
            PG8_LDB(B1, 0, 1); PG8_STAGE(PG8_SB(0, 0), b2, voffB);
            PG8_BAR; PG8_WAIT_L(0); PG8_MMA(0, 1, At, B1); PG8_BAR;
            PG8_LDA(At, 0, 1); PG8_STAGE(PG8_SA(0, 0), a2, voffA);
            PG8_BAR; PG8_WAIT_L(0); PG8_MMA(1, 0, At, B0); PG8_BAR; PG8_SCHED;
            PG8_STAGE(PG8_SB(0, 1), b2 + hstep, voffB);
            PG8_WAIT_V(6); PG8_BAR; PG8_MMA(1, 1, At, B1); PG8_BAR;
            PG8_LDB(B0, 1, 0); PG8_SCHED; PG8_LDA(At, 1, 0); PG8_STAGE(PG8_SA(0, 1), a2 + hstep, voffA);
            PG8_WAIT_L(8); PG8_BAR; PG8_WAIT_L(0); PG8_MMA(0, 0, At, B0); PG8_BAR; PG8_SCHED;
            PG8_LDB(B1, 1, 1); PG8_STAGE(PG8_SB(1, 0), b3, voffB);
            PG8_BAR; PG8_WAIT_L(0); PG8_MMA(0, 1, At, B1); PG8_BAR;
            PG8_LDA(At, 1, 1); PG8_STAGE(PG8_SA(1, 0), a3, voffA);
            PG8_BAR; PG8_WAIT_L(0); PG8_MMA(1, 0, At, B0); PG8_BAR; PG8_SCHED;
            PG8_STAGE(PG8_SB(1, 1), b3 + hstep, voffB);
            PG8_WAIT_V(6); PG8_BAR; PG8_MMA(1, 1, At, B1); PG8_BAR;
            }
        }
        if constexpr (ALIGN_EPI) { if (wr == 0) PG8_BAR; }
        if constexpr (!Epi::AFTER_DRAIN) { E(acc, cur, wr, wc, fr, fq); S.done(cur); }
        if (!has_next) break;
        if (!Sched::KEEP || (nxt.pn >> 2) == 0) {
#pragma unroll
        for (int a = 0; a < 2; ++a)
#pragma unroll
            for (int b = 0; b < 2; ++b)
#pragma unroll
                for (int m = 0; m < 4; ++m)
#pragma unroll
                    for (int n = 0; n < 2; ++n) acc[a][b][m][n] = (f32x4){0.f, 0.f, 0.f, 0.f};
        }
        cur = nxt; cA = nA; cB = nB; ++ui;
        if constexpr (ALIGN_EPI) { if (wr == 1) PG8_BAR; }
    }
    PG8_WAIT_V(0);
    if constexpr (!ALIGN_EPI) { if (wr == 0) PG8_BAR; }
    PG8_BAR;
    if constexpr (Epi::AFTER_DRAIN) { E.fused(acc, cur, wr, wc, fr, fq, lds, wid, lane); S.done(cur); }
#undef PG8_SA
#undef PG8_SB
#undef PG8_STAGE
#undef PG8_LDA
#undef PG8_LDB
#undef PG8_MMA
#undef PG8_WAIT_V
#undef PG8_WAIT_L
#undef PG8_BAR
#undef PG8_SCHED
}
}

#include <hip/hip_bf16.h>
#include <cmath>
namespace attn_body {
using bf16=__hip_bfloat16;
using bf16x8=__attribute__((ext_vector_type(8)))short;
using s16x4=__attribute__((ext_vector_type(4)))short;
using f32x16=__attribute__((ext_vector_type(16)))float;
using u32x4=__attribute__((ext_vector_type(4)))unsigned;
constexpr int BATCH=2,NHEAD=8,SEQ=8192,D=64,DM=NHEAD*D;
constexpr int NW=8,QBLK=32,QB=QBLK*NW,KVBLK=64,NQB=SEQ/QB;
constexpr int ATTN_PITCH=DM, ATTN_UNIT_ROWS=QB;
__device__ __forceinline__ int crow(int r,int hi){return (r&3)+8*(r>>2)+4*hi;}
#define SBAR() __builtin_amdgcn_sched_barrier(0)
__device__ __forceinline__ void cmask(f32x16&p0,f32x16&p1,int jb,int qrel,int hi){
  const float NEG=-INFINITY; int kb=64*jb+4*hi;
  #pragma unroll
  for(int r=0;r<16;++r){int kv=kb+(r&3)+8*(r>>2); if(kv>qrel)p0[r]=NEG; if(kv+32>qrel)p1[r]=NEG;}
}

constexpr int NSLOT=3, SLOTB=8192;
constexpr int LDS_K=0, LDS_V=NSLOT*SLOTB, LDS_WS=2*NSLOT*SLOTB, LDS_OST=LDS_WS+NW*64*4, LDS_BYTES=LDS_OST+NW*4096;
constexpr float C2=0.125f*1.4426950408889634f; constexpr float LOG2E=1.4426950408889634f; constexpr int TAB_OFF=86016, LDS_BYTES_ALL=TAB_OFF+32768+512; constexpr float NEGBIG=-30000.f;

typedef __attribute__((address_space(3))) float* lds_fptr;
typedef float f32x4a __attribute__((ext_vector_type(4)));
template<int MODE> __device__ __forceinline__ void hook(f32x16&p0,f32x16&p1,int t,int NT,int qrel,int hi,lds_fptr tab,int dbase,int ibase){
  if(MODE==0){
    const lds_fptr tb=tab+64*t+4*hi;
    #pragma unroll
    for(int g=0;g<4;++g){ const f32x4a a=*(const __attribute__((address_space(3))) f32x4a*)(tb+8*g); const f32x4a c=*(const __attribute__((address_space(3))) f32x4a*)(tb+32+8*g);
      p0[4*g+0]+=a.x;p0[4*g+1]+=a.y;p0[4*g+2]+=a.z;p0[4*g+3]+=a.w; p1[4*g+0]+=c.x;p1[4*g+1]+=c.y;p1[4*g+2]+=c.z;p1[4*g+3]+=c.w; }
    const int jb=t-(NT-4); if(jb>=0)cmask(p0,p1,jb,qrel,hi);
  } else {
    const int delta=dbase-t;
    if(delta<0||delta>8){
      #pragma unroll
      for(int r=0;r<16;++r){p0[r]=NEGBIG;p1[r]=NEGBIG;}
    } else if(delta>=3){ const float cf=tab[256];
      #pragma unroll
      for(int r=0;r<16;++r){p0[r]+=cf;p1[r]+=cf;}
    } else { const int ib=64*delta+ibase-4*hi;
      #pragma unroll
      for(int r=0;r<16;++r){ const int kc=(r&3)+8*(r>>2); int i0=ib-kc, i1=ib-32-kc; i0=i0>256?256:i0; i1=i1>256?256:i1; p0[r]+=tab[i0]; p1[r]+=tab[i1]; }
    }
  }
}
__device__ __forceinline__ void glds16(const void*gsrc,unsigned lds_dst){unsigned keep;
  asm volatile("s_mov_b32 %0, m0\n\ts_mov_b32 m0, %2\n\ts_nop 0\n\tglobal_load_lds_dwordx4 %1, off\n\ts_mov_b32 m0, %0":"=&s"(keep):"v"(gsrc),"s"(lds_dst):"memory");}
__device__ __forceinline__ float max3f(float a,float b,float c){float r;asm("v_max3_f32 %0, %1, %2, %3":"=v"(r):"v"(a),"v"(b),"v"(c));return r;}
__device__ __forceinline__ float max2f(float a,float b){float r;asm("v_max_f32_e32 %0, %1, %2":"=v"(r):"v"(a),"v"(b));return r;}
__device__ __forceinline__ float fadd_s(float a,float b){float r;asm("v_add_f32_e32 %0, %1, %2":"=v"(r):"v"(a),"v"(b));return r;}
__device__ __forceinline__ float fsub_s(float a,float b){float r;asm("v_sub_f32_e32 %0, %1, %2":"=v"(r):"v"(a),"v"(b));return r;}
typedef float f32x2_t __attribute__((ext_vector_type(2))); typedef __bf16 bf16x2_t __attribute__((ext_vector_type(2)));
__device__ __forceinline__ unsigned cvtpk_s(float lo,float hi){f32x2_t v={lo,hi};bf16x2_t b=__builtin_convertvector(v,bf16x2_t);return __builtin_bit_cast(unsigned,b);}
#define WAIT_BAR(N) asm volatile("s_waitcnt vmcnt(" #N ") lgkmcnt(0)\n\ts_barrier":::"memory")

__device__ __forceinline__ void qkt(f32x16&p0,f32x16&p1,const char*Kslot,const bf16x8*qr,const f32x16&negm,int r32,int hi){
  const char*kb=Kslot+hi*1024+r32*16;
  #pragma unroll
  for(int d0=0;d0<4;++d0){
    const bf16x8 b0=*reinterpret_cast<const bf16x8*>(kb+d0*2048);
    const bf16x8 b1=*reinterpret_cast<const bf16x8*>(kb+d0*2048+512);
    if(d0==0){p0=__builtin_amdgcn_mfma_f32_32x32x16_bf16(b0,qr[0],negm,0,0,0);p1=__builtin_amdgcn_mfma_f32_32x32x16_bf16(b1,qr[0],negm,0,0,0);}
    else{p0=__builtin_amdgcn_mfma_f32_32x32x16_bf16(b0,qr[d0],p0,0,0,0);p1=__builtin_amdgcn_mfma_f32_32x32x16_bf16(b1,qr[d0],p1,0,0,0);}}
}
typedef __attribute__((address_space(3))) const char* lds_cptr;
typedef short v4i16_t __attribute__((ext_vector_type(4)));
__device__ __forceinline__ void kload8(bf16x8*kf,lds_cptr kp){
  kf[0]=*(const __attribute__((address_space(3))) bf16x8*)(kp);      kf[1]=*(const __attribute__((address_space(3))) bf16x8*)(kp+512);
  kf[2]=*(const __attribute__((address_space(3))) bf16x8*)(kp+2048); kf[3]=*(const __attribute__((address_space(3))) bf16x8*)(kp+2560);
  kf[4]=*(const __attribute__((address_space(3))) bf16x8*)(kp+4096); kf[5]=*(const __attribute__((address_space(3))) bf16x8*)(kp+4608);
  kf[6]=*(const __attribute__((address_space(3))) bf16x8*)(kp+6144); kf[7]=*(const __attribute__((address_space(3))) bf16x8*)(kp+6656);
}
__device__ __forceinline__ void kload2(bf16x8*kf,lds_cptr kp,int j){ kf[2*j]=*(const __attribute__((address_space(3))) bf16x8*)(kp+j*2048); kf[2*j+1]=*(const __attribute__((address_space(3))) bf16x8*)(kp+j*2048+512); }
__device__ __forceinline__ s16x4 vtr(lds_cptr p){ return __builtin_bit_cast(s16x4,__builtin_amdgcn_ds_read_tr16_b64_v4i16((__attribute__((address_space(3))) v4i16_t*)p)); }
__device__ __forceinline__ float rowmax(const f32x16&p0,const f32x16&p1){
  float a=max3f(p0[0],p0[1],p1[0]),b=max3f(p0[2],p0[3],p1[1]);a=max3f(a,p1[2],p1[3]);
  #pragma unroll
  for(int r=4;r<16;r+=4){a=max3f(a,p0[r],p0[r+1]);b=max3f(b,p0[r+2],p0[r+3]);a=max3f(a,p1[r],p1[r+1]);b=max3f(b,p1[r+2],p1[r+3]);}
  const float m=max2f(a,b);
  auto rr=__builtin_amdgcn_permlane32_swap(__float_as_uint(m),__float_as_uint(m),false,false);
  return max2f(__uint_as_float(rr[0]),__uint_as_float(rr[1]));
}
__device__ __forceinline__ void pv(f32x16*o,int vb,bf16x8 pa0,bf16x8 pa1,bf16x8 pa2,bf16x8 pa3){
  #pragma unroll
  for(int d0=0;d0<2;++d0){s16x4 lo[4],hi[4];
    #pragma unroll
    for(int ks=0;ks<4;++ks){
      asm volatile("ds_read_b64_tr_b16 %0,%1 offset:%c2":"=&v"(lo[ks]):"v"(vb),"i"(d0*4096+ks*1024):"memory");
      asm volatile("ds_read_b64_tr_b16 %0,%1 offset:%c2":"=&v"(hi[ks]):"v"(vb),"i"(d0*4096+ks*1024+512):"memory");}
    asm volatile("s_waitcnt lgkmcnt(0)":::"memory");SBAR();
    #define PK(k) (bf16x8){lo[k][0],lo[k][1],lo[k][2],lo[k][3],hi[k][0],hi[k][1],hi[k][2],hi[k][3]}
    o[d0]=__builtin_amdgcn_mfma_f32_32x32x16_bf16(pa0,PK(0),o[d0],0,0,0);
    o[d0]=__builtin_amdgcn_mfma_f32_32x32x16_bf16(pa1,PK(1),o[d0],0,0,0);
    o[d0]=__builtin_amdgcn_mfma_f32_32x32x16_bf16(pa2,PK(2),o[d0],0,0,0);
    o[d0]=__builtin_amdgcn_mfma_f32_32x32x16_bf16(pa3,PK(3),o[d0],0,0,0);
    #undef PK
  }
}

#ifndef ATTN_STORE16
#define ATTN_STORE16(p,v) (*(u32x4*)(p)=(v))
#endif
template<int MODE,int THRL> __device__ __forceinline__ void attn_unit(int b,int h,int qb,const bf16*Q,const bf16*__restrict__ K,const bf16*__restrict__ V,bf16*O,char*shm,const float*aux0,const float*aux1,const float*aux2){
  int tid_l=threadIdx.x; asm volatile("":"+v"(tid_l)); const int tid=tid_l,lane=tid&63,r32=lane&31,hi=lane>>5; const int wid=__builtin_amdgcn_readfirstlane(tid>>6);
  const long rowbase=(long)b*SEQ; const int q0=qb*QB;
  const bf16*Qw=Q+(rowbase+q0+wid*QBLK)*DM+h*D;
  int T0;
  if(MODE==1){ T0=(4*qb-8)>0?(4*qb-8):0; }
  else {
    const lds_fptr bp0=(lds_fptr)((lds_cptr)shm+TAB_OFF)+8192;
    if(wid==0){ const float a=aux1[(b*128+lane)*32+h], c=aux1[(b*128+64+lane)*32+h]; float sa=a, sc=c;
      #pragma unroll
      for(int o=1;o<64;o<<=1){ const float ta=__shfl_up(sa,o), tc=__shfl_up(sc,o); if(lane>=o){sa+=ta;sc+=tc;} }
      const float tot=__shfl(sa,63); bp0[lane]=sa-a; bp0[64+lane]=tot+sc-c; }
    asm volatile("s_waitcnt vmcnt(0) lgkmcnt(0)\n\ts_barrier":::"memory");
    const float*cum0=aux0+(long)(b*NHEAD+h)*SEQ; const int ntp=q0/KVBLK;
    float gq=fabsf(aux2[128+lane]), gk=fabsf(aux2[192+lane]);
    #pragma unroll
    for(int o=1;o<64;o<<=1){ gq=fmaxf(gq,__shfl_xor(gq,o)); gk=fmaxf(gk,__shfl_xor(gk,o)); }
    const float thr=-(cum0[q0]+bp0[q0>>6])*LOG2E-(2.02f*8.f*LOG2E*gq*gk+38.f);
    bool c0=false,c1=false;
    if(lane<ntp) c0=(-(cum0[64*lane+63]+bp0[lane])*LOG2E<thr);
    if(lane+64<ntp) c1=(-(cum0[64*(lane+64)+63]+bp0[lane+64])*LOG2E<thr);
    const int cnt=__popcll(__ballot(c0))+__popcll(__ballot(c1));
    T0=__builtin_amdgcn_readfirstlane(cnt&~1);
  }
  const bf16*Kh=K+(rowbase+(long)T0*KVBLK)*DM+h*D,*Vh=V+(rowbase+(long)T0*KVBLK)*DM+h*D;
  const unsigned lds0=(unsigned)(uintptr_t)shm;
  float*wsf=(float*)(shm+LDS_WS)+wid*64;
  const bf16*ksrc=Kh+(long)lane*DM+wid*8;
  const bf16*vsrc=Vh+(long)(16*(wid&3)+(lane>>2))*DM+(wid>>2)*32+(lane&3)*8;
  const unsigned kdst=lds0+LDS_K+wid*1024, vdst=lds0+LDS_V+wid*1024;
  #define DMA_K(t,slot) glds16(ksrc+(long)(t)*KVBLK*DM,(unsigned)__builtin_amdgcn_readfirstlane(kdst+(slot)))
  #define DMA_V(t,slot) glds16(vsrc+(long)(t)*KVBLK*DM,(unsigned)__builtin_amdgcn_readfirstlane(vdst+(slot)))
  const int vb0=(int)(lds0+LDS_V)+((lane>>4)&1)*32+(lane&3)*8+(4*hi+((lane&15)>>2))*64;
  const char*Kbase=shm+LDS_K; bf16x8 kf[8];
  const lds_cptr shm3=(lds_cptr)shm; const lds_cptr kp0=shm3+LDS_K+hi*1024+r32*16; const lds_cptr vp0=shm3+LDS_V+((lane>>4)&1)*32+(lane&3)*8+(4*hi+((lane&15)>>2))*64;
  const int NT=(q0+QB)/KVBLK-T0;
  const lds_fptr tab=(lds_fptr)(shm3+TAB_OFF);
  const int dbase=4*qb+(wid>>1)-T0, ibase=32*(wid&1)+r32+128; const lds_fptr tabh=(MODE==0)?tab+64*T0:tab;
  if(MODE==0){
    const lds_fptr bp=tab+8192;
    const int nkeys=q0+QB; const float*cum=aux0+(long)(b*NHEAD+h)*SEQ;
    for(int j0=64*T0+tid;j0<nkeys;j0+=2048){ float cv[4];
      #pragma unroll
      for(int u4=0;u4<4;++u4){const int jj=j0+512*u4; cv[u4]=(jj<nkeys)?cum[jj]:0.f;}
      #pragma unroll
      for(int u4=0;u4<4;++u4){const int jj=j0+512*u4; if(jj<nkeys) tab[jj]=-(cv[u4]+bp[jj>>6])*LOG2E;} }
  } else {
    if(tid<257) tab[tid]=aux0[tid]*LOG2E;
  }
  DMA_K(0,0);DMA_V(0,0);DMA_K(1,SLOTB);
  bf16x8 qr[4];
  #pragma unroll
  for(int d0=0;d0<4;++d0)qr[d0]=*reinterpret_cast<const bf16x8*>(&Qw[(long)r32*DM+d0*16+hi*8]);
  float mhat=0.f,l_reg=0.f;f32x16 o[2];o[0]=f32x16{};o[1]=f32x16{};f32x16 negm=f32x16{};asm volatile("":"+v"(negm));
  const int qrel=wid*QBLK+r32;
  #define CMASK(P0,P1,t) hook<MODE>(P0,P1,(t),NT,qrel,hi,tabh,dbase,ibase)
  bool resc=false;
  #define START(P0,P1) do{ const float rm=rowmax(P0,P1); resc=false; \
    { const float dl=rm; mhat=fadd_s(mhat,dl); \
      _Pragma("unroll") for(int r=0;r<16;++r){P0[r]=fsub_s(P0[r],dl);P1[r]=fsub_s(P1[r],dl);} \
      _Pragma("unroll") for(int r=0;r<16;++r)negm[r]=-mhat; asm volatile("":"+v"(negm)); } \
    _Pragma("unroll") for(int r=0;r<16;++r)P0[r]=__builtin_amdgcn_exp2f(P0[r]); }while(0)
  #define RESC() do{ if(resc){ asm volatile("s_waitcnt lgkmcnt(0)":::"memory"); \
      _Pragma("unroll") for(int d_=0;d_<2;++d_) _Pragma("unroll") for(int r=0;r<16;++r)o[d_][r]*=wsf[crow(r,hi)]; } }while(0)
  f32x16 pA0,pA1,pB0,pB1;
  int sl_prev=0,sl_cur=0,sl_next=SLOTB;
  #define ROT() do{sl_prev=sl_cur;sl_cur=sl_next;sl_next=(sl_next==(NSLOT-1)*SLOTB)?0:sl_next+SLOTB;}while(0)
  DMA_K(2,2*SLOTB);
  WAIT_BAR(3);
  qkt(pA0,pA1,Kbase,qr,negm,r32,hi);asm volatile("s_nop 15\n\ts_nop 7":"+v"(pA0),"+v"(pA1));CMASK(pA0,pA1,0);
  START(pA0,pA1);
  _Pragma("unroll") for(int r=0;r<16;++r)pA1[r]=__builtin_amdgcn_exp2f(pA1[r]);
  WAIT_BAR(0);
  DMA_K(3,0);DMA_V(1,SLOTB);
  ROT();
  kload8(kf,kp0+sl_cur);
  WAIT_BAR(2);
  s16x4 vlo[8],vhi[8]; u32x4 pw0,pw1,pw2,pw3;
  #define PKW(P,B) cvtpk_s(P[B],P[B+1])
  #define PAF(k) __builtin_bit_cast(bf16x8,pw##k)
  #define VFR(i) (bf16x8){vlo[i][0],vlo[i][1],vlo[i][2],vlo[i][3],vhi[i][0],vhi[i][1],vhi[i][2],vhi[i][3]}
  #define PIN(x) asm volatile("":"+v"(x))
  #define MX3(a,b,c) __builtin_fmaxf(__builtin_fmaxf((a),(b)),(c))
  #define GAPA(MF,A0,A1,A2,A3,W0,W1,PW) do{ MF; sacc+=A0; sacc+=A1; sacc+=A2; sacc+=A3; PIN(sacc); W0; W1; PIN(PW); SBAR(); }while(0)
  #define EX(v) __builtin_amdgcn_exp2f(v)
  #define GAPB(MF,X,B) do{ MF; X[B]=EX(X[B]); X[B+1]=EX(X[B+1]); X[B+2]=EX(X[B+2]); X[B+3]=EX(X[B+3]); PIN(X); SBAR(); }while(0)
  #define VRD(i) do{ vlo[i]=vtr(vp_+(((i)>>2)*4096+((i)&3)*1024)); vhi[i]=vtr(vp_+(((i)>>2)*4096+((i)&3)*1024+512)); }while(0)
  #define KRD(G,j) do{ if(G){ kload2(kf,kp0+sl_next,j); SBAR(); } }while(0)
  #define STEP(C0,C1,P0,P1,t,GK,GV,GL) do{ SBAR(); \
    const lds_cptr vp_=vp0+sl_prev; \
    VRD(0); SBAR(); float sacc=(P0[0]+P0[1]); \
    GAPA(C0=__builtin_amdgcn_mfma_f32_32x32x16_bf16(kf[0],qr[0],negm,0,0,0), P0[2],P0[3],P0[4],P0[5],     pw0[0]=PKW(P0,0), pw0[1]=PKW(P0,2), pw0); \
    VRD(4); SBAR(); GAPA(C1=__builtin_amdgcn_mfma_f32_32x32x16_bf16(kf[1],qr[0],negm,0,0,0), P0[6],P0[7],P0[8],P0[9],     pw0[2]=PKW(P0,4), pw0[3]=PKW(P0,6), pw0); \
    VRD(1); SBAR(); GAPA(C0=__builtin_amdgcn_mfma_f32_32x32x16_bf16(kf[2],qr[1],C0,0,0,0),   P0[10],P0[11],P0[12],P0[13], pw1[0]=PKW(P0,8), pw1[1]=PKW(P0,10), pw1); \
    VRD(5); SBAR(); GAPA(C1=__builtin_amdgcn_mfma_f32_32x32x16_bf16(kf[3],qr[1],C1,0,0,0),   P0[14],P0[15],P1[0],P1[1],   pw1[2]=PKW(P0,12),pw1[3]=PKW(P0,14), pw1); \
    VRD(2); SBAR(); GAPA(C0=__builtin_amdgcn_mfma_f32_32x32x16_bf16(kf[4],qr[2],C0,0,0,0),   P1[2],P1[3],P1[4],P1[5],     pw2[0]=PKW(P1,0), pw2[1]=PKW(P1,2), pw2); \
    VRD(6); SBAR(); GAPA(C1=__builtin_amdgcn_mfma_f32_32x32x16_bf16(kf[5],qr[2],C1,0,0,0),   P1[6],P1[7],P1[8],P1[9],     pw2[2]=PKW(P1,4), pw2[3]=PKW(P1,6), pw2); \
    VRD(3); SBAR(); GAPA(C0=__builtin_amdgcn_mfma_f32_32x32x16_bf16(kf[6],qr[3],C0,0,0,0),   P1[10],P1[11],P1[12],P1[13], pw3[0]=PKW(P1,8), pw3[1]=PKW(P1,10), pw3); \
    VRD(7); SBAR(); GAPA(C1=__builtin_amdgcn_mfma_f32_32x32x16_bf16(kf[7],qr[3],C1,0,0,0),   P1[14],P1[15],0.f,0.f,       pw3[2]=PKW(P1,12),pw3[3]=PKW(P1,14), pw3); \
    l_reg+=sacc; \
    if(GK){DMA_K((t)+3,sl_cur);} if(GV){DMA_V((t)+1,sl_next);} \
    CMASK(C0,C1,t); \
    { float a=MX3(C0[0],C0[1],C1[0]),b=MX3(C0[2],C0[3],C1[1]); a=MX3(a,C1[2],C1[3]); \
      _Pragma("unroll") for(int r=4;r<16;r+=4){a=MX3(a,C0[r],C0[r+1]);b=MX3(b,C0[r+2],C0[r+3]);a=MX3(a,C1[r],C1[r+1]);b=MX3(b,C1[r+2],C1[r+3]);} \
      float rm=__builtin_fmaxf(a,b); { auto rr=__builtin_amdgcn_permlane32_swap(__float_as_uint(rm),__float_as_uint(rm),false,false); rm=__builtin_fmaxf(__uint_as_float(rr[0]),__uint_as_float(rr[1])); } \
      resc=false; \
      if(__builtin_expect(__any(rm>(float)THRL),0)){ const float dl=__builtin_fmaxf(rm,0.f); mhat+=dl; \
        _Pragma("unroll") for(int r=0;r<16;++r){C0[r]-=dl;C1[r]-=dl;} \
        _Pragma("unroll") for(int r=0;r<16;++r)negm[r]=-mhat; asm volatile("":"+v"(negm)); \
        const float f=__builtin_amdgcn_exp2f(-dl); l_reg*=f; if(hi==0)wsf[r32]=f; resc=true; } } \
    SBAR(); \
    GAPB(o[0]=__builtin_amdgcn_mfma_f32_32x32x16_bf16(PAF(0),VFR(0),o[0],0,0,0), C0,0); \
    GAPB(o[1]=__builtin_amdgcn_mfma_f32_32x32x16_bf16(PAF(0),VFR(4),o[1],0,0,0), C0,4); \
    KRD(GL,0); GAPB(o[0]=__builtin_amdgcn_mfma_f32_32x32x16_bf16(PAF(1),VFR(1),o[0],0,0,0), C0,8); \
    KRD(GL,1); GAPB(o[1]=__builtin_amdgcn_mfma_f32_32x32x16_bf16(PAF(1),VFR(5),o[1],0,0,0), C0,12); \
    KRD(GL,2); GAPB(o[0]=__builtin_amdgcn_mfma_f32_32x32x16_bf16(PAF(2),VFR(2),o[0],0,0,0), C1,0); \
    KRD(GL,3); GAPB(o[1]=__builtin_amdgcn_mfma_f32_32x32x16_bf16(PAF(2),VFR(6),o[1],0,0,0), C1,4); \
    GAPB(o[0]=__builtin_amdgcn_mfma_f32_32x32x16_bf16(PAF(3),VFR(3),o[0],0,0,0), C1,8); \
    GAPB(o[1]=__builtin_amdgcn_mfma_f32_32x32x16_bf16(PAF(3),VFR(7),o[1],0,0,0), C1,12); \
    }while(0)
  int t=1;
  for(;t+5<NT;t+=2){
    STEP(pB0,pB1,pA0,pA1,t,true,true,true);     WAIT_BAR(2); RESC(); ROT();
    STEP(pA0,pA1,pB0,pB1,t+1,true,true,true);   WAIT_BAR(2); RESC(); ROT();
  }
  #define ENDW(tt) do{ if((tt)+3<NT){WAIT_BAR(2);} else if((tt)+2<NT){WAIT_BAR(1);} else {WAIT_BAR(0);} }while(0)
  for(;t+1<NT;t+=2){
    STEP(pB0,pB1,pA0,pA1,t,(t+3<NT),(t+1<NT),(t+1<NT));       ENDW(t);   RESC(); ROT();
    STEP(pA0,pA1,pB0,pB1,t+1,(t+4<NT),(t+2<NT),(t+2<NT));     ENDW(t+1); RESC(); ROT();
  }
  STEP(pB0,pB1,pA0,pA1,NT-1,false,false,false); RESC();
  { float sacc=pB0[0]+pB0[1]; _Pragma("unroll") for(int r=2;r<16;++r)sacc+=pB0[r]; _Pragma("unroll") for(int r=0;r<16;++r)sacc+=pB1[r]; l_reg+=sacc;
    pw0=(u32x4){PKW(pB0,0),PKW(pB0,2),PKW(pB0,4),PKW(pB0,6)};pw1=(u32x4){PKW(pB0,8),PKW(pB0,10),PKW(pB0,12),PKW(pB0,14)};pw2=(u32x4){PKW(pB1,0),PKW(pB1,2),PKW(pB1,4),PKW(pB1,6)};pw3=(u32x4){PKW(pB1,8),PKW(pB1,10),PKW(pB1,12),PKW(pB1,14)};
    SBAR(); pv(o,vb0+sl_cur,PAF(0),PAF(1),PAF(2),PAF(3)); }
  #undef PKW
  #undef PAF
  #undef VFR
  #undef PIN
  #undef MX3
  #undef GAPA
  #undef GAPB
  #undef EX
  #undef VRD
  #undef KRD
  #undef STEP
  #undef ENDW
  {auto rr=__builtin_amdgcn_permlane32_swap(__float_as_uint(l_reg),__float_as_uint(l_reg),false,false);l_reg=__uint_as_float(rr[0])+__uint_as_float(rr[1]);}
  if(hi==0)wsf[32+r32]=l_reg;asm volatile("s_waitcnt lgkmcnt(0)":::"memory");
  float rli[16];
  #pragma unroll
  for(int r=0;r<16;++r)rli[r]=__builtin_amdgcn_rcpf(wsf[32+crow(r,hi)]);
  bf16*Ow=O+(rowbase+q0+wid*QBLK)*DM+h*D;
  { bf16*stg=(bf16*)(shm+LDS_OST)+wid*2048;
    #pragma unroll
    for(int r=0;r<16;++r){const int orow=crow(r,hi);
      #pragma unroll
      for(int d0=0;d0<2;++d0)stg[orow*64+d0*32+r32]=__float2bfloat16(o[d0][r]*rli[r]);}
    asm volatile("s_waitcnt lgkmcnt(0)":::"memory");
    #pragma unroll
    for(int i=0;i<4;++i){const int row=i*8+(lane>>3),ch=lane&7; const u32x4 v=*(const u32x4*)(stg+row*64+ch*8); ATTN_STORE16(Ow+(long)row*DM+ch*8,v);} }
  asm volatile("s_waitcnt lgkmcnt(0)\n\ts_barrier":::"memory");
  #undef DMA_K
  #undef DMA_V
  #undef CMASK
  #undef START
  #undef RESC
  #undef ROT
}
constexpr int ATTN_LDS_BYTES=LDS_BYTES_ALL;
#undef SBAR
#undef WAIT_BAR
}

constexpr int NWAVES = 8;
constexpr int M = 16384, D = 1024, FF = 2816, NGU = 5632, NIN = 6656, DIN = 6664, SEQ = 8192;
constexpr size_t MiB = 1u << 20;
constexpr size_t WS_MOD = 0;
constexpr size_t WS_WF = 256 * 1024;
constexpr size_t WS_BT = 320 * 1024;
constexpr size_t WS_CTL = 1536 * 1024, CTL_ZERO_BYTES = 131072;
constexpr size_t WS_XBUF = WS_CTL + 131072;
constexpr size_t WS_CUM = 1 * MiB;
constexpr size_t WS_WGU = 2 * MiB;
constexpr size_t WS_WD = WS_WGU + 22 * MiB;
constexpr size_t WS_WIN = WS_WD + 11 * MiB;
constexpr size_t WS_WBR = WS_WIN + 13 * MiB;
constexpr size_t WS_WO = WS_WBR + 3 * MiB;
constexpr size_t WS_XN = 54 * MiB;
constexpr size_t WS_BIG = 86 * MiB;
constexpr size_t SLOT = 16 * MiB;
constexpr size_t WS_G = WS_BIG + 8 * SLOT;
constexpr size_t WS_MG = WS_BIG + 3 * SLOT;
constexpr size_t WS_END = WS_G + 96 * MiB;
static_assert(WS_WO + 2 * MiB <= WS_XN, "weights fit");
constexpr int LDS_BYTES = 147456;

#define LAS __attribute__((address_space(3)))
typedef unsigned short bf16;
typedef unsigned v4u __attribute__((ext_vector_type(4)));
typedef float f32x4 __attribute__((ext_vector_type(4)));
#define LDS_WAIT() asm volatile("s_waitcnt lgkmcnt(0)" ::: "memory")
__device__ __forceinline__ unsigned f2bf(float f) { unsigned u = __builtin_bit_cast(unsigned, f); return (u + 0x7fffu + ((u >> 16) & 1u)) >> 16; }
__device__ __forceinline__ unsigned pk2(float lo, float hi) { return f2bf(lo) | (f2bf(hi) << 16); }
__device__ __forceinline__ float wave_sum(float v) {
#pragma unroll
    for (int o = 1; o < 64; o <<= 1) v += __shfl_xor(v, o);
    return v;
}
__device__ __forceinline__ float silu_f(float x) { return x / (1.0f + __expf(-x)); }

__device__ __forceinline__ void transpose_item(const float* __restrict__ W, int ldw, int k0, int c0, bf16* WT, int K, int drow0, LAS float* scr, int lane) {
    { const int kr = lane >> 3, n4 = lane & 7;
      f32x4 v[8];
#pragma unroll
      for (int i = 0; i < 8; ++i) v[i] = *(const f32x4*)(W + (size_t)(k0 + 8 * i + kr) * ldw + c0 + 4 * n4);
#pragma unroll
      for (int i = 0; i < 8; ++i) { LAS float* p = scr + (8 * i + kr) * 33 + 4 * n4; p[0] = v[i].x; p[1] = v[i].y; p[2] = v[i].z; p[3] = v[i].w; } }
    LDS_WAIT(); asm volatile("" ::: "memory");
    const int c = lane & 7;
#pragma unroll
    for (int j = 0; j < 4; ++j) { const int n = (lane >> 3) + 8 * j; const LAS float* s = scr + (8 * c) * 33 + n;
        v4u o; o.x = pk2(s[0 * 33], s[1 * 33]); o.y = pk2(s[2 * 33], s[3 * 33]); o.z = pk2(s[4 * 33], s[5 * 33]); o.w = pk2(s[6 * 33], s[7 * 33]);
        *(v4u*)(WT + (size_t)(drow0 + n) * K + k0 + 8 * c) = o; }
    LDS_WAIT(); asm volatile("" ::: "memory");
}

#define XB_TMO      128
#define XB_XCNT(j)  (256  + 64 * (j))
#define XB_XSUB(j)  (1280 + 64 * (j))
#define XB_XGEN(j)  (2304 + 64 * (j))
#define XB_TOP      3328
#define XB_TOPGEN   3392
#define XCD_BAR_WORDS 3456
#define XB_SPIN_CAP (1u << 18)

__device__ __forceinline__ unsigned xb_ld(unsigned* p)              { return __hip_atomic_load(p, __ATOMIC_RELAXED, __HIP_MEMORY_SCOPE_AGENT); }
__device__ __forceinline__ unsigned xb_add(unsigned* p, unsigned v) { return __hip_atomic_fetch_add(p, v, __ATOMIC_RELAXED, __HIP_MEMORY_SCOPE_AGENT); }
__device__ __forceinline__ unsigned xb_xcc_id() { return (unsigned)__builtin_amdgcn_s_getreg((3 << 11) | 20) & 0xFu; }
#define XB_SPIN(cond, bar) do { unsigned _sp = 0; while (cond) { __builtin_amdgcn_s_sleep(1); \
    if ((++_sp & 255u) == 0u) { if (xb_ld(&(bar)[XB_TMO])) break; if (_sp > XB_SPIN_CAP) { atomicAdd(&(bar)[XB_TMO], 1u); break; } } } } while (0)

struct XcdBarrier {
    unsigned* bar; unsigned x;
    volatile LAS unsigned* st;
};

__device__ __forceinline__ XcdBarrier xcd_barrier_post(unsigned* bar, volatile LAS unsigned* st) {
    XcdBarrier b; b.bar = bar; b.x = xb_xcc_id(); b.st = st;
    if (threadIdx.x == 0) (void)xb_add(&bar[XB_XCNT(b.x)], 1u);
    return b;
}
__device__ __forceinline__ void xcd_barrier_complete(unsigned* bar, unsigned x, unsigned& nloc, unsigned& nx) {
    const unsigned G = gridDim.x * gridDim.y * gridDim.z;
    unsigned sum, cnt, mine, sp = 0u;
    for (;;) {
        sum = 0u; cnt = 0u; mine = 0u;
#pragma unroll
        for (unsigned j = 0; j < 16; ++j) { const unsigned c = xb_ld(&bar[XB_XCNT(j)]); sum += c; cnt += (c > 0u) ? 1u : 0u; mine = (j == x) ? c : mine; }
        if (sum == G) break;
        __builtin_amdgcn_s_sleep(1);
        if ((++sp & 255u) == 0u) { if (xb_ld(&bar[XB_TMO])) break; if (sp > XB_SPIN_CAP) { atomicAdd(&bar[XB_TMO], 1u); break; } }
    }
    nloc = mine > 0u ? mine : 1u; nx = cnt > 0u ? cnt : 1u;
}

__device__ __forceinline__ void xcd_barrier(const XcdBarrier& b) {
    asm volatile("s_waitcnt vmcnt(0)" ::: "memory");
    __syncthreads();
    if (threadIdx.x == 0) {
        unsigned* bar = b.bar;
        __builtin_amdgcn_s_waitcnt(0);
        unsigned nloc = b.st[0], nx = b.st[1];
        if (nloc == 0u) { xcd_barrier_complete(bar, b.x, nloc, nx); b.st[0] = nloc; b.st[1] = nx; }
        const unsigned old = xb_add(&bar[XB_XSUB(b.x)], 1u);
        const unsigned gen = old / nloc;
        if (old + 1u == (gen + 1u) * nloc) {
            __builtin_amdgcn_fence(__ATOMIC_RELEASE, "agent");
            asm volatile("s_waitcnt vmcnt(0)" ::: "memory");
            const unsigned og = xb_add(&bar[XB_TOP], 1u);
            const unsigned tg = og / nx;
            if (og + 1u == (tg + 1u) * nx) xb_add(&bar[XB_TOPGEN], 1u);
            else XB_SPIN(xb_ld(&bar[XB_TOPGEN]) == tg, bar);
            __builtin_amdgcn_fence(__ATOMIC_ACQUIRE, "agent");
            xb_add(&bar[XB_XGEN(b.x)], 1u);
            asm volatile("s_waitcnt vmcnt(0)" ::: "memory");
        } else {
            XB_SPIN(xb_ld(&bar[XB_XGEN(b.x)]) == gen, bar);
            __builtin_amdgcn_fence(__ATOMIC_ACQUIRE, "agent");
            asm volatile("s_waitcnt vmcnt(0)" ::: "memory");
        }
    }
    __syncthreads();
}

struct Args { const float* in[16]; float* out; unsigned char* ws; int cg_seam, pad; };
__device__ __forceinline__ const float* argp(int i) { auto ka = __builtin_amdgcn_kernarg_segment_ptr(); const __attribute__((address_space(1))) float* r; asm volatile("s_load_dwordx2 %0, %1, %2\n\ts_waitcnt lgkmcnt(0)" : "=s"(r) : "s"(ka), "i"(i * 8) : "memory"); return (const float*)r; }
#define ARG_IN(i) argp(i)
#define ARG_OUT ((float*)argp(16))
#define ARG_WS ((unsigned char*)argp(17))
__device__ __forceinline__ int arg_cg_seam() { auto ka = __builtin_amdgcn_kernarg_segment_ptr(); int r; asm volatile("s_load_dword %0, %1, 144\n\ts_waitcnt lgkmcnt(0)" : "=s"(r) : "s"(ka) : "memory"); return r; }

__device__ __forceinline__ void mod_phase(int j0, int j1, LAS unsigned char* lds, int vcu, int G, int tid, int wave, int lane) {
    unsigned char* ws_ = ARG_WS; float* MOD = (float*)(ws_ + WS_MOD); const float* c = ARG_IN(1); const float* w_ada = ARG_IN(2); const float* b_ada = ARG_IN(3);
    LAS float* part = (LAS float*)lds;
    for (int job = j0 + vcu; job < j1; job += G) {
        const int lm = job / 144, colbase = (job % 144) * 64, kk = lane >> 4, c4 = lane & 15;
        f32x4 acc0 = {0.f, 0.f, 0.f, 0.f}, acc1 = {0.f, 0.f, 0.f, 0.f};
        const float* wp = w_ada + ((size_t)lm * 1024 + wave * 128 + kk) * 9216 + colbase + 4 * c4;
#pragma unroll 8
        for (int i = 0; i < 32; ++i) { const int k = wave * 128 + 4 * i + kk; const f32x4 wv = *(const f32x4*)(wp + (size_t)i * 4 * 9216); const float a0 = silu_f(c[k]), a1 = silu_f(c[1024 + k]); acc0 += a0 * wv; acc1 += a1 * wv; }
#pragma unroll
        for (int e = 0; e < 4; ++e) { acc0[e] += __shfl_xor(acc0[e], 16); acc0[e] += __shfl_xor(acc0[e], 32); acc1[e] += __shfl_xor(acc1[e], 16); acc1[e] += __shfl_xor(acc1[e], 32); }
        if (kk == 0) { *(LAS f32x4*)(part + (wave * 2 + 0) * 64 + 4 * c4) = acc0; *(LAS f32x4*)(part + (wave * 2 + 1) * 64 + 4 * c4) = acc1; }
        __syncthreads();
        if (tid < 128) { const int b = tid >> 6, col = tid & 63; float s = b_ada[lm * 9216 + colbase + col];
#pragma unroll
          for (int w = 0; w < 8; ++w) s += part[(w * 2 + b) * 64 + col];
          MOD[(size_t)(lm * 2 + b) * 9216 + colbase + col] = s; }
        __syncthreads();
    }
}

__device__ __forceinline__ void weights_phase(int l, LAS unsigned char* lds, int vcu, int G, int wave, int lane) {
    LAS float* scr = (LAS float*)(lds + wave * 16384); unsigned char* ws_ = ARG_WS;
    bf16* WGU = (bf16*)(ws_ + WS_WGU); bf16* WD = (bf16*)(ws_ + WS_WD); bf16* WIN = (bf16*)(ws_ + WS_WIN); bf16* WBR = (bf16*)(ws_ + WS_WBR); bf16* WO = (bf16*)(ws_ + WS_WO);
    constexpr int IT_EFF = 1024, IT_GU = 2 * 2 * 16 * 88, IT_DN = 2 * 44 * 32, IT_IN = 16 * 208, IT_BR = 2 * 8 * 32, IT_WO = 16 * 32, IT_WF = 128, NITEMS = IT_EFF + IT_GU + IT_DN + IT_IN + IT_BR + IT_WO + IT_WF;
    const int gw = vcu * NWAVES + wave, NGW = G * NWAVES;
    for (int it = gw; it < NITEMS; it += NGW) {
        int r = it;
        if (r < IT_EFF) {
            const int cblk = r & 127, kh = (r >> 7) & 1, g = r >> 8, ci = kh * 64 + lane;
            const float* wp = ARG_IN(12) + ((size_t)(l * 4 + g) * 128 + ci) * 128; const float* ps = ARG_IN(13) + l * 512 + g * 128;
            const float* wb = ARG_IN(14) + ((size_t)(l * 3 + 1) * 512 + g * 128) * 1024 + cblk * 8;
            f32x4 a0 = {0.f, 0.f, 0.f, 0.f}, a1 = {0.f, 0.f, 0.f, 0.f};
#pragma unroll 16
            for (int e = 0; e < 128; ++e) { const float cf = wp[e] * ps[e]; a0 += cf * *(const f32x4*)(wb + (size_t)e * 1024); a1 += cf * *(const f32x4*)(wb + (size_t)e * 1024 + 4); }
            bf16* dst = WBR + (size_t)(1024 + cblk * 8) * 512 + g * 128 + ci;
            dst[0 * 512] = (bf16)f2bf(a0.x); dst[1 * 512] = (bf16)f2bf(a0.y); dst[2 * 512] = (bf16)f2bf(a0.z); dst[3 * 512] = (bf16)f2bf(a0.w);
            dst[4 * 512] = (bf16)f2bf(a1.x); dst[5 * 512] = (bf16)f2bf(a1.y); dst[6 * 512] = (bf16)f2bf(a1.z); dst[7 * 512] = (bf16)f2bf(a1.w);
        } else if ((r -= IT_EFF) < IT_GU) { const int j = r / 2816; r %= 2816; const int isup = r / 1408; r %= 1408; const int kb = r / 88, nb = r % 88, f0 = 32 * nb;
            const float* src = (isup ? ARG_IN(6) : ARG_IN(5)) + (size_t)(l * 2 + j) * 1024 * 2816;
            transpose_item(src, 2816, 64 * kb, f0, WGU + (size_t)j * NGU * 1024, 1024, 256 * (f0 >> 7) + 128 * isup + (f0 & 127), scr, lane);
        } else if ((r -= IT_GU) < IT_DN) { const int j = r / 1408; r %= 1408; const int kb = r / 32, nb = r % 32;
            transpose_item(ARG_IN(7) + (size_t)(l * 2 + j) * 2816 * 1024, 1024, 64 * kb, 32 * nb, WD + (size_t)j * 1024 * 2816, 2816, 32 * nb, scr, lane);
        } else if ((r -= IT_DN) < IT_IN) { const int kb = r / 208, nb = r % 208, L0 = 32 * nb, c0 = L0 < 3584 ? L0 : L0 + 8, pn = L0 >> 8, w = L0 & 255, hh = w >> 6, dh = (w >> 5) & 1;
            transpose_item(ARG_IN(8) + (size_t)l * 1024 * DIN, DIN, 64 * kb, c0, WIN, 1024, 256 * pn + 128 * dh + 32 * hh, scr, lane);
        } else if ((r -= IT_IN) < IT_BR) { const int n = (r / 256) * 2; r %= 256; const int kb = r / 32, nb = r % 32;
            transpose_item(ARG_IN(14) + (size_t)(l * 3 + n) * 512 * 1024, 1024, 64 * kb, 32 * nb, WBR, 512, n * 1024 + 32 * nb, scr, lane);
        } else if ((r -= IT_BR) < IT_WO) { const int kb = r / 32, nb = r % 32; transpose_item(ARG_IN(15) + (size_t)l * 1024 * 1024, 1024, 64 * kb, 32 * nb, WO, 1024, 32 * nb, scr, lane);
        } else { r -= IT_WO; float* WF = (float*)(ws_ + WS_WF); const int i = r * 64 + lane, hh = i >> 10, k = i & 1023; WF[i] = (ARG_IN(8) + (size_t)l * 1024 * DIN)[(size_t)k * DIN + 3584 + hh]; }
    }
}

__device__ __forceinline__ float log_sigmoid_f(float x) { return fminf(x, 0.f) - log1pf(__expf(-fabsf(x))); }

template <bool MIX>
__device__ __forceinline__ void norm_phase(const float* xin, int l, int sub, LAS unsigned char* lds, int vcu, int G, int tid, int wave, int lane) {
    unsigned char* ws_ = ARG_WS; const float* gain = ARG_IN(4) + (size_t)(l * 3 + sub) * 1024; const float* MOD = (const float*)(ws_ + WS_MOD);
    const float* shift = MOD + (size_t)(l * 2) * 9216 + (3 * sub) * 1024; const float* scale = shift + 1024;
    bf16* XN = (bf16*)(ws_ + WS_XN);
    LAS float* wfs = (LAS float*)lds; LAS float* lfs = (LAS float*)(lds + 32768);
    if (MIX) { const float* WF = (const float*)(ws_ + WS_WF); for (int i = tid; i < 8192; i += 512) wfs[i] = WF[i]; __syncthreads(); }
    for (int blk = vcu; blk < 256; blk += G) {
        const int b = blk >> 7;
#pragma unroll (MIX ? 2 : 4)
        for (int i = 0; i < 8; ++i) { const int rl = wave * 8 + i, row = blk * 64 + rl;
            const f32x4* xr = (const f32x4*)(xin + (size_t)row * 1024) + lane;
            f32x4 v[4]; float ss = 0.f;
#pragma unroll
            for (int j = 0; j < 4; ++j) { v[j] = xr[64 * j]; ss += (v[j].x * v[j].x + v[j].y * v[j].y) + (v[j].z * v[j].z + v[j].w * v[j].w); }
            const float rstd = 1.0f / sqrtf(wave_sum(ss) * (1.0f / 1024.0f) + 1e-6f);
            unsigned long long* o8 = (unsigned long long*)(XN + (size_t)row * 1024) + lane;
#pragma unroll
            for (int j = 0; j < 4; ++j) { const f32x4 g = ((const f32x4*)gain)[64 * j + lane], sc = ((const f32x4*)(scale + b * 9216))[64 * j + lane], sh = ((const f32x4*)(shift + b * 9216))[64 * j + lane];
                v[j] = (v[j] * rstd * g) * (1.0f + sc) + sh;
                o8[64 * j] = (unsigned long long)pk2(v[j].x, v[j].y) | ((unsigned long long)pk2(v[j].z, v[j].w) << 32); }
            if (MIX) { float keep = 0.f;
#pragma unroll
                for (int hh = 0; hh < 8; ++hh) { float p = 0.f;
#pragma unroll
                    for (int j = 0; j < 4; ++j) { const f32x4 w = *(const LAS f32x4*)(wfs + hh * 1024 + 4 * (64 * j + lane)); p += (v[j].x * w.x + v[j].y * w.y) + (v[j].z * w.z + v[j].w * w.w); }
                    p = wave_sum(p); keep = (lane == hh) ? p : keep; }
                if (lane < 8) lfs[rl * 8 + lane] = log_sigmoid_f(keep + ARG_IN(11)[l * 8 + lane]); }
        }
        if (MIX) { __syncthreads();
            float* CUM = (float*)(ws_ + WS_CUM); float* BT = (float*)(ws_ + WS_BT);
            float s = lfs[lane * 8 + wave];
#pragma unroll
            for (int o = 1; o < 64; o <<= 1) { const float t = __shfl_up(s, o); if (lane >= o) s += t; }
            CUM[(size_t)(b * 8 + wave) * SEQ + (blk & 127) * 64 + lane] = s; if (lane == 63) BT[blk * 32 + wave] = s;
            __syncthreads(); }
    }
}

__device__ __forceinline__ void f_phase(int l, LAS unsigned char* lds, int vcu, int G, int tid, int wave, int lane) {
    unsigned char* ws_ = ARG_WS; const bf16* XN = (const bf16*)(ws_ + WS_XN); const float* fb = ARG_IN(11) + l * 8;
    LAS float* wfs = (LAS float*)lds; LAS float* lfs = (LAS float*)(lds + 32768);
    { const float* WF = (const float*)(ws_ + WS_WF); for (int i = tid; i < 8192; i += 512) wfs[i] = WF[i]; __syncthreads(); }
    for (int blk = vcu; blk < 256; blk += G) {
        const int b = blk >> 7;
#pragma unroll 2
        for (int i = 0; i < 8; ++i) { const int rl = wave * 8 + i, row = blk * 64 + rl;
            const v4u* xr = (const v4u*)(XN + (size_t)row * 1024) + lane;
            const v4u a = xr[0], c = xr[64];
            const f32x4 h0 = {__uint_as_float(a.x << 16), __uint_as_float(a.x & 0xffff0000u), __uint_as_float(a.y << 16), __uint_as_float(a.y & 0xffff0000u)};
            const f32x4 h1 = {__uint_as_float(a.z << 16), __uint_as_float(a.z & 0xffff0000u), __uint_as_float(a.w << 16), __uint_as_float(a.w & 0xffff0000u)};
            const f32x4 h2 = {__uint_as_float(c.x << 16), __uint_as_float(c.x & 0xffff0000u), __uint_as_float(c.y << 16), __uint_as_float(c.y & 0xffff0000u)};
            const f32x4 h3 = {__uint_as_float(c.z << 16), __uint_as_float(c.z & 0xffff0000u), __uint_as_float(c.w << 16), __uint_as_float(c.w & 0xffff0000u)};
            float p8[8];
#pragma unroll
            for (int hh = 0; hh < 8; ++hh) { const LAS f32x4* w = (const LAS f32x4*)(wfs + hh * 1024 + 8 * lane);
                const f32x4 w0 = w[0], w1 = w[1], w2 = w[128], w3 = w[129];
                float p = ((h0.x * w0.x + h0.y * w0.y) + (h0.z * w0.z + h0.w * w0.w)) + ((h1.x * w1.x + h1.y * w1.y) + (h1.z * w1.z + h1.w * w1.w))
                        + ((h2.x * w2.x + h2.y * w2.y) + (h2.z * w2.z + h2.w * w2.w)) + ((h3.x * w3.x + h3.y * w3.y) + (h3.z * w3.z + h3.w * w3.w));
                p8[hh] = p; }
            { const bool b32 = (lane & 32) != 0, b16 = (lane & 16) != 0, b8 = (lane & 8) != 0; float q4[4], q2[2], q1;
#pragma unroll
              for (int k = 0; k < 4; ++k) { const float mine = b32 ? p8[4 + k] : p8[k], send = b32 ? p8[k] : p8[4 + k]; q4[k] = mine + __shfl_xor(send, 32); }
#pragma unroll
              for (int k = 0; k < 2; ++k) { const float mine = b16 ? q4[2 + k] : q4[k], send = b16 ? q4[k] : q4[2 + k]; q2[k] = mine + __shfl_xor(send, 16); }
              { const float mine = b8 ? q2[1] : q2[0], send = b8 ? q2[0] : q2[1]; q1 = mine + __shfl_xor(send, 8); }
              q1 += __shfl_xor(q1, 4); q1 += __shfl_xor(q1, 2); q1 += __shfl_xor(q1, 1);
              if ((lane & 7) == 0) lfs[rl * 8 + (lane >> 3)] = log_sigmoid_f(q1 + fb[lane >> 3]); } }
        __syncthreads();
        { float* CUM = (float*)(ws_ + WS_CUM); float* BT = (float*)(ws_ + WS_BT);
          float s = lfs[lane * 8 + wave];
#pragma unroll
          for (int o = 1; o < 64; o <<= 1) { const float t = __shfl_up(s, o); if (lane >= o) s += t; }
          CUM[(size_t)(b * 8 + wave) * SEQ + (blk & 127) * 64 + lane] = s; if (lane == 63) BT[blk * 32 + wave] = s; }
        __syncthreads();
    }
}

__device__ __forceinline__ void pool_un8(const v4u u, float (&f)[8]) {
    f[0] = __uint_as_float(u.x << 16); f[1] = __uint_as_float(u.x & 0xffff0000u); f[2] = __uint_as_float(u.y << 16); f[3] = __uint_as_float(u.y & 0xffff0000u);
    f[4] = __uint_as_float(u.z << 16); f[5] = __uint_as_float(u.z & 0xffff0000u); f[6] = __uint_as_float(u.w << 16); f[7] = __uint_as_float(u.w & 0xffff0000u);
}
__device__ __forceinline__ void pool_phase(const bf16* UB, bf16* DD, int vcu, int G, int tid) {
    for (int blk = vcu; blk < 256; blk += G) {
        const int ch = (tid & 63) * 8, lg = ch >> 7, w = 2 << lg, wv = tid >> 6, tr0 = (blk & 127) * 64 + wv * 8; const size_t row0 = (size_t)blk * 64 + wv * 8;
        v4u u[23];
#pragma unroll
        for (int k = 0; k < 23; ++k) { const int d = k - 15; const bool need = (d >= 1 - w) && (tr0 + d >= 0);
            u[k] = (v4u){0u, 0u, 0u, 0u}; if (need) u[k] = *(const v4u*)(UB + (row0 + d) * 512 + ch); }
        float s[8];
#pragma unroll
        for (int e = 0; e < 8; ++e) s[e] = 0.f;
#pragma unroll
        for (int k = 0; k < 16; ++k) { float f[8]; pool_un8(u[k], f);
#pragma unroll
            for (int e = 0; e < 8; ++e) s[e] += f[e]; }
#pragma unroll
        for (int i = 0; i < 8; ++i) { float cur[8]; pool_un8(u[15 + i], cur);
            if (i > 0) {
                const v4u uo = (lg == 0) ? u[13 + i] : (lg == 1) ? u[11 + i] : (lg == 2) ? u[7 + i] : u[i - 1]; float old[8]; pool_un8(uo, old);
#pragma unroll
                for (int e = 0; e < 8; ++e) s[e] += cur[e] - old[e]; }
            const int t = tr0 + i, cnt = (t + 1 < w) ? t + 1 : w; const float inv = 1.0f / (float)cnt; v4u o;
            o.x = pk2(s[0] * inv - cur[0], s[1] * inv - cur[1]); o.y = pk2(s[2] * inv - cur[2], s[3] * inv - cur[3]); o.z = pk2(s[4] * inv - cur[4], s[5] * inv - cur[5]); o.w = pk2(s[6] * inv - cur[6], s[7] * inv - cur[7]);
            *(v4u*)(DD + (row0 + i) * 512 + ch) = o; }
    }
}

__global__ void __launch_bounds__(NWAVES * 64, 2) mk_fwd(Args) {
    extern __shared__ __attribute__((aligned(16))) unsigned char lds_raw[];
    cg::grid_group grid = cg::this_grid();
    LAS unsigned char* lds = (LAS unsigned char*)lds_raw;
    const int tid = threadIdx.x, lane = tid & 63, wave = __builtin_amdgcn_readfirstlane(tid >> 6);
    const int G = gridDim.x, bx = blockIdx.x, vcu = (G % 8 == 0) ? (bx % 8) * (G / 8) + bx / 8 : bx;
    constexpr size_t SLOT_E = (size_t)M * 512;
    constexpr int NOSPLIT = 1 << 30;
    typedef pg8::bf16_t pbf;
#define CG_SYNC() do { asm volatile("s_waitcnt vmcnt(0) lgkmcnt(0)" ::: "memory"); __syncthreads(); grid.sync(); __builtin_amdgcn_fence(__ATOMIC_ACQUIRE, "agent"); asm volatile("s_waitcnt vmcnt(0)" ::: "memory"); __syncthreads(); } while (0)
#define GRID_SYNC() do { asm volatile("s_waitcnt lgkmcnt(0)" ::: "memory"); XcdBarrier b_; b_.bar = (unsigned*)(ARG_WS + WS_CTL); b_.x = xb_xcc_id(); b_.st = (volatile LAS unsigned*)(lds + 131072 + 256); xcd_barrier(b_); } while (0)
#define FRESH() int G_ = G, bx_ = bx, vcu_ = vcu, tid_ = tid; asm volatile("" : "+s"(G_), "+s"(bx_), "+s"(vcu_), "+v"(tid_)); const int lane_ = tid_ & 63; (void)lane_; (void)bx_
    volatile LAS unsigned* bst = (volatile LAS unsigned*)(lds + 131072 + 256);
    if (tid < 2) bst[tid] = 0u;
    __syncthreads();
    (void)xcd_barrier_post((unsigned*)(ARG_WS + WS_CTL), bst);
    if (arg_cg_seam()) CG_SYNC();
    { FRESH(); mod_phase(0, 32, lds, vcu_, G_, tid_, wave, lane_); }
    GRID_SYNC();
    { FRESH(); norm_phase<false>(ARG_IN(0), 0, 0, lds, vcu_, G_, tid_, wave, lane_); }
    { FRESH(); mod_phase(32, 288, lds, vcu_, G_, tid_, wave, lane_); }
    { FRESH(); weights_phase(0, lds, vcu_, G_, wave, lane_); }
    GRID_SYNC();
    for (int l = 0; l < 2; ++l) {
        if (l == 1) { FRESH(); weights_phase(1, lds, vcu_, G_, wave, lane_); GRID_SYNC(); }
        for (int f = 0; f < 2; ++f) {
#ifndef NO_N
#endif
            {
                FRESH(); unsigned char* ws = ARG_WS;
                pg8::Gemm g{(const pbf*)(ws + WS_XN), (const pbf*)(ws + WS_WGU) + (size_t)f * NGU * 1024, M, NGU, D, NOSPLIT, 0}; pg8::StaticOrder S; S.init(M, NGU, G_, bx_); S.tail = 1;
                pg8::EpiSwiglu E{(pbf*)(ws + WS_BIG), FF};
#ifndef NO_GU
                pg8::gemm_phase<pg8::EpiSwiglu, pg8::StaticOrder, true, true>(lds, g, S, E);
#endif
            }
            GRID_SYNC();
            {
                FRESH(); unsigned char* ws = ARG_WS; float* outp = ARG_OUT;
                pg8::Gemm g{(const pbf*)(ws + WS_BIG), (const pbf*)(ws + WS_WD) + (size_t)f * 1024 * FF, M, D, FF, NOSPLIT, 0}; pg8::StaticOrder S; S.init(M, D, G_, bx_);
                const int nl = (f == 0) ? l : 1, nsub = (f == 0) ? 1 : 0, bank = (f == 0) ? 3 + l : 2, donorm = (f == 0 || l == 0) ? 1 : 0;
                const float* ng_ = ARG_IN(4) + (size_t)(nl * 3 + nsub) * 1024; const float* xin_ = ARG_IN(0);
                const float* nm_ = (const float*)(ws + WS_MOD) + (size_t)(nl * 2) * 9216 + (size_t)(3 * nsub) * 1024;
                pg8::EpiResid E{(f == 0 && l == 0) ? xin_ : (const float*)outp, outp, (const float*)(ws + WS_MOD) + (size_t)(l * 2) * 9216 + (f == 0 ? 2 : 8) * 1024,
                                (pbf*)(ws + WS_XN), ng_, nm_, nm_ + 1024, (float*)(ws + WS_XBUF), (unsigned*)(ws + WS_CTL) + 4096 + bank * 4096, 0.5f, donorm};
#ifndef NO_RES
                pg8::gemm_phase<pg8::EpiResid, pg8::StaticOrder, false, true>(lds, g, S, E);
#endif
            }
            GRID_SYNC();
            if (f == 0) {
                {
                    FRESH(); f_phase(l, lds, vcu_, G_, tid_, wave, lane_); unsigned char* ws = ARG_WS;
                    pg8::Gemm g{(const pbf*)(ws + WS_XN), (const pbf*)(ws + WS_WIN), M, NIN, D, NOSPLIT, 0}; pg8::StaticOrder S; S.init(M, NIN, G_, bx_); S.tail = 1;
                    LAS float* gl = (LAS float*)(lds + 131072 + 1024); if (tid_ < 256) gl[tid_] = (ARG_IN(9) + l * 256)[tid_]; __syncthreads();
                    pg8::EpiInproj E{(pbf*)(ws + WS_BIG), (pbf*)(ws + WS_G), (const LAS float*)gl};
#ifndef NO_IN
                    pg8::gemm_phase<pg8::EpiInproj, pg8::StaticOrder, true, true>(lds, g, S, E);
#endif
                }
                GRID_SYNC();
                {
                    FRESH(); unsigned char* ws = ARG_WS; pbf* SL = (pbf*)(ws + WS_BIG);
#ifndef NO_POOL
                    pool_phase((const bf16*)(SL + 5 * SLOT_E), (bf16*)(SL + 1 * SLOT_E), vcu_, G_, tid_);
#endif
                    using abf = attn_body::bf16;
                    volatile LAS int* hmap = (volatile LAS int*)(lds + 131072 + 288);
                    if (tid_ < 8) { const float* fbp = ARG_IN(11) + l * 8; const float fh = fbp[tid_]; int rank = 0;
#pragma unroll
                        for (int jj = 0; jj < 8; ++jj) { const float fj = fbp[jj]; rank += (fj > fh || (fj == fh && jj < tid_)) ? 1 : 0; }
                        hmap[rank] = tid_; }
                    __syncthreads();
                    for (int uu = vcu_; uu < 256; uu += G_) { const int bh = uu >> 4, s = uu & 15, b = bh >> 3, r = bh & 7;
#ifndef NO_ATTN0
                        for (int i = 0; i < 2; ++i) { const int h = __builtin_amdgcn_readfirstlane(hmap[i ? 7 - r : r]);
                            attn_body::attn_unit<0, 24>(b, h, i ? s : 31 - s, (const abf*)(SL + 2 * SLOT_E), (const abf*)(SL + 6 * SLOT_E), (const abf*)(SL + 7 * SLOT_E), (abf*)(SL + 2 * SLOT_E), (char*)lds_raw, (const float*)(ws + WS_CUM), (const float*)(ws + WS_BT), ARG_IN(9) + l * 256); }
#endif
#ifndef NO_ATTN1
                        for (int i = 0; i < 2; ++i)
                            attn_body::attn_unit<1, 24>(b, r, i ? s : 31 - s, (const abf*)(SL + 0 * SLOT_E), (const abf*)(SL + 3 * SLOT_E), (const abf*)(SL + 4 * SLOT_E), (abf*)(SL + 0 * SLOT_E), (char*)lds_raw, ARG_IN(10) + (size_t)(l * 8 + r) * 257, nullptr, nullptr);
#endif
                    }
                }
                GRID_SYNC();
                {
                    FRESH(); unsigned char* ws = ARG_WS;
                    pg8::Gemm g{(const pbf*)(ws + WS_BIG), (const pbf*)(ws + WS_WBR), M, 3072, 512, 4, SLOT}; pg8::BranchOrder S; S.S0.init(M, D, G_, bx_);
                    pg8::EpiBranch E{(pbf*)(ws + WS_MG), (const pbf*)(ws + WS_G)};
#ifndef NO_BR
                    pg8::gemm_phase<pg8::EpiBranch, pg8::BranchOrder, true, true>(lds, g, S, E);
#endif
                }
                GRID_SYNC();
                {
                    FRESH(); unsigned char* ws = ARG_WS; float* outp = ARG_OUT;
                    pg8::Gemm g{(const pbf*)(ws + WS_MG), (const pbf*)(ws + WS_WO), M, D, D, NOSPLIT, 0}; pg8::StaticOrder S; S.init(M, D, G_, bx_);
                    const float* ng_ = ARG_IN(4) + (size_t)(l * 3 + 2) * 1024;
                    pg8::EpiResid E{outp, outp, (const float*)(ws + WS_MOD) + (size_t)(l * 2) * 9216 + 5 * 1024,
                                    (pbf*)(ws + WS_XN), ng_, (const float*)(ws + WS_MOD) + (size_t)(l * 2) * 9216 + 6 * 1024, (const float*)(ws + WS_MOD) + (size_t)(l * 2) * 9216 + 7 * 1024, (float*)(ws + WS_XBUF), (unsigned*)(ws + WS_CTL) + 4096 + l * 4096, 1.0f, 1};
#ifndef NO_RES
                    pg8::gemm_phase<pg8::EpiResid, pg8::StaticOrder, false, true>(lds, g, S, E);
#endif
                }
                GRID_SYNC();
            }
        }
    }
}

extern "C" void kernel_launch(void* const* d_in, const int* in_sizes, int n_in, void* d_out, int out_size, void* d_ws, size_t ws_size, hipStream_t stream) {
    static int grid = 0;
    if (grid == 0) {
        if (n_in != 16 || out_size != M * D || ws_size < WS_END) { fprintf(stderr, "kernel_launch: unexpected shapes (n_in %d out %d ws %zu need %zu)\n", n_in, out_size, ws_size, (size_t)WS_END); grid = -1; return; }
        int dev = 0, cus = 0, per_cu = 0;
        if (hipGetDevice(&dev) != hipSuccess || hipDeviceGetAttribute(&cus, hipDeviceAttributeMultiprocessorCount, dev) != hipSuccess) { grid = -1; return; }
        if (hipFuncSetAttribute((const void*)mk_fwd, hipFuncAttributeMaxDynamicSharedMemorySize, LDS_BYTES) != hipSuccess) { fprintf(stderr, "kernel_launch: hipFuncSetAttribute failed\n"); grid = -1; return; }
        if (hipOccupancyMaxActiveBlocksPerMultiprocessor(&per_cu, (const void*)mk_fwd, NWAVES * 64, LDS_BYTES) != hipSuccess || per_cu < 1) { fprintf(stderr, "kernel_launch: occupancy query says %d\n", per_cu); per_cu = 1; }
        (void)hipGetLastError();
        grid = cus;
    }
    if (grid < 0) return;
    Args a{};
    for (int i = 0; i < 16; ++i) a.in[i] = (const float*)d_in[i];
    a.out = (float*)d_out; a.ws = (unsigned char*)d_ws; a.cg_seam = 0; a.pad = 0;
    if (hipMemsetAsync((char*)d_ws + WS_CTL, 0, CTL_ZERO_BYTES, stream) != hipSuccess) { fprintf(stderr, "kernel_launch: hipMemsetAsync failed\n"); return; }
    void* params[] = {&a};
    const hipError_t e = hipLaunchCooperativeKernel((const void*)mk_fwd, dim3(grid), dim3(NWAVES * 64), params, LDS_BYTES, stream);
    if (e != hipSuccess) fprintf(stderr, "kernel_launch: cooperative launch failed: %s (grid %d)\n", hipGetErrorString(e), grid);
}
```
